# Optimizing an MI355X kernel written in HIP

```python
import jax, jax.numpy as jnp
from jax import lax
import numpy as np

D_MODEL = 1024
BATCH = 4
SEQ = 8192
DEPTH = 1

CONV_WIDTH = 1024
CONV_SIZE = 31
HEAD_DIM = 64
HEADS_PER_GROUP = 8
DILATION_GROUPS = ((128, 1), (512, 4), (2048, 16))
N_GROUPS = len(DILATION_GROUPS)
N_ATT_HEADS = N_GROUPS * HEADS_PER_GROUP
ATT_QKV = N_ATT_HEADS * HEAD_DIM
ATT_OUT = HEADS_PER_GROUP * HEAD_DIM
ROT_DIM = HEAD_DIM // 4
ROPE_THETA = 500000.0
BLOCK = 128
MAX_POS_OFFSET = 4096
EPS = 1e-6
NEG_INF = -1e30

IN_SPLITS = (CONV_WIDTH, CONV_WIDTH, CONV_WIDTH,
             ATT_QKV, ATT_QKV, ATT_QKV, ATT_OUT,
             D_MODEL, D_MODEL)
IN_COLS = sum(IN_SPLITS)

kernel_name = "hybrid_conformer_conv_dilated_attention_gated_merge"


def _rmsnorm(x, g):
    xf = x.astype(jnp.float32)
    y = xf * lax.rsqrt(jnp.mean(xf * xf, axis=-1, keepdims=True) + EPS)
    return (y * g.astype(jnp.float32)).astype(x.dtype)


def _layernorm(x, g, b):
    xf = x.astype(jnp.float32)
    mu = jnp.mean(xf, axis=-1, keepdims=True)
    var = jnp.mean(jnp.square(xf - mu), axis=-1, keepdims=True)
    y = (xf - mu) * lax.rsqrt(var + EPS)
    return (y * g.astype(jnp.float32) + b.astype(jnp.float32)).astype(x.dtype)


def _partial_rope(t, positions):
    half = ROT_DIM // 2
    inv_freq = ROPE_THETA ** (-(jnp.arange(half, dtype=jnp.float32) * 2.0 / ROT_DIM))
    ang = positions.astype(jnp.float32)[..., None] * inv_freq
    cos = jnp.cos(ang)[:, :, None, :]
    sin = jnp.sin(ang)[:, :, None, :]
    tf = t.astype(jnp.float32)
    t1, t2 = tf[..., :half], tf[..., half:ROT_DIM]
    out = jnp.concatenate([t1 * cos - t2 * sin, t2 * cos + t1 * sin, tf[..., ROT_DIM:]], axis=-1)
    return out.astype(t.dtype)


def _dilated_window_group(q, k, v, window, dilation):
    b, s, h, e = q.shape
    L = s // dilation
    w_sub = window // dilation
    nb = -(-L // BLOCK)
    lp = nb * BLOCK

    def to_sub(t):
        return t.reshape(b, L, dilation, h, e).transpose(0, 2, 3, 1, 4)

    qs, ks, vs = to_sub(q), to_sub(k), to_sub(v)
    qs = jnp.pad(qs, ((0, 0), (0, 0), (0, 0), (0, lp - L), (0, 0)))
    ks = jnp.pad(ks, ((0, 0), (0, 0), (0, 0), (BLOCK, lp - L), (0, 0)))
    vs = jnp.pad(vs, ((0, 0), (0, 0), (0, 0), (BLOCK, lp - L), (0, 0)))
    qb = qs.reshape(b, dilation, h, nb, BLOCK, e)

    def band(t):
        prev = t[:, :, :, :lp].reshape(b, dilation, h, nb, BLOCK, e)
        cur = t[:, :, :, BLOCK:].reshape(b, dilation, h, nb, BLOCK, e)
        return jnp.concatenate([prev, cur], axis=-2)

    kb, vb = band(ks), band(vs)
    scores = jnp.einsum('bdhnqe,bdhnke->bdhnqk', qb.astype(jnp.float32),
                        kb.astype(jnp.float32)) * (e ** -0.5)
    qi = jnp.arange(BLOCK)[:, None]
    kj = jnp.arange(2 * BLOCK)[None, :]
    dist = qi + BLOCK - kj
    key_idx = jnp.arange(nb)[:, None, None] * BLOCK - BLOCK + kj[None]
    mask = (dist >= 0) & (dist <= w_sub) & (key_idx >= 0)
    scores = jnp.where(mask, scores, NEG_INF)
    m = jnp.max(scores, axis=-1)
    p = jnp.exp(scores - m[..., None])
    den = jnp.sum(p, axis=-1)
    o = jnp.einsum('bdhnqk,bdhnke->bdhnqe', p, vb.astype(jnp.float32)) / den[..., None]

    def from_sub(t):
        tail = t.shape[5:]
        t = t.reshape((b, dilation, h, lp) + tail)[:, :, :, :L]
        t = jnp.moveaxis(t, 3, 1)
        return t.reshape((b, s, h) + tail)

    return from_sub(o), from_sub(m), from_sub(den)


def setup_inputs(seed: int = 0) -> dict:
    key = jax.random.key(seed)
    ks = jax.random.split(key, 16)
    f32 = jnp.float32
    x = jax.random.normal(ks[0], (BATCH, SEQ, D_MODEL), f32)
    c = jax.random.normal(ks[1], (BATCH, D_MODEL), f32)
    positions = (jnp.arange(SEQ, dtype=jnp.int32)[None, :]
                 + jax.random.randint(ks[2], (BATCH, 1), 0, MAX_POS_OFFSET, dtype=jnp.int32))
    norm_g = 1.0 + 0.05 * jax.random.normal(ks[3], (DEPTH, D_MODEL), f32)
    w_ada = 0.5 * D_MODEL ** -0.5 * jax.random.normal(ks[4], (DEPTH, D_MODEL, 3 * D_MODEL), f32)
    b_ada = 0.02 * jax.random.normal(ks[5], (DEPTH, 3 * D_MODEL), f32)
    w_in = D_MODEL ** -0.5 * jax.random.normal(ks[6], (DEPTH, D_MODEL, IN_COLS), f32)
    conv_w = CONV_SIZE ** -0.5 * jax.random.normal(ks[7], (DEPTH, CONV_SIZE, CONV_WIDTH), f32)
    conv_b = 0.02 * jax.random.normal(ks[8], (DEPTH, CONV_WIDTH), f32)
    conv_ln_g = 1.0 + 0.05 * jax.random.normal(ks[9], (DEPTH, CONV_WIDTH), f32)
    conv_ln_b = 0.02 * jax.random.normal(ks[10], (DEPTH, CONV_WIDTH), f32)
    w_conv_out = CONV_WIDTH ** -0.5 * jax.random.normal(ks[11], (DEPTH, CONV_WIDTH, D_MODEL), f32)
    w_att_out = ATT_OUT ** -0.5 * jax.random.normal(ks[12], (DEPTH, ATT_OUT, D_MODEL), f32)
    w_o = D_MODEL ** -0.5 * jax.random.normal(ks[13], (DEPTH, D_MODEL, D_MODEL), f32)
    final_g = 1.0 + 0.05 * jax.random.normal(ks[14], (D_MODEL,), f32)
    return {"x": x, "c": c, "positions": positions, "norm_g": norm_g,
            "w_ada": w_ada, "b_ada": b_ada, "w_in": w_in, "conv_w": conv_w,
            "conv_b": conv_b, "conv_ln_g": conv_ln_g, "conv_ln_b": conv_ln_b,
            "w_conv_out": w_conv_out, "w_att_out": w_att_out, "w_o": w_o,
            "final_g": final_g}


def reference(x, c, positions, norm_g, w_ada, b_ada, w_in, conv_w, conv_b, conv_ln_g,
              conv_ln_b, w_conv_out, w_att_out, w_o, final_g):
    b, s, _ = x.shape
    split_idx = np.cumsum(IN_SPLITS)[:-1].tolist()
    for layer in range(DEPTH):
        mod = c @ w_ada[layer] + b_ada[layer]
        shift, scale, gate = [t[:, None, :] for t in jnp.split(mod, 3, axis=-1)]
        h = _rmsnorm(x, norm_g[layer]) * (1.0 + scale) + shift

        proj = h @ w_in[layer]
        (glu_a, glu_b, z_conv, q, k, v, z_att, g_conv, g_att) = jnp.split(proj, split_idx, axis=-1)

        u = glu_a * jax.nn.sigmoid(glu_b)
        u = lax.conv_general_dilated(
            u, conv_w[layer][:, None, :].astype(u.dtype), window_strides=(1,),
            padding=[(CONV_SIZE - 1, 0)], dimension_numbers=('NWC', 'WIO', 'NWC'),
            feature_group_count=CONV_WIDTH) + conv_b[layer]
        u = jax.nn.silu(_layernorm(u, conv_ln_g[layer], conv_ln_b[layer]))
        y_conv = (u * jax.nn.silu(z_conv)) @ w_conv_out[layer]

        q = _partial_rope(q.reshape(b, s, N_ATT_HEADS, HEAD_DIM), positions)
        k = _partial_rope(k.reshape(b, s, N_ATT_HEADS, HEAD_DIM), positions)
        v = v.reshape(b, s, N_ATT_HEADS, HEAD_DIM)
        outs, maxes, dens = [], [], []
        for gi, (window, dilation) in enumerate(DILATION_GROUPS):
            sl = slice(gi * HEADS_PER_GROUP, (gi + 1) * HEADS_PER_GROUP)
            o_g, m_g, d_g = _dilated_window_group(q[:, :, sl], k[:, :, sl], v[:, :, sl],
                                                  window, dilation)
            outs.append(o_g); maxes.append(m_g); dens.append(d_g)
        m_all = jnp.maximum(jnp.maximum(maxes[0], maxes[1]), maxes[2])
        wts = [d_g * jnp.exp(m_g - m_all) for m_g, d_g in zip(maxes, dens)]
        w_sum = wts[0] + wts[1] + wts[2]
        att = (wts[0][..., None] * outs[0] + wts[1][..., None] * outs[1]
               + wts[2][..., None] * outs[2]) / w_sum[..., None]
        att = att.reshape(b, s, ATT_OUT).astype(x.dtype)
        y_att = (att * jax.nn.silu(z_att)) @ w_att_out[layer]

        merged = jax.nn.sigmoid(g_conv) * y_conv + jax.nn.sigmoid(g_att) * y_att
        x = x + gate * (merged @ w_o[layer])
    return _rmsnorm(x, final_g)
```

```cpp
#include <hip/hip_runtime.h>
#include <hip/hip_cooperative_groups.h>
#include <cstdio>
#include <cstdint>
namespace cg = cooperative_groups;
namespace pg8 {
#define PG8_LAS __attribute__((address_space(3)))
typedef unsigned short bf16_t;
typedef short bf16x8 __attribute__((ext_vector_type(8)));
typedef float f32x4 __attribute__((ext_vector_type(4)));
typedef unsigned u32x4 __attribute__((ext_vector_type(4)));
constexpr int BM = 256, BK = 64, HALF = 128, HTB = HALF * BK * 2  , STAGE_BYTES = 8 * HTB, NXCD = 8, WGM = 8;

__host__ __device__ __forceinline__ int lds_byte(int r, int c) { const int st = (r >> 4) * 2 + (c >> 5), rr = r & 15, cc = c & 31, ob = rr * 64 + cc * 2; return st * 1024 + (ob ^ (((ob >> 9) & 1) << 5)); }
__host__ __device__ __forceinline__ void stage_rc(int b, int& R, int& C) { const int st = b / 1024, sb = b % 1024, swz = sb ^ (((sb >> 9) & 1) << 5); R = (st >> 1) * 16 + swz / 64; C = (st & 1) * 32 + (swz % 64) / 2; }
__host__ __device__ __forceinline__ int perm32(int rho) { const int n = rho >> 4, i = rho & 15; return 8 * (i >> 2) + 4 * n + (i & 3); }

struct Unit { int pm, pn; };
struct Gemm { const bf16_t* A; const bf16_t* Bt; int M, N, K; };

struct StaticOrder {
    int nM, nN, nwg, G, c;
    __host__ __device__ void init(int M, int N, int G_, int c_) { nM = M / BM; nN = N / BM; nwg = nM * nN; G = G_; c = c_; }
    __host__ __device__ bool next(int i, Unit& u) const {
        const long L = (long)i * G + c; if (L >= nwg) return false;
        int wgid = (int)L; { const int q = nwg / NXCD, r = nwg % NXCD, xcd = wgid % NXCD, off = wgid / NXCD; wgid = (xcd < r ? xcd * (q + 1) : r * (q + 1) + (xcd - r) * q) + off; }
        const int nig = WGM * nN, gid = wgid / nig, fm = gid * WGM, gsz = (nM - fm) < WGM ? (nM - fm) : WGM;
        u.pm = fm + ((wgid % nig) % gsz); u.pn = (wgid % nig) / gsz; return true;
    }
    __device__ __forceinline__ void a_ready(const Unit&) const {}
    __device__ __forceinline__ void done(const Unit&) const {}
};

__device__ __forceinline__ unsigned cvt_pk_bf16(float lo, float hi) { unsigned r; asm volatile("v_cvt_pk_bf16_f32 %0, %1, %2" : "=v"(r) : "v"(lo), "v"(hi)); return r; }
typedef float f32x2 __attribute__((ext_vector_type(2)));
template <class Epi, class Sched, bool ALIGN_EPI = false, bool SP2 = false>
__device__ __forceinline__ void gemm_phase(PG8_LAS unsigned char* lds, const Gemm g, const Sched& S, const Epi& E) {
    int tid_ = threadIdx.x; asm volatile("" : "+v"(tid_));
    const int tid = tid_, wid = __builtin_amdgcn_readfirstlane(tid >> 6), lane = tid & 63, wr = wid >> 2, wc = wid & 3, fr = lane & 15, fq = lane >> 4;
    const int K = g.K, nt = K / BK;
    unsigned voffA[2], voffB[2];
#pragma unroll
    for (int i = 0; i < 2; ++i) { int R, C; stage_rc(tid * 16 + i * 8192, R, C); const int Rb = Epi::PERM ? ((R & ~31) + perm32(R & 31)) : R;
        voffA[i] = (unsigned)(R * K + C) * 2u; voffB[i] = (unsigned)(Rb * K + C) * 2u; }
    const size_t kstep = (size_t)(BK * 2);
    const size_t hstep = (size_t)HALF * K * 2;
    const size_t tstep = 2 * hstep;
    const unsigned ldsw = (unsigned)wid * 1024u;
    const int aoff = lds_byte(wr * 64 + fr, fq * 8), boff = lds_byte(wc * 32 + fr, fq * 8);
#define PG8_SA(b, h) (((b) * 2 + (h)) * HTB)
#define PG8_SB(b, h) ((4 + (b) * 2 + (h)) * HTB)
#define PG8_STAGE(bufoff, gbase, voff) do { _Pragma("unroll") for (int _i = 0; _i < 2; ++_i) \
        __builtin_amdgcn_global_load_lds((const unsigned*)((const char*)(gbase) + (voff)[_i]), (PG8_LAS unsigned*)(lds + (bufoff) + ldsw + _i * 8192), 16, 0, 0); } while (0)
#define PG8_LDA(dst, b, h) do { _Pragma("unroll") for (int m = 0; m < 4; ++m) _Pragma("unroll") for (int k = 0; k < 2; ++k) dst[m][k] = *(const PG8_LAS bf16x8*)(lds + PG8_SA(b, h) + aoff + m * 2048 + k * 1024); } while (0)
#define PG8_LDB(dst, b, h) do { _Pragma("unroll") for (int n = 0; n < 2; ++n) _Pragma("unroll") for (int k = 0; k < 2; ++k) dst[n][k] = *(const PG8_LAS bf16x8*)(lds + PG8_SB(b, h) + boff + n * 2048 + k * 1024); } while (0)
#define PG8_MMA(ai, bj, At, Bt) do { __builtin_amdgcn_s_setprio(1); _Pragma("unroll") for (int m = 0; m < 4; ++m) _Pragma("unroll") for (int n = 0; n < 2; ++n) _Pragma("unroll") for (int k = 0; k < 2; ++k) \
        acc[ai][bj][m][n] = __builtin_amdgcn_mfma_f32_16x16x32_bf16(Bt[n][k], At[m][k], acc[ai][bj][m][n], 0, 0, 0); __builtin_amdgcn_s_setprio(0); } while (0)
#define PG8_WAIT_V(n) asm volatile("s_waitcnt vmcnt(" #n ")" ::: "memory")
#define PG8_WAIT_L(n) asm volatile("s_waitcnt lgkmcnt(" #n ")" ::: "memory")
#define PG8_BAR __builtin_amdgcn_s_barrier()
#define PG8_SCHED __builtin_amdgcn_sched_barrier(0)
    Unit cur, nxt; int ui = 0;
    if (!S.next(0, cur)) return;
    f32x4 acc[2][2][4][2];
#pragma unroll
    for (int a = 0; a < 2; ++a)
#pragma unroll
        for (int b = 0; b < 2; ++b)
#pragma unroll
            for (int m = 0; m < 4; ++m)
#pragma unroll
                for (int n = 0; n < 2; ++n) acc[a][b][m][n] = (f32x4){0.f, 0.f, 0.f, 0.f};
    bf16x8 At[4][2], B0[2][2], B1[2][2];
    const char* cA = (const char*)g.A + (size_t)cur.pm * tstep; const char* cB = (const char*)g.Bt + (size_t)cur.pn * tstep;
    S.a_ready(cur);
    if constexpr (SP2) {
        PG8_STAGE(PG8_SB(0, 0), cB, voffB); PG8_STAGE(PG8_SB(0, 1), cB + hstep, voffB); PG8_STAGE(PG8_SA(0, 0), cA, voffA); PG8_STAGE(PG8_SA(0, 1), cA + hstep, voffA);
        if (wr == 1) PG8_BAR;
        PG8_WAIT_V(2); PG8_BAR;
        PG8_STAGE(PG8_SB(1, 0), cB + kstep, voffB); PG8_STAGE(PG8_SA(1, 0), cA + kstep, voffA); PG8_STAGE(PG8_SB(1, 1), cB + hstep + kstep, voffB);
        PG8_WAIT_V(6); PG8_BAR;
    } else {
        PG8_STAGE(PG8_SB(0, 0), cB, voffB); PG8_STAGE(PG8_SA(0, 0), cA, voffA); PG8_STAGE(PG8_SB(0, 1), cB + hstep, voffB); PG8_STAGE(PG8_SA(0, 1), cA + hstep, voffA);
        if (wr == 1) PG8_BAR;
        PG8_WAIT_V(4); PG8_BAR;
        PG8_STAGE(PG8_SB(1, 0), cB + kstep, voffB); PG8_STAGE(PG8_SA(1, 0), cA + kstep, voffA); PG8_STAGE(PG8_SB(1, 1), cB + hstep + kstep, voffB);
        PG8_WAIT_V(6); PG8_BAR;
    }
    for (;;) {
        const bool has_next = S.next(ui + 1, nxt);
        const char* nA = has_next ? (const char*)g.A + (size_t)nxt.pm * tstep : cA; const char* nB = has_next ? (const char*)g.Bt + (size_t)nxt.pn * tstep : cB;
        for (int t = 0; t < nt; t += 2) {
            const bool last = (t == nt - 2);
            const char* a1 = cA + (size_t)(t + 1) * kstep;
            const char* a2 = last ? nA : cA + (size_t)(t + 2) * kstep; const char* b2 = last ? nB : cB + (size_t)(t + 2) * kstep;
            const char* a3 = a2 + kstep; const char* b3 = b2 + kstep;
            if (last && has_next) S.a_ready(nxt);
            if constexpr (SP2) {
            PG8_LDB(B0, 0, 0); PG8_LDB(B1, 0, 1); PG8_SCHED; PG8_LDA(At, 0, 0); PG8_STAGE(PG8_SA(1, 1), a1 + hstep, voffA);
            PG8_WAIT_V(8); PG8_WAIT_L(0); PG8_BAR; PG8_MMA(0, 0, At, B0); PG8_MMA(0, 1, At, B1); PG8_BAR; PG8_SCHED;
            PG8_LDA(At, 0, 1); PG8_STAGE(PG8_SB(0, 0), b2, voffB); PG8_STAGE(PG8_SB(0, 1), b2 + hstep, voffB); PG8_STAGE(PG8_SA(0, 0), a2, voffA);
            PG8_WAIT_V(8); PG8_WAIT_L(0); PG8_BAR; PG8_MMA(1, 0, At, B0); PG8_MMA(1, 1, At, B1); PG8_BAR; PG8_SCHED;
            PG8_LDB(B0, 1, 0); PG8_LDB(B1, 1, 1); PG8_SCHED; PG8_LDA(At, 1, 0); PG8_STAGE(PG8_SA(0, 1), a2 + hstep, voffA);
            PG8_WAIT_V(8); PG8_WAIT_L(0); PG8_BAR; PG8_MMA(0, 0, At, B0); PG8_MMA(0, 1, At, B1); PG8_BAR; PG8_SCHED;
            PG8_LDA(At, 1, 1); PG8_STAGE(PG8_SB(1, 0), b3, voffB); PG8_STAGE(PG8_SB(1, 1), b3 + hstep, voffB); PG8_STAGE(PG8_SA(1, 0), a3, voffA);
            PG8_WAIT_V(8); PG8_WAIT_L(0); PG8_BAR; PG8_MMA(1, 0, At, B0); PG8_MMA(1, 1, At, B1); PG8_BAR; PG8_SCHED;
            } else {
            PG8_LDB(B0, 0, 0); PG8_SCHED; PG8_LDA(At, 0, 0); PG8_STAGE(PG8_SA(1, 1), a1 + hstep, voffA);
            PG8_WAIT_L(8); PG8_BAR; PG8_WAIT_L(0); PG8_MMA(0, 0, At, B0); PG8_BAR; PG8_SCHED;
            PG8_LDB(B1, 0, 1); PG8_STAGE(PG8_SB(0, 0), b2, voffB);
            PG8_BAR; PG8_WAIT_L(0); PG8_MMA(0, 1, At, B1); PG8_BAR;
            PG8_LDA(At, 0, 1); PG8_STAGE(PG8_SA(0, 0), a2, voffA);
            PG8_BAR; PG8_WAIT_L(0); PG8_MMA(1, 0, At, B0); PG8_BAR; PG8_SCHED;
            PG8_STAGE(PG8_SB(0, 1), b2 + hstep, voffB);
            PG8_WAIT_V(6); PG8_BAR; PG8_MMA(1, 1, At, B1); PG8_BAR;
            PG8_LDB(B0, 1, 0); PG8_SCHED; PG8_LDA(At, 1, 0); PG8_STAGE(PG8_SA(0, 1), a2 + hstep, voffA);
            PG8_WAIT_L(8); PG8_BAR; PG8_WAIT_L(0); PG8_MMA(0, 0, At, B0); PG8_BAR; PG8_SCHED;
            PG8_LDB(B1, 1, 1); PG8_STAGE(PG8_SB(1, 0), b3, voffB);
            PG8_BAR; PG8_WAIT_L(0); PG8_MMA(0, 1, At, B1); PG8_BAR;
            PG8_LDA(At, 1, 1); PG8_STAGE(PG8_SA(1, 0), a3, voffA);
            PG8_BAR; PG8_WAIT_L(0); PG8_MMA(1, 0, At, B0); PG8_BAR; PG8_SCHED;
            PG8_STAGE(PG8_SB(1, 1), b3 + hstep, voffB);
            PG8_WAIT_V(6); PG8_BAR; PG8_MMA(1, 1, At, B1); PG8_BAR;
            }
        }
        if constexpr (ALIGN_EPI) { if (wr == 0) PG8_BAR; }
        if constexpr (!Epi::AFTER_DRAIN) { E(acc, cur, wr, wc, fr, fq); S.done(cur); }
        if (!has_next) break;
#pragma unroll
        for (int a = 0; a < 2; ++a)
#pragma unroll
            for (int b = 0; b < 2; ++b)
#pragma unroll
                for (int m = 0; m < 4; ++m)
#pragma unroll
                    for (int n = 0; n < 2; ++n) acc[a][b][m][n] = (f32x4){0.f, 0.f, 0.f, 0.f};
        cur = nxt; cA = nA; cB = nB; ++ui;
        if constexpr (ALIGN_EPI) { if (wr == 1) PG8_BAR; }
    }
    PG8_WAIT_V(0);
    if constexpr (!ALIGN_EPI) { if (wr == 0) PG8_BAR; }
    PG8_BAR;
    if constexpr (Epi::AFTER_DRAIN) { E.fused(acc, cur, wr, wc, fr, fq, lds, wid, lane); S.done(cur); }
#undef PG8_SA
#undef PG8_SB
#undef PG8_STAGE
#undef PG8_LDA
#undef PG8_LDB
#undef PG8_MMA
#undef PG8_WAIT_V
#undef PG8_WAIT_L
#undef PG8_BAR
#undef PG8_SCHED
}
}

#define LAS __attribute__((address_space(3)))
typedef unsigned short bf16_t;
typedef short bf16x8 __attribute__((ext_vector_type(8)));
typedef short s16x4 __attribute__((ext_vector_type(4)));
typedef float f32x4 __attribute__((ext_vector_type(4)));
typedef unsigned u32x4 __attribute__((ext_vector_type(4)));
typedef unsigned u32x2 __attribute__((ext_vector_type(2)));
typedef float f32x2 __attribute__((ext_vector_type(2)));

constexpr int NB = 4, SEQ = 8192, DM = 1024, M = NB * SEQ, NIN = 10240, QP = 1536;
constexpr size_t MiB = 1u << 20;
constexpr size_t WS_MOD = 0, WS_CS = 1 * MiB, WS_SSQ = 3 * MiB, WS_LSE = 5 * MiB, WS_W1T = 8 * MiB, WS_WCO = 28 * MiB, WS_WAO = 30 * MiB, WS_WO = 31 * MiB,
                 WS_U = 36 * MiB, WS_ZC = 100 * MiB, WS_Q = 164 * MiB, WS_K = 260 * MiB, WS_V = 356 * MiB, WS_GA = 452 * MiB, WS_END = 484 * MiB;
constexpr size_t WS_MG = WS_U, WS_T = WS_K, WS_A2 = WS_V;
constexpr size_t DO_H = 0, DO_ZA = 64 * MiB, DO_GC = 96 * MiB;
constexpr int LDS_BYTES = 147456;
constexpr float QSCALE = 0.125f * 1.4426950408889634f;
constexpr float EPS = 1e-6f;

struct Params {
    const float *x, *c; const int* pos; const float *norm_g, *w_ada, *b_ada, *w_in, *conv_w, *conv_b, *ln_g, *ln_b, *w_co, *w_ao, *w_o, *final_g;
    float* out; unsigned char* ws;
    float f0, f1, f2, f3, f4, f5, f6, f7;
};

__device__ __forceinline__ unsigned pk2(float lo, float hi) { return pg8::cvt_pk_bf16(lo, hi); }
__device__ __forceinline__ float bflo(unsigned w) { return __uint_as_float(w << 16); }
__device__ __forceinline__ float bfhi(unsigned w) { return __uint_as_float(w & 0xffff0000u); }
__device__ __forceinline__ float sigm(float x) { return __builtin_amdgcn_rcpf(1.f + __expf(-x)); }
__device__ __forceinline__ float wave_sum(float v) {
#pragma unroll
    for (int o = 1; o < 64; o <<= 1) v += __shfl_xor(v, o);
    return v;
}
__device__ __forceinline__ u32x4 pack8(const f32x4 a, const f32x4 b) { u32x4 w; w.x = pk2(a[0], a[1]); w.y = pk2(a[2], a[3]); w.z = pk2(b[0], b[1]); w.w = pk2(b[2], b[3]); return w; }
__device__ __forceinline__ f32x4 sigm4(const f32x4 v) { return (f32x4){sigm(v[0]), sigm(v[1]), sigm(v[2]), sigm(v[3])}; }
__device__ __forceinline__ unsigned un8x4(const f32x4 s) {
    const unsigned a = (unsigned)(s[0] * 255.f + 0.5f), b = (unsigned)(s[1] * 255.f + 0.5f), c = (unsigned)(s[2] * 255.f + 0.5f), d = (unsigned)(s[3] * 255.f + 0.5f);
    return a | (b << 8) | (c << 16) | (d << 24);
}
__device__ __forceinline__ f32x4 deq8(unsigned w) { return (f32x4){(float)(w & 255u), (float)((w >> 8) & 255u), (float)((w >> 16) & 255u), (float)(w >> 24)} * (1.0f / 255.0f); }
__device__ __forceinline__ f32x4 bf4lo(unsigned w0, unsigned w1) { return (f32x4){bflo(w0), bfhi(w0), bflo(w1), bfhi(w1)}; }

struct Epi1 {
    static constexpr bool PERM = true, AFTER_DRAIN = false;
    unsigned char *ws, *dout;
    __device__ __forceinline__ void operator()(const f32x4 (&acc)[2][2][4][2], const pg8::Unit& u, int wr, int wc, int fr, int fq) const {
        const int pn = u.pn, row0 = u.pm * 256 + wr * 64 + fr, cl = wc * 32 + 8 * fq;
        bf16_t* const U = (bf16_t*)(ws + WS_U); bf16_t* const ZC = (bf16_t*)(ws + WS_ZC); bf16_t* const Q = (bf16_t*)(ws + WS_Q); bf16_t* const K = (bf16_t*)(ws + WS_K); bf16_t* const V = (bf16_t*)(ws + WS_V);
        bf16_t* const ZA = (bf16_t*)(dout + DO_ZA); unsigned char* const GC8 = dout + DO_GC; unsigned char* const GA8 = ws + WS_GA; const float* const CS = (const float*)(ws + WS_CS);
        if (pn < 8) {
#pragma unroll
            for (int ai = 0; ai < 2; ++ai)
#pragma unroll
                for (int m = 0; m < 4; ++m) {
                    const size_t row = (size_t)(row0 + ai * 128 + m * 16);
                    const f32x4 a0 = acc[ai][0][m][0] * sigm4(acc[ai][1][m][0]), a1 = acc[ai][0][m][1] * sigm4(acc[ai][1][m][1]);
                    *(u32x4*)(U + row * 1024 + pn * 128 + cl) = pack8(a0, a1);
                }
        } else if (pn < 12 || pn == 30 || pn == 31) {
            bf16_t* base = pn < 12 ? ZC : ZA; const int pitch = pn < 12 ? 1024 : 512, col0 = (pn < 12 ? (pn - 8) : (pn - 30)) * 256 + cl;
#pragma unroll
            for (int ai = 0; ai < 2; ++ai)
#pragma unroll
                for (int m = 0; m < 4; ++m) {
                    const size_t row = (size_t)(row0 + ai * 128 + m * 16);
#pragma unroll
                    for (int bj = 0; bj < 2; ++bj) {
                        const f32x4 v0 = acc[ai][bj][m][0], v1 = acc[ai][bj][m][1];
                        *(u32x4*)(base + row * pitch + col0 + bj * 128) = pack8(v0 * sigm4(v0), v1 * sigm4(v1));
                    }
                }
        } else if (pn < 24) {
            const bool isq = pn < 18; bf16_t* base = isq ? Q : K; const int col0 = (pn - (isq ? 12 : 18)) * 256 + cl; const float sc = isq ? QSCALE : 1.0f;
            const bool rot = ((wc & 1) == 0) && (fq < 2);
#pragma unroll
            for (int ai = 0; ai < 2; ++ai)
#pragma unroll
                for (int m = 0; m < 4; ++m) {
                    const size_t row = (size_t)(row0 + ai * 128 + m * 16);
                    f32x4 cv = (f32x4){1.f, 1.f, 1.f, 1.f}, sv = (f32x4){0.f, 0.f, 0.f, 0.f};
                    if (rot) { cv = *(const f32x4*)(CS + row * 16 + 4 * fq); sv = *(const f32x4*)(CS + row * 16 + 8 + 4 * fq); }
#pragma unroll
                    for (int bj = 0; bj < 2; ++bj) {
                        const f32x4 v0 = acc[ai][bj][m][0], v1 = acc[ai][bj][m][1];
                        const f32x4 n0 = (v0 * cv - v1 * sv) * sc, n1 = (v1 * cv + v0 * sv) * sc;
                        *(u32x4*)(base + row * QP + col0 + bj * 128) = pack8(n0, n1);
                    }
                }
        } else if (pn < 30) {
            const int col0 = (pn - 24) * 256 + cl;
#pragma unroll
            for (int ai = 0; ai < 2; ++ai)
#pragma unroll
                for (int m = 0; m < 4; ++m) {
                    const size_t row = (size_t)(row0 + ai * 128 + m * 16);
#pragma unroll
                    for (int bj = 0; bj < 2; ++bj) *(u32x4*)(V + row * QP + col0 + bj * 128) = pack8(acc[ai][bj][m][0], acc[ai][bj][m][1]);
                }
        } else {
            unsigned char* base = pn < 36 ? GC8 : GA8; const int col0 = (pn - (pn < 36 ? 32 : 36)) * 256 + cl;
#pragma unroll
            for (int ai = 0; ai < 2; ++ai)
#pragma unroll
                for (int m = 0; m < 4; ++m) {
                    const size_t row = (size_t)(row0 + ai * 128 + m * 16);
#pragma unroll
                    for (int bj = 0; bj < 2; ++bj) { u32x2 w; w.x = un8x4(sigm4(acc[ai][bj][m][0])); w.y = un8x4(sigm4(acc[ai][bj][m][1])); *(u32x2*)(base + row * 1024 + col0 + bj * 128) = w; }
                }
        }
    }
};
struct Epi3 {
    static constexpr bool PERM = true, AFTER_DRAIN = false;
    const unsigned char* GC8; bf16_t* T;
    __device__ __forceinline__ void operator()(const f32x4 (&acc)[2][2][4][2], const pg8::Unit& u, int wr, int wc, int fr, int fq) const {
        const int row0 = u.pm * 256 + wr * 64 + fr, col0 = u.pn * 256 + wc * 32 + 8 * fq;
#pragma unroll
        for (int ai = 0; ai < 2; ++ai)
#pragma unroll
            for (int m = 0; m < 4; ++m) {
                const size_t row = (size_t)(row0 + ai * 128 + m * 16);
#pragma unroll
                for (int bj = 0; bj < 2; ++bj) {
                    const u32x2 g = *(const u32x2*)(GC8 + row * 1024 + col0 + bj * 128);
                    *(u32x4*)(T + row * 1024 + col0 + bj * 128) = pack8(acc[ai][bj][m][0] * deq8(g.x), acc[ai][bj][m][1] * deq8(g.y));
                }
            }
    }
};
struct Epi4 {
    static constexpr bool PERM = true, AFTER_DRAIN = false;
    const unsigned char* GA8; const bf16_t* T; bf16_t* MG;
    __device__ __forceinline__ void operator()(const f32x4 (&acc)[2][2][4][2], const pg8::Unit& u, int wr, int wc, int fr, int fq) const {
        const int row0 = u.pm * 256 + wr * 64 + fr, col0 = u.pn * 256 + wc * 32 + 8 * fq;
#pragma unroll
        for (int ai = 0; ai < 2; ++ai)
#pragma unroll
            for (int m = 0; m < 4; ++m) {
                const size_t row = (size_t)(row0 + ai * 128 + m * 16);
#pragma unroll
                for (int bj = 0; bj < 2; ++bj) {
                    const u32x2 g = *(const u32x2*)(GA8 + row * 1024 + col0 + bj * 128);
                    const u32x4 t = *(const u32x4*)(T + row * 1024 + col0 + bj * 128);
                    *(u32x4*)(MG + row * 1024 + col0 + bj * 128) = pack8(bf4lo(t.x, t.y) + acc[ai][bj][m][0] * deq8(g.x), bf4lo(t.z, t.w) + acc[ai][bj][m][1] * deq8(g.y));
                }
            }
    }
};
struct Epi5 {
    static constexpr bool PERM = true, AFTER_DRAIN = false;
    const float* x; const float* MOD; float* out; float* SSQ;
    __device__ __forceinline__ void operator()(const f32x4 (&acc)[2][2][4][2], const pg8::Unit& u, int wr, int wc, int fr, int fq) const {
        const int row0 = u.pm * 256 + wr * 64 + fr, col0 = u.pn * 256 + wc * 32 + 8 * fq, b = u.pm >> 5;
        f32x4 gt[2][2];
#pragma unroll
        for (int bj = 0; bj < 2; ++bj) { gt[bj][0] = *(const f32x4*)(MOD + b * 3072 + 2048 + col0 + bj * 128); gt[bj][1] = *(const f32x4*)(MOD + b * 3072 + 2048 + col0 + bj * 128 + 4); }
#pragma unroll
        for (int ai = 0; ai < 2; ++ai)
#pragma unroll
            for (int m = 0; m < 4; ++m) {
                const size_t row = (size_t)(row0 + ai * 128 + m * 16);
                float ss = 0.f;
#pragma unroll
                for (int bj = 0; bj < 2; ++bj) {
                    const f32x4 xa = *(const f32x4*)(x + row * 1024 + col0 + bj * 128), xb = *(const f32x4*)(x + row * 1024 + col0 + bj * 128 + 4);
                    const f32x4 o0 = xa + gt[bj][0] * acc[ai][bj][m][0], o1 = xb + gt[bj][1] * acc[ai][bj][m][1];
                    *(f32x4*)(out + row * 1024 + col0 + bj * 128) = o0; *(f32x4*)(out + row * 1024 + col0 + bj * 128 + 4) = o1;
                    ss += (o0[0] * o0[0] + o0[1] * o0[1]) + (o0[2] * o0[2] + o0[3] * o0[3]) + (o1[0] * o1[0] + o1[1] * o1[1]) + (o1[2] * o1[2] + o1[3] * o1[3]);
                }
                ss += __shfl_xor(ss, 16); ss += __shfl_xor(ss, 32);
                if (fq == 0) SSQ[row * 16 + u.pn * 4 + wc] = ss;
            }
    }
};

__device__ __forceinline__ int src_col(int n) {
    const int tile = n >> 8, loc = n & 255;
    if (tile < 8) return (loc < 128) ? tile * 128 + loc : 1024 + tile * 128 + (loc - 128);
    if (tile >= 12 && tile < 24) { const int p = loc & 63; if (p < 16) return (n & ~63) + (p & 3) + ((p >> 2) & 1) * 8 + ((p >> 3) & 1) * 4; }
    return n;
}
template <bool PERMUTE>
__device__ __forceinline__ void transpose_item(const float* W, int K, int N, bf16_t* WT, LAS float* scr, int item, int lane) {
    const int nblk = N / 32, kb = item / nblk, nb = item % nblk, k0 = 64 * kb, n0 = 32 * nb;
    const int sn = PERMUTE ? src_col(n0 + (lane & 31)) : n0 + (lane & 31);
#pragma unroll 8
    for (int i = 0; i < 32; ++i) { const int kk = 2 * i + (lane >> 5); scr[kk * 33 + (lane & 31)] = W[(size_t)(k0 + kk) * N + sn]; }
    asm volatile("s_waitcnt lgkmcnt(0)" ::: "memory");
    const int c = lane & 7;
#pragma unroll
    for (int j = 0; j < 4; ++j) { const int n = (lane >> 3) + 8 * j; const LAS float* s = scr + (8 * c) * 33 + n;
        u32x4 o; o.x = pk2(s[0 * 33], s[1 * 33]); o.y = pk2(s[2 * 33], s[3 * 33]); o.z = pk2(s[4 * 33], s[5 * 33]); o.w = pk2(s[6 * 33], s[7 * 33]);
        *(u32x4*)(WT + (size_t)(n0 + n) * K + k0 + 8 * c) = o; }
    asm volatile("s_waitcnt lgkmcnt(0)" ::: "memory");
}

__device__ __forceinline__ void conv_item(const Params& p, LAS unsigned char* lds, int it, int tid) {
    const bf16_t* U = (const bf16_t*)(p.ws + WS_U); bf16_t* ZC = (bf16_t*)(p.ws + WS_ZC);
    const int row0 = it * 32, s0 = row0 & (SEQ - 1), c = 2 * tid;
    float w0[31], w1[31];
#pragma unroll
    for (int k = 0; k < 31; ++k) { const f32x2 wv = *(const f32x2*)(p.conv_w + k * 1024 + c); w0[k] = wv.x; w1[k] = wv.y; }
    const f32x2 bias = *(const f32x2*)(p.conv_b + c);
    float a0[32], a1[32];
#pragma unroll
    for (int t = 0; t < 32; ++t) { a0[t] = bias.x; a1[t] = bias.y; }
    const unsigned* up = (const unsigned*)(U + ((long)row0 - 30) * 1024 + c);
#pragma unroll
    for (int s = 0; s < 62; ++s) {
        unsigned uu = 0u;
        if (s >= 30 || s0 > 0) uu = up[(long)s * 512];
        const float u0 = bflo(uu), u1 = bfhi(uu);
#pragma unroll
        for (int k = 0; k < 31; ++k) { const int t = s - k; if (t >= 0 && t < 32) { a0[t] += w0[k] * u0; a1[t] += w1[k] * u1; } }
    }
    LAS f32x2* red = (LAS f32x2*)lds;
    LAS f32x2* stats = (LAS f32x2*)(lds + 131072);
#pragma unroll
    for (int t = 0; t < 32; ++t) red[t * 512 + tid] = (f32x2){a0[t] + a1[t], a0[t] * a0[t] + a1[t] * a1[t]};
    __syncthreads();
    {
        const int t = tid >> 4, part = tid & 15; float s1 = 0.f, s2 = 0.f;
#pragma unroll 8
        for (int i = 0; i < 32; ++i) { const f32x2 v = red[t * 512 + part + 16 * i]; s1 += v.x; s2 += v.y; }
#pragma unroll
        for (int o = 1; o < 16; o <<= 1) { s1 += __shfl_xor(s1, o); s2 += __shfl_xor(s2, o); }
        if (part == 0) { const float mean = s1 * (1.f / 1024.f); const float var = fmaxf(s2 * (1.f / 1024.f) - mean * mean, 0.f); stats[t] = (f32x2){mean, 1.0f / sqrtf(var + EPS)}; }
    }
    __syncthreads();
    const f32x2 g2 = *(const f32x2*)(p.ln_g + c), b2 = *(const f32x2*)(p.ln_b + c);
    unsigned* zp = (unsigned*)(ZC + (size_t)row0 * 1024 + c);
#pragma unroll
    for (int t = 0; t < 32; ++t) {
        const f32x2 st = stats[t];
        float y0 = (a0[t] - st.x) * st.y * g2.x + b2.x, y1 = (a1[t] - st.x) * st.y * g2.y + b2.y;
        y0 *= sigm(y0); y1 *= sigm(y1);
        const unsigned z = zp[(size_t)t * 512];
        zp[(size_t)t * 512] = pk2(y0 * bflo(z), y1 * bfhi(z));
    }
    __syncthreads();
}

typedef short v4i16_t __attribute__((ext_vector_type(4)));
__device__ __forceinline__ s16x4 vtr(const LAS unsigned char* p) { return __builtin_bit_cast(s16x4, __builtin_amdgcn_ds_read_tr16_b64_v4i16((LAS v4i16_t*)p)); }
constexpr int KV_ROWB = 160, LDS_VOFF = 256 * KV_ROWB;
__device__ __forceinline__ void attn_item(const Params& p, LAS unsigned char* lds, int idx, int tid, int lane, int w) {
    bf16_t* Q = (bf16_t*)(p.ws + WS_Q); const bf16_t* K = (const bf16_t*)(p.ws + WS_K); const bf16_t* V = (const bf16_t*)(p.ws + WS_V); float* LSE = (float*)(p.ws + WS_LSE);
    const int q64 = idx & 63; int rest = idx >> 6; const int j = rest & 7; rest >>= 3; const int g = rest % 3, b = rest / 3;
    const int sh = 2 * g, d = 1 << sh, nbm = (64 >> sh) - 1, r = q64 >> (6 - sh), n = q64 & nbm;
    const int hc = (8 * g + j) * 64;
    const size_t rowb = (size_t)b * SEQ + r;
    {
        const int kr = tid >> 2, ch = tid & 3, nprev = n > 0 ? n - 1 : n;
        const size_t rp = (rowb + (size_t)(nprev * 128 + kr) * d) * QP + hc + ch * 16, rc = (rowb + (size_t)(n * 128 + kr) * d) * QP + hc + ch * 16;
        const u32x4 k0 = *(const u32x4*)(K + rp), k1 = *(const u32x4*)(K + rp + 8), k2 = *(const u32x4*)(K + rc), k3 = *(const u32x4*)(K + rc + 8);
        const u32x4 v0 = *(const u32x4*)(V + rp), v1 = *(const u32x4*)(V + rp + 8), v2 = *(const u32x4*)(V + rc), v3 = *(const u32x4*)(V + rc + 8);
        __syncthreads();
        LAS unsigned char* dp = lds + kr * KV_ROWB + ch * 32; LAS unsigned char* dc = dp + 128 * KV_ROWB;
        *(LAS u32x4*)(dp) = k0; *(LAS u32x4*)(dp + 16) = k1; *(LAS u32x4*)(dc) = k2; *(LAS u32x4*)(dc + 16) = k3;
        *(LAS u32x4*)(dp + LDS_VOFF) = v0; *(LAS u32x4*)(dp + LDS_VOFF + 16) = v1; *(LAS u32x4*)(dc + LDS_VOFF) = v2; *(LAS u32x4*)(dc + LDS_VOFF + 16) = v3;
        __syncthreads();
    }
    const int fr = lane & 15, fq = lane >> 4;
    const size_t qrow = rowb + (size_t)(n * 128 + 16 * w + fr) * d;
    bf16_t* qptr = Q + qrow * QP + hc;
    const bf16x8 qf0 = *(const bf16x8*)(qptr + 8 * fq), qf1 = *(const bf16x8*)(qptr + 32 + 8 * fq);
    f32x4 s[9];
#pragma unroll
    for (int tp = 0; tp < 9; ++tp) {
        const LAS unsigned char* kb = lds + (16 * (w + tp) + fr) * KV_ROWB + fq * 16;
        const bf16x8 ka = *(const LAS bf16x8*)kb, kc = *(const LAS bf16x8*)(kb + 64);
        f32x4 z = (f32x4){0.f, 0.f, 0.f, 0.f};
        z = __builtin_amdgcn_mfma_f32_16x16x32_bf16(ka, qf0, z, 0, 0, 0);
        s[tp] = __builtin_amdgcn_mfma_f32_16x16x32_bf16(kc, qf1, z, 0, 0, 0);
    }
    const float NEG = -1e30f;
#pragma unroll
    for (int jj = 0; jj < 4; ++jj) { const int key = 4 * fq + jj; if (key < fr) s[0][jj] = NEG; if (key > fr) s[8][jj] = NEG; }
    if (n == 0) {
#pragma unroll
        for (int tp = 0; tp < 8; ++tp) if (w + tp < 8) s[tp] = (f32x4){NEG, NEG, NEG, NEG};
    }
    float mx = NEG;
#pragma unroll
    for (int tp = 0; tp < 9; ++tp) mx = fmaxf(fmaxf(mx, fmaxf(s[tp][0], s[tp][1])), fmaxf(s[tp][2], s[tp][3]));
    mx = fmaxf(mx, __shfl_xor(mx, 16)); mx = fmaxf(mx, __shfl_xor(mx, 32));
    float l = 0.f;
#pragma unroll
    for (int tp = 0; tp < 9; ++tp)
#pragma unroll
        for (int jj = 0; jj < 4; ++jj) { const float e = __builtin_amdgcn_exp2f(s[tp][jj] - mx); s[tp][jj] = e; l += e; }
    u32x4 pw[5];
#pragma unroll
    for (int kp = 0; kp < 4; ++kp) pw[kp] = pack8(s[2 * kp], s[2 * kp + 1]);
    pw[4] = pack8(s[8], (f32x4){0.f, 0.f, 0.f, 0.f});
    f32x4 ot[4];
#pragma unroll
    for (int dt = 0; dt < 4; ++dt) ot[dt] = (f32x4){0.f, 0.f, 0.f, 0.f};
    const LAS unsigned char* vbase = lds + LDS_VOFF + (16 * w + 4 * fq + (fr >> 2)) * KV_ROWB + (fr & 3) * 8;
#pragma unroll
    for (int kp = 0; kp < 5; ++kp)
#pragma unroll
        for (int dt = 0; dt < 4; ++dt) {
            const s16x4 lo = vtr(vbase + (2 * kp) * 16 * KV_ROWB + dt * 32);
            s16x4 hi = (s16x4){0, 0, 0, 0};
            if (kp < 4) hi = vtr(vbase + (2 * kp + 1) * 16 * KV_ROWB + dt * 32);
            const bf16x8 a = (bf16x8){lo[0], lo[1], lo[2], lo[3], hi[0], hi[1], hi[2], hi[3]};
            ot[dt] = __builtin_amdgcn_mfma_f32_16x16x32_bf16(a, __builtin_bit_cast(bf16x8, pw[kp]), ot[dt], 0, 0, 0);
        }
    l += __shfl_xor(l, 16); l += __shfl_xor(l, 32);
    const float inv = 1.0f / l;
#pragma unroll
    for (int dt = 0; dt < 4; ++dt) { u32x2 o; o.x = pk2(ot[dt][0] * inv, ot[dt][1] * inv); o.y = pk2(ot[dt][2] * inv, ot[dt][3] * inv); *(u32x2*)(qptr + 16 * dt + 4 * fq) = o; }
    if (fq == 0) LSE[((size_t)g * M + qrow) * 8 + j] = mx + __log2f(l);
}

__global__ void __launch_bounds__(512, 2) fwd_megakernel(Params p) {
    extern __shared__ __attribute__((aligned(16))) unsigned char lds_raw[];
    LAS unsigned char* lds = (LAS unsigned char*)lds_raw;
    cg::grid_group grid = cg::this_grid();
    int tid, lane, wave, gw;
#define RELANE() do { int t_ = threadIdx.x; asm volatile("" : "+v"(t_)); tid = t_; lane = tid & 63; wave = __builtin_amdgcn_readfirstlane(tid >> 6); gw = bid * 8 + wave; } while (0)
    const int G = gridDim.x, bid = blockIdx.x, NGW = G * 8;
    RELANE();
    unsigned char* ws = p.ws; unsigned char* dout = (unsigned char*)p.out;
    float* MOD = (float*)(ws + WS_MOD); float* CS = (float*)(ws + WS_CS); float* SSQ = (float*)(ws + WS_SSQ);
    bf16_t* W1T = (bf16_t*)(ws + WS_W1T); bf16_t* WCO = (bf16_t*)(ws + WS_WCO); bf16_t* WAO = (bf16_t*)(ws + WS_WAO); bf16_t* WO = (bf16_t*)(ws + WS_WO);
    bf16_t* H = (bf16_t*)(dout + DO_H); bf16_t* ZA = (bf16_t*)(dout + DO_ZA); unsigned char* GC8 = dout + DO_GC;

    for (int it = bid; it < 96; it += G) {
        const int n0 = it * 32, col = tid & 31, ks = tid >> 5;
        float a0 = 0.f, a1 = 0.f, a2 = 0.f, a3 = 0.f;
        const float* wp = p.w_ada + (size_t)(ks * 64) * 3072 + n0 + col; const float* cc = p.c + ks * 64;
#pragma unroll 8
        for (int k = 0; k < 64; ++k) { const float wv = wp[(size_t)k * 3072]; a0 += cc[k] * wv; a1 += cc[1024 + k] * wv; a2 += cc[2048 + k] * wv; a3 += cc[3072 + k] * wv; }
        LAS float* red = (LAS float*)lds;
        red[(ks * 4 + 0) * 32 + col] = a0; red[(ks * 4 + 1) * 32 + col] = a1; red[(ks * 4 + 2) * 32 + col] = a2; red[(ks * 4 + 3) * 32 + col] = a3;
        __syncthreads();
        if (tid < 128) { const int b = tid >> 5; float sum = p.b_ada[n0 + col];
#pragma unroll
            for (int k2 = 0; k2 < 16; ++k2) sum += red[(k2 * 4 + b) * 32 + col];
            MOD[b * 3072 + n0 + col] = sum; }
        __syncthreads();
    }
    {
        LAS float* scr = (LAS float*)(lds + wave * 16384);
        constexpr int I1 = 16 * 320, I2 = 16 * 32, I3 = 8 * 32, I4 = 16 * 32;
        for (int it = gw; it < I1 + I2 + I3 + I4; it += NGW) {
            int r = it;
            if (r < I1) { transpose_item<true>(p.w_in, 1024, NIN, W1T, scr, r, lane); continue; } r -= I1;
            if (r < I2) { transpose_item<false>(p.w_co, 1024, 1024, WCO, scr, r, lane); continue; } r -= I2;
            if (r < I3) { transpose_item<false>(p.w_ao, 512, 1024, WAO, scr, r, lane); continue; } r -= I3;
            transpose_item<false>(p.w_o, 1024, 1024, WO, scr, r, lane);
        }
    }
    for (int e = bid * 512 + tid; e < M * 8; e += G * 512) {
        const int row = e >> 3, i = e & 7;
        const float fi = i == 0 ? p.f0 : i == 1 ? p.f1 : i == 2 ? p.f2 : i == 3 ? p.f3 : i == 4 ? p.f4 : i == 5 ? p.f5 : i == 6 ? p.f6 : p.f7;
        const float ang = (float)p.pos[row] * fi;
        const double rev = (double)ang * 0.15915494309189535; const float frac = (float)(rev - __builtin_rint(rev));
        CS[row * 16 + i] = __builtin_amdgcn_cosf(frac); CS[row * 16 + 8 + i] = __builtin_amdgcn_sinf(frac);
    }
    grid.sync(); RELANE();

    for (int row = gw; row < M; row += NGW) {
        const f32x4* xr = (const f32x4*)(p.x + (size_t)row * 1024) + lane; f32x4 v[4]; float ss = 0.f;
#pragma unroll
        for (int jx = 0; jx < 4; ++jx) { v[jx] = xr[64 * jx]; ss += (v[jx][0] * v[jx][0] + v[jx][1] * v[jx][1]) + (v[jx][2] * v[jx][2] + v[jx][3] * v[jx][3]); }
        const float rstd = 1.0f / sqrtf(wave_sum(ss) * (1.f / 1024.f) + EPS);
        const float* mb = MOD + (row >> 13) * 3072;
#pragma unroll
        for (int jx = 0; jx < 4; ++jx) { const int col = 4 * lane + 256 * jx;
            const f32x4 gg = *(const f32x4*)(p.norm_g + col), scl = *(const f32x4*)(mb + 1024 + col), sft = *(const f32x4*)(mb + col);
            const f32x4 y = v[jx] * rstd * gg * (scl + 1.0f) + sft;
            u32x2 o; o.x = pk2(y[0], y[1]); o.y = pk2(y[2], y[3]); *(u32x2*)(H + (size_t)row * 1024 + col) = o; }
    }
    grid.sync(); RELANE();

    {
        pg8::Gemm g{H, W1T, M, NIN, 1024}; pg8::StaticOrder S; S.init(M, NIN, G, bid);
        Epi1 E{ws, dout};
        pg8::gemm_phase<Epi1, pg8::StaticOrder, true, true>(lds, g, S, E);
    }
    grid.sync(); RELANE();

    for (int it = bid; it < 1024 + 6144; it += G) {
        if (it < 1024) conv_item(p, lds, it, tid);
        else attn_item(p, lds, it - 1024, tid, lane, wave);
    }
    grid.sync(); RELANE();

    {
        const bf16_t* OG = (const bf16_t*)(ws + WS_Q); const float* LSE = (const float*)(ws + WS_LSE); bf16_t* A2 = (bf16_t*)(ws + WS_A2);
        for (int e = bid * 512 + tid; e < M * 64; e += G * 512) {
            const size_t row = (size_t)(e >> 6); const int jc = e & 63, j = jc >> 3;
            const float l0 = LSE[row * 8 + j], l1 = LSE[((size_t)M + row) * 8 + j], l2 = LSE[((size_t)2 * M + row) * 8 + j];
            const float mxl = fmaxf(l0, fmaxf(l1, l2));
            float w0 = __builtin_amdgcn_exp2f(l0 - mxl), w1 = __builtin_amdgcn_exp2f(l1 - mxl), w2 = __builtin_amdgcn_exp2f(l2 - mxl);
            const float inv = 1.0f / (w0 + w1 + w2); w0 *= inv; w1 *= inv; w2 *= inv;
            const u32x4 o0 = *(const u32x4*)(OG + row * QP + jc * 8), o1 = *(const u32x4*)(OG + row * QP + 512 + jc * 8), o2 = *(const u32x4*)(OG + row * QP + 1024 + jc * 8);
            const u32x4 za = *(const u32x4*)(ZA + row * 512 + jc * 8);
            u32x4 o;
#pragma unroll
            for (int q = 0; q < 4; ++q) {
                const float lo = (w0 * bflo(o0[q]) + w1 * bflo(o1[q]) + w2 * bflo(o2[q])) * bflo(za[q]);
                const float hi = (w0 * bfhi(o0[q]) + w1 * bfhi(o1[q]) + w2 * bfhi(o2[q])) * bfhi(za[q]);
                o[q] = pk2(lo, hi);
            }
            *(u32x4*)(A2 + row * 512 + jc * 8) = o;
        }
        pg8::Gemm g{(const bf16_t*)(ws + WS_ZC), WCO, M, 1024, 1024}; pg8::StaticOrder S; S.init(M, 1024, G, bid);
        Epi3 E{GC8, (bf16_t*)(ws + WS_T)};
        pg8::gemm_phase<Epi3, pg8::StaticOrder, true, true>(lds, g, S, E);
    }
    grid.sync(); RELANE();

    {
        pg8::Gemm g{(const bf16_t*)(ws + WS_A2), WAO, M, 1024, 512}; pg8::StaticOrder S; S.init(M, 1024, G, bid);
        Epi4 E{ws + WS_GA, (const bf16_t*)(ws + WS_T), (bf16_t*)(ws + WS_MG)};
        pg8::gemm_phase<Epi4, pg8::StaticOrder, true, true>(lds, g, S, E);
    }
    grid.sync(); RELANE();

    {
        pg8::Gemm g{(const bf16_t*)(ws + WS_MG), WO, M, 1024, 1024}; pg8::StaticOrder S; S.init(M, 1024, G, bid);
        Epi5 E{p.x, MOD, p.out, SSQ};
        pg8::gemm_phase<Epi5, pg8::StaticOrder, true, true>(lds, g, S, E);
    }
    grid.sync(); RELANE();

    for (int row = gw; row < M; row += NGW) {
        const float part = lane < 16 ? SSQ[(size_t)row * 16 + lane] : 0.f;
        const float rstd = 1.0f / sqrtf(wave_sum(part) * (1.f / 1024.f) + EPS);
        f32x4* orow = (f32x4*)(p.out + (size_t)row * 1024) + lane;
#pragma unroll
        for (int jx = 0; jx < 4; ++jx) { const f32x4 fg = *((const f32x4*)p.final_g + lane + 64 * jx); orow[64 * jx] = orow[64 * jx] * rstd * fg; }
    }
}

extern "C" void kernel_launch(void* const* d_in, const int* in_sizes, int n_in, void* d_out, int out_size, void* d_ws, size_t ws_size, hipStream_t stream) {
    static int grid = 0;
    if (grid == 0) {
        if (n_in != 15 || out_size != M * DM || ws_size < WS_END) { fprintf(stderr, "kernel_launch: unexpected sizes (n_in %d, out %d, ws %zu)\n", n_in, out_size, ws_size); grid = -1; return; }
        int dev = 0, cus = 0, per_cu = 0;
        (void)hipGetDevice(&dev); (void)hipDeviceGetAttribute(&cus, hipDeviceAttributeMultiprocessorCount, dev);
        (void)hipFuncSetAttribute((const void*)fwd_megakernel, hipFuncAttributeMaxDynamicSharedMemorySize, LDS_BYTES);
        if (hipOccupancyMaxActiveBlocksPerMultiprocessor(&per_cu, (const void*)fwd_megakernel, 512, LDS_BYTES) != hipSuccess || per_cu < 1) per_cu = 1;
        (void)hipGetLastError();
        grid = cus * per_cu;
    }
    if (grid < 0) return;
    Params p{};
    p.x = (const float*)d_in[0]; p.c = (const float*)d_in[1]; p.pos = (const int*)d_in[2]; p.norm_g = (const float*)d_in[3]; p.w_ada = (const float*)d_in[4]; p.b_ada = (const float*)d_in[5];
    p.w_in = (const float*)d_in[6]; p.conv_w = (const float*)d_in[7]; p.conv_b = (const float*)d_in[8]; p.ln_g = (const float*)d_in[9]; p.ln_b = (const float*)d_in[10];
    p.w_co = (const float*)d_in[11]; p.w_ao = (const float*)d_in[12]; p.w_o = (const float*)d_in[13]; p.final_g = (const float*)d_in[14];
    p.out = (float*)d_out; p.ws = (unsigned char*)d_ws;
    p.f0 = 1.0f; p.f1 = 1.939227432e-01f; p.f2 = 3.760603070e-02f; p.f3 = 7.292664610e-03f; p.f4 = 1.414213562e-03f; p.f5 = 2.742481884e-04f; p.f6 = 5.318295734e-05f; p.f7 = 1.031338525e-05f;
    void* args[] = {&p};
    const hipError_t e = hipLaunchCooperativeKernel((const void*)fwd_megakernel, dim3(grid), dim3(512), args, LDS_BYTES, stream);
    if (e != hipSuccess) fprintf(stderr, "cooperative launch failed: %s (grid %d)\n", hipGetErrorString(e), grid);
}
```

```cpp
#include <hip/hip_runtime.h>
#include <hip/hip_cooperative_groups.h>
#include <cstdio>
#include <cstdint>
namespace cg = cooperative_groups;
namespace pg8 {
#define PG8_LAS __attribute__((address_space(3)))
typedef unsigned short bf16_t;
typedef short bf16x8 __attribute__((ext_vector_type(8)));
typedef float f32x4 __attribute__((ext_vector_type(4)));
typedef unsigned u32x4 __attribute__((ext_vector_type(4)));
constexpr int BM = 256, BK = 64, HALF = 128, HTB = HALF * BK * 2  , STAGE_BYTES = 8 * HTB, NXCD = 8, WGM = 8;

__host__ __device__ __forceinline__ int lds_byte(int r, int c) { const int st = (r >> 4) * 2 + (c >> 5), rr = r & 15, cc = c & 31, ob = rr * 64 + cc * 2; return st * 1024 + (ob ^ (((ob >> 9) & 1) << 5)); }
__host__ __device__ __forceinline__ void stage_rc(int b, int& R, int& C) { const int st = b / 1024, sb = b % 1024, swz = sb ^ (((sb >> 9) & 1) << 5); R = (st >> 1) * 16 + swz / 64; C = (st & 1) * 32 + (swz % 64) / 2; }
__host__ __device__ __forceinline__ int perm32(int rho) { const int n = rho >> 4, i = rho & 15; return 8 * (i >> 2) + 4 * n + (i & 3); }

struct Unit { int pm, pn; };
struct Gemm { const bf16_t* A; const bf16_t* Bt; int M, N, K; };

struct StaticOrder {
    int nM, nN, nwg, G, c;
    __host__ __device__ void init(int M, int N, int G_, int c_) { nM = M / BM; nN = N / BM; nwg = nM * nN; G = G_; c = c_; }
    __host__ __device__ bool next(int i, Unit& u) const {
        const long L = (long)i * G + c; if (L >= nwg) return false;
        int wgid = (int)L; { const int q = nwg / NXCD, r = nwg % NXCD, xcd = wgid % NXCD, off = wgid / NXCD; wgid = (xcd < r ? xcd * (q + 1) : r * (q + 1) + (xcd - r) * q) + off; }
        const int nig = WGM * nN, gid = wgid / nig, fm = gid * WGM, gsz = (nM - fm) < WGM ? (nM - fm) : WGM;
        u.pm = fm + ((wgid % nig) % gsz); u.pn = (wgid % nig) / gsz; return true;
    }
    __device__ __forceinline__ void a_ready(const Unit&) const {}
    __device__ __forceinline__ void done(const Unit&) const {}
};

__device__ __forceinline__ unsigned cvt_pk_bf16(float lo, float hi) { unsigned r; asm volatile("v_cvt_pk_bf16_f32 %0, %1, %2" : "=v"(r) : "v"(lo), "v"(hi)); return r; }
typedef float f32x2 __attribute__((ext_vector_type(2)));
template <class Epi, class Sched, bool ALIGN_EPI = false, bool SP2 = false>
__device__ __forceinline__ void gemm_phase(PG8_LAS unsigned char* lds, const Gemm g, const Sched& S, const Epi& E) {
    int tid_ = threadIdx.x; asm volatile("" : "+v"(tid_));
    const int tid = tid_, wid = __builtin_amdgcn_readfirstlane(tid >> 6), lane = tid & 63, wr = wid >> 2, wc = wid & 3, fr = lane & 15, fq = lane >> 4;
    const int K = g.K, nt = K / BK;
    unsigned voffA[2], voffB[2];
#pragma unroll
    for (int i = 0; i < 2; ++i) { int R, C; stage_rc(tid * 16 + i * 8192, R, C); const int Rb = Epi::PERM ? ((R & ~31) + perm32(R & 31)) : R;
        voffA[i] = (unsigned)(R * K + C) * 2u; voffB[i] = (unsigned)(Rb * K + C) * 2u; }
    const size_t kstep = (size_t)(BK * 2);
    const size_t hstep = (size_t)HALF * K * 2;
    const size_t tstep = 2 * hstep;
    const unsigned ldsw = (unsigned)wid * 1024u;
    const int aoff = lds_byte(wr * 64 + fr, fq * 8), boff = lds_byte(wc * 32 + fr, fq * 8);
#define PG8_SA(b, h) (((b) * 2 + (h)) * HTB)
#define PG8_SB(b, h) ((4 + (b) * 2 + (h)) * HTB)
#define PG8_STAGE(bufoff, gbase, voff) do { _Pragma("unroll") for (int _i = 0; _i < 2; ++_i) \
        __builtin_amdgcn_global_load_lds((const unsigned*)((const char*)(gbase) + (voff)[_i]), (PG8_LAS unsigned*)(lds + (bufoff) + ldsw + _i * 8192), 16, 0, 0); } while (0)
#define PG8_LDA(dst, b, h) do { _Pragma("unroll") for (int m = 0; m < 4; ++m) _Pragma("unroll") for (int k = 0; k < 2; ++k) dst[m][k] = *(const PG8_LAS bf16x8*)(lds + PG8_SA(b, h) + aoff + m * 2048 + k * 1024); } while (0)
#define PG8_LDB(dst, b, h) do { _Pragma("unroll") for (int n = 0; n < 2; ++n) _Pragma("unroll") for (int k = 0; k < 2; ++k) dst[n][k] = *(const PG8_LAS bf16x8*)(lds + PG8_SB(b, h) + boff + n * 2048 + k * 1024); } while (0)
#define PG8_MMA(ai, bj, At, Bt) do { __builtin_amdgcn_s_setprio(1); _Pragma("unroll") for (int m = 0; m < 4; ++m) _Pragma("unroll") for (int n = 0; n < 2; ++n) _Pragma("unroll") for (int k = 0; k < 2; ++k) \
        acc[ai][bj][m][n] = __builtin_amdgcn_mfma_f32_16x16x32_bf16(Bt[n][k], At[m][k], acc[ai][bj][m][n], 0, 0, 0); __builtin_amdgcn_s_setprio(0); } while (0)
#define PG8_WAIT_V(n) asm volatile("s_waitcnt vmcnt(" #n ")" ::: "memory")
#define PG8_WAIT_L(n) asm volatile("s_waitcnt lgkmcnt(" #n ")" ::: "memory")
#define PG8_BAR __builtin_amdgcn_s_barrier()
#define PG8_SCHED __builtin_amdgcn_sched_barrier(0)
    Unit cur, nxt; int ui = 0;
    if (!S.next(0, cur)) return;
    f32x4 acc[2][2][4][2];
#pragma unroll
    for (int a = 0; a < 2; ++a)
#pragma unroll
        for (int b = 0; b < 2; ++b)
#pragma unroll
            for (int m = 0; m < 4; ++m)
#pragma unroll
                for (int n = 0; n < 2; ++n) acc[a][b][m][n] = (f32x4){0.f, 0.f, 0.f, 0.f};
    bf16x8 At[4][2], B0[2][2], B1[2][2];
    const char* cA = (const char*)g.A + (size_t)cur.pm * tstep; const char* cB = (const char*)g.Bt + (size_t)cur.pn * tstep;
    S.a_ready(cur);
    if constexpr (SP2) {
        PG8_STAGE(PG8_SB(0, 0), cB, voffB); PG8_STAGE(PG8_SB(0, 1), cB + hstep, voffB); PG8_STAGE(PG8_SA(0, 0), cA, voffA); PG8_STAGE(PG8_SA(0, 1), cA + hstep, voffA);
        if (wr == 1) PG8_BAR;
        PG8_WAIT_V(2); PG8_BAR;
        PG8_STAGE(PG8_SB(1, 0), cB + kstep, voffB); PG8_STAGE(PG8_SA(1, 0), cA + kstep, voffA); PG8_STAGE(PG8_SB(1, 1), cB + hstep + kstep, voffB);
        PG8_WAIT_V(6); PG8_BAR;
    } else {
        PG8_STAGE(PG8_SB(0, 0), cB, voffB); PG8_STAGE(PG8_SA(0, 0), cA, voffA); PG8_STAGE(PG8_SB(0, 1), cB + hstep, voffB); PG8_STAGE(PG8_SA(0, 1), cA + hstep, voffA);
        if (wr == 1) PG8_BAR;
        PG8_WAIT_V(4); PG8_BAR;
        PG8_STAGE(PG8_SB(1, 0), cB + kstep, voffB); PG8_STAGE(PG8_SA(1, 0), cA + kstep, voffA); PG8_STAGE(PG8_SB(1, 1), cB + hstep + kstep, voffB);
        PG8_WAIT_V(6); PG8_BAR;
    }
    for (;;) {
        const bool has_next = S.next(ui + 1, nxt);
        const char* nA = has_next ? (const char*)g.A + (size_t)nxt.pm * tstep : cA; const char* nB = has_next ? (const char*)g.Bt + (size_t)nxt.pn * tstep : cB;
        for (int t = 0; t < nt; t += 2) {
            const bool last = (t == nt - 2);
            const char* a1 = cA + (size_t)(t + 1) * kstep;
            const char* a2 = last ? nA : cA + (size_t)(t + 2) * kstep; const char* b2 = last ? nB : cB + (size_t)(t + 2) * kstep;
            const char* a3 = a2 + kstep; const char* b3 = b2 + kstep;
            if (last && has_next) S.a_ready(nxt);
            if constexpr (SP2) {
            PG8_LDB(B0, 0, 0); PG8_LDB(B1, 0, 1); PG8_SCHED; PG8_LDA(At, 0, 0); PG8_STAGE(PG8_SA(1, 1), a1 + hstep, voffA);
            PG8_WAIT_V(8); PG8_WAIT_L(0); PG8_BAR; PG8_MMA(0, 0, At, B0); PG8_MMA(0, 1, At, B1); PG8_BAR; PG8_SCHED;
            PG8_LDA(At, 0, 1); PG8_STAGE(PG8_SB(0, 0), b2, voffB); PG8_STAGE(PG8_SB(0, 1), b2 + hstep, voffB); PG8_STAGE(PG8_SA(0, 0), a2, voffA);
            PG8_WAIT_V(8); PG8_WAIT_L(0); PG8_BAR; PG8_MMA(1, 0, At, B0); PG8_MMA(1, 1, At, B1); PG8_BAR; PG8_SCHED;
            PG8_LDB(B0, 1, 0); PG8_LDB(B1, 1, 1); PG8_SCHED; PG8_LDA(At, 1, 0); PG8_STAGE(PG8_SA(0, 1), a2 + hstep, voffA);
            PG8_WAIT_V(8); PG8_WAIT_L(0); PG8_BAR; PG8_MMA(0, 0, At, B0); PG8_MMA(0, 1, At, B1); PG8_BAR; PG8_SCHED;
            PG8_LDA(At, 1, 1); PG8_STAGE(PG8_SB(1, 0), b3, voffB); PG8_STAGE(PG8_SB(1, 1), b3 + hstep, voffB); PG8_STAGE(PG8_SA(1, 0), a3, voffA);
            PG8_WAIT_V(8); PG8_WAIT_L(0); PG8_BAR; PG8_MMA(1, 0, At, B0); PG8_MMA(1, 1, At, B1); PG8_BAR; PG8_SCHED;
            } else {
            PG8_LDB(B0, 0, 0); PG8_SCHED; PG8_LDA(At, 0, 0); PG8_STAGE(PG8_SA(1, 1), a1 + hstep, voffA);
            PG8_WAIT_L(8); PG8_BAR; PG8_WAIT_L(0); PG8_MMA(0, 0, At, B0); PG8_BAR; PG8_SCHED;
            PG8_LDB(B1, 0, 1); PG8_STAGE(PG8_SB(0, 0), b2, voffB);
            PG8_BAR; PG8_WAIT_L(0); PG8_MMA(0, 1, At, B1); PG8_BAR;
            PG8_LDA(At, 0, 1); PG8_STAGE(PG8_SA(0, 0), a2, voffA);
            PG8_BAR; PG8_WAIT_L(0); PG8_MMA(1, 0, At, B0); PG8_BAR; PG8_SCHED;
            PG8_STAGE(PG8_SB(0, 1), b2 + hstep, voffB);
            PG8_WAIT_V(6); PG8_BAR; PG8_MMA(1, 1, At, B1); PG8_BAR;
            PG8_LDB(B0, 1, 0); PG8_SCHED; PG8_LDA(At, 1, 0); PG8_STAGE(PG8_SA(0, 1), a2 + hstep, voffA);
            PG8_WAIT_L(8); PG8_BAR; PG8_WAIT_L(0); PG8_MMA(0, 0, At, B0); PG8_BAR; PG8_SCHED;
            PG8_LDB(B1, 1, 1); PG8_STAGE(PG8_SB(1, 0), b3, voffB);
            PG8_BAR; PG8_WAIT_L(0); PG8_MMA(0, 1, At, B1); PG8_BAR;
            PG8_LDA(At, 1, 1); PG8_STAGE(PG8_SA(1, 0), a3, voffA);
            PG8_BAR; PG8_WAIT_L(0); PG8_MMA(1, 0, At, B0); PG8_BAR; PG8_SCHED;
            PG8_STAGE(PG8_SB(1, 1), b3 + hstep, voffB);
            PG8_WAIT_V(6); PG8_BAR; PG8_MMA(1, 1, At, B1); PG8_BAR;
            }
        }
        if constexpr (ALIGN_EPI) { if (wr == 0) PG8_BAR; }
        if constexpr (!Epi::AFTER_DRAIN) { E(acc, cur, wr, wc, fr, fq); S.done(cur); }
        if (!has_next) break;
#pragma unroll
        for (int a = 0; a < 2; ++a)
#pragma unroll
            for (int b = 0; b < 2; ++b)
#pragma unroll
                for (int m = 0; m < 4; ++m)
#pragma unroll
                    for (int n = 0; n < 2; ++n) acc[a][b][m][n] = (f32x4){0.f, 0.f, 0.f, 0.f};
        cur = nxt; cA = nA; cB = nB; ++ui;
        if constexpr (ALIGN_EPI) { if (wr == 1) PG8_BAR; }
    }
    PG8_WAIT_V(0);
    if constexpr (!ALIGN_EPI) { if (wr == 0) PG8_BAR; }
    PG8_BAR;
    if constexpr (Epi::AFTER_DRAIN) { E.fused(acc, cur, wr, wc, fr, fq, lds, wid, lane); S.done(cur); }
#undef PG8_SA
#undef PG8_SB
#undef PG8_STAGE
#undef PG8_LDA
#undef PG8_LDB
#undef PG8_MMA
#undef PG8_WAIT_V
#undef PG8_WAIT_L
#undef PG8_BAR
#undef PG8_SCHED
}
}

#define LAS __attribute__((address_space(3)))
typedef unsigned short bf16_t;
typedef short bf16x8 __attribute__((ext_vector_type(8)));
typedef short s16x4 __attribute__((ext_vector_type(4)));
typedef float f32x4 __attribute__((ext_vector_type(4)));
typedef unsigned u32x4 __attribute__((ext_vector_type(4)));
typedef unsigned u32x2 __attribute__((ext_vector_type(2)));
typedef float f32x2 __attribute__((ext_vector_type(2)));

constexpr int NB = 4, SEQ = 8192, DM = 1024, M = NB * SEQ, NIN = 10240, QP = 1536;
constexpr size_t MiB = 1u << 20;
constexpr size_t WS_MOD = 0, WS_CS = 1 * MiB, WS_SSQ = 3 * MiB, WS_LSE = 5 * MiB, WS_W1T = 8 * MiB, WS_WCO = 28 * MiB, WS_WAO = 30 * MiB, WS_WO = 31 * MiB,
                 WS_U = 36 * MiB, WS_ZC = 100 * MiB, WS_Q = 164 * MiB, WS_K = 260 * MiB, WS_V = 356 * MiB, WS_GA = 452 * MiB, WS_END = 484 * MiB;
constexpr size_t WS_MG = WS_U, WS_T = WS_K, WS_A2 = WS_V;
constexpr size_t DO_H = 0, DO_ZA = 64 * MiB, DO_GC = 96 * MiB;
constexpr int LDS_BYTES = 147456;
constexpr int REP_P0 = 1, REP_P1 = 1, REP_P3 = 1, REP_P4 = 1, REP_P5 = 1, REP_CONV = 1;
constexpr float QSCALE = 0.125f * 1.4426950408889634f;
constexpr float EPS = 1e-6f;

struct Params {
    const float *x, *c; const int* pos; const float *norm_g, *w_ada, *b_ada, *w_in, *conv_w, *conv_b, *ln_g, *ln_b, *w_co, *w_ao, *w_o, *final_g;
    float* out; unsigned char* ws;
    float f0, f1, f2, f3, f4, f5, f6, f7;
};

__device__ __forceinline__ unsigned pk2(float lo, float hi) { return pg8::cvt_pk_bf16(lo, hi); }
__device__ __forceinline__ float bflo(unsigned w) { return __uint_as_float(w << 16); }
__device__ __forceinline__ float bfhi(unsigned w) { return __uint_as_float(w & 0xffff0000u); }
__device__ __forceinline__ float sigm(float x) { return __builtin_amdgcn_rcpf(1.f + __expf(-x)); }
__device__ __forceinline__ float wave_sum(float v) {
#pragma unroll
    for (int o = 1; o < 64; o <<= 1) v += __shfl_xor(v, o);
    return v;
}
__device__ __forceinline__ u32x4 pack8(const f32x4 a, const f32x4 b) { u32x4 w; w.x = pk2(a[0], a[1]); w.y = pk2(a[2], a[3]); w.z = pk2(b[0], b[1]); w.w = pk2(b[2], b[3]); return w; }
__device__ __forceinline__ f32x4 sigm4(const f32x4 v) { return (f32x4){sigm(v[0]), sigm(v[1]), sigm(v[2]), sigm(v[3])}; }
__device__ __forceinline__ unsigned un8x4(const f32x4 s) {
    const unsigned a = (unsigned)(s[0] * 255.f + 0.5f), b = (unsigned)(s[1] * 255.f + 0.5f), c = (unsigned)(s[2] * 255.f + 0.5f), d = (unsigned)(s[3] * 255.f + 0.5f);
    return a | (b << 8) | (c << 16) | (d << 24);
}
__device__ __forceinline__ f32x4 deq8(unsigned w) { return (f32x4){(float)(w & 255u), (float)((w >> 8) & 255u), (float)((w >> 16) & 255u), (float)(w >> 24)} * (1.0f / 255.0f); }
__device__ __forceinline__ f32x4 bf4lo(unsigned w0, unsigned w1) { return (f32x4){bflo(w0), bfhi(w0), bflo(w1), bfhi(w1)}; }

__device__ __forceinline__ size_t qkv_off(int b, int g, int j, int t) { const int sh = 2 * g; return ((size_t)(((b * 3 + g) * 8 + j) * SEQ + ((t & ((1 << sh) - 1)) << (13 - sh)) + (t >> sh))) * 64; }

struct Epi1 {
    static constexpr bool PERM = true, AFTER_DRAIN = false;
    unsigned char *ws, *dout;
    __device__ __forceinline__ void operator()(const f32x4 (&acc)[2][2][4][2], const pg8::Unit& u, int wr, int wc, int fr, int fq) const {
        const int pn = u.pn, row0 = u.pm * 256 + wr * 64 + fr, cl = wc * 32 + 8 * fq;
        bf16_t* const U = (bf16_t*)(ws + WS_U); bf16_t* const ZC = (bf16_t*)(ws + WS_ZC); bf16_t* const Q = (bf16_t*)(ws + WS_Q); bf16_t* const K = (bf16_t*)(ws + WS_K); bf16_t* const V = (bf16_t*)(ws + WS_V);
        bf16_t* const ZA = (bf16_t*)(dout + DO_ZA); unsigned char* const GC8 = dout + DO_GC; unsigned char* const GA8 = ws + WS_GA; const float* const CS = (const float*)(ws + WS_CS);
        if (pn < 8) {
#pragma unroll
            for (int ai = 0; ai < 2; ++ai)
#pragma unroll
                for (int m = 0; m < 4; ++m) {
                    const size_t row = (size_t)(row0 + ai * 128 + m * 16);
                    const f32x4 a0 = acc[ai][0][m][0] * sigm4(acc[ai][1][m][0]), a1 = acc[ai][0][m][1] * sigm4(acc[ai][1][m][1]);
                    *(u32x4*)(U + row * 1024 + pn * 128 + cl) = pack8(a0, a1);
                }
        } else if (pn < 12 || pn == 30 || pn == 31) {
            bf16_t* base = pn < 12 ? ZC : ZA; const int pitch = pn < 12 ? 1024 : 512, col0 = (pn < 12 ? (pn - 8) : (pn - 30)) * 256 + cl;
#pragma unroll
            for (int ai = 0; ai < 2; ++ai)
#pragma unroll
                for (int m = 0; m < 4; ++m) {
                    const size_t row = (size_t)(row0 + ai * 128 + m * 16);
#pragma unroll
                    for (int bj = 0; bj < 2; ++bj) {
                        const f32x4 v0 = acc[ai][bj][m][0], v1 = acc[ai][bj][m][1];
                        *(u32x4*)(base + row * pitch + col0 + bj * 128) = pack8(v0 * sigm4(v0), v1 * sigm4(v1));
                    }
                }
        } else if (pn < 24) {
            const bool isq = pn < 18; bf16_t* base = isq ? Q : K; const int pl = pn - (isq ? 12 : 18), g = pl >> 1, dim0 = (wc & 1) * 32 + 8 * fq; const float sc = isq ? QSCALE : 1.0f;
            const bool rot = ((wc & 1) == 0) && (fq < 2);
#pragma unroll
            for (int ai = 0; ai < 2; ++ai)
#pragma unroll
                for (int m = 0; m < 4; ++m) {
                    const size_t row = (size_t)(row0 + ai * 128 + m * 16);
                    f32x4 cv = (f32x4){1.f, 1.f, 1.f, 1.f}, sv = (f32x4){0.f, 0.f, 0.f, 0.f};
                    if (rot) { cv = *(const f32x4*)(CS + row * 16 + 4 * fq); sv = *(const f32x4*)(CS + row * 16 + 8 + 4 * fq); }
#pragma unroll
                    for (int bj = 0; bj < 2; ++bj) {
                        const f32x4 v0 = acc[ai][bj][m][0], v1 = acc[ai][bj][m][1];
                        const f32x4 n0 = (v0 * cv - v1 * sv) * sc, n1 = (v1 * cv + v0 * sv) * sc;
                        *(u32x4*)(base + qkv_off((int)(row >> 13), g, (4 * pl + 2 * bj + (wc >> 1)) & 7, (int)(row & (SEQ - 1))) + dim0) = pack8(n0, n1);
                    }
                }
        } else if (pn < 30) {
            const int pl = pn - 24, g = pl >> 1, dim0 = (wc & 1) * 32 + 8 * fq;
#pragma unroll
            for (int ai = 0; ai < 2; ++ai)
#pragma unroll
                for (int m = 0; m < 4; ++m) {
                    const size_t row = (size_t)(row0 + ai * 128 + m * 16);
#pragma unroll
                    for (int bj = 0; bj < 2; ++bj) *(u32x4*)(V + qkv_off((int)(row >> 13), g, (4 * pl + 2 * bj + (wc >> 1)) & 7, (int)(row & (SEQ - 1))) + dim0) = pack8(acc[ai][bj][m][0], acc[ai][bj][m][1]);
                }
        } else {
            unsigned char* base = pn < 36 ? GC8 : GA8; const int col0 = (pn - (pn < 36 ? 32 : 36)) * 256 + cl;
#pragma unroll
            for (int ai = 0; ai < 2; ++ai)
#pragma unroll
                for (int m = 0; m < 4; ++m) {
                    const size_t row = (size_t)(row0 + ai * 128 + m * 16);
#pragma unroll
                    for (int bj = 0; bj < 2; ++bj) { u32x2 w; w.x = un8x4(sigm4(acc[ai][bj][m][0])); w.y = un8x4(sigm4(acc[ai][bj][m][1])); *(u32x2*)(base + row * 1024 + col0 + bj * 128) = w; }
                }
        }
    }
};
struct Epi3 {
    static constexpr bool PERM = true, AFTER_DRAIN = false;
    const unsigned char* GC8; bf16_t* T;
    __device__ __forceinline__ void operator()(const f32x4 (&acc)[2][2][4][2], const pg8::Unit& u, int wr, int wc, int fr, int fq) const {
        const int row0 = u.pm * 256 + wr * 64 + fr, col0 = u.pn * 256 + wc * 32 + 8 * fq;
#pragma unroll
        for (int ai = 0; ai < 2; ++ai)
#pragma unroll
            for (int m = 0; m < 4; ++m) {
                const size_t row = (size_t)(row0 + ai * 128 + m * 16);
#pragma unroll
                for (int bj = 0; bj < 2; ++bj) {
                    const u32x2 g = *(const u32x2*)(GC8 + row * 1024 + col0 + bj * 128);
                    *(u32x4*)(T + row * 1024 + col0 + bj * 128) = pack8(acc[ai][bj][m][0] * deq8(g.x), acc[ai][bj][m][1] * deq8(g.y));
                }
            }
    }
};
struct Epi4 {
    static constexpr bool PERM = true, AFTER_DRAIN = false;
    const unsigned char* GA8; const bf16_t* T; bf16_t* MG;
    __device__ __forceinline__ void operator()(const f32x4 (&acc)[2][2][4][2], const pg8::Unit& u, int wr, int wc, int fr, int fq) const {
        const int row0 = u.pm * 256 + wr * 64 + fr, col0 = u.pn * 256 + wc * 32 + 8 * fq;
#pragma unroll
        for (int ai = 0; ai < 2; ++ai)
#pragma unroll
            for (int m = 0; m < 4; ++m) {
                const size_t row = (size_t)(row0 + ai * 128 + m * 16);
#pragma unroll
                for (int bj = 0; bj < 2; ++bj) {
                    const u32x2 g = *(const u32x2*)(GA8 + row * 1024 + col0 + bj * 128);
                    const u32x4 t = *(const u32x4*)(T + row * 1024 + col0 + bj * 128);
                    *(u32x4*)(MG + row * 1024 + col0 + bj * 128) = pack8(bf4lo(t.x, t.y) + acc[ai][bj][m][0] * deq8(g.x), bf4lo(t.z, t.w) + acc[ai][bj][m][1] * deq8(g.y));
                }
            }
    }
};
struct Epi5 {
    static constexpr bool PERM = true, AFTER_DRAIN = false;
    const float* x; const float* MOD; float* out; float* SSQ;
    __device__ __forceinline__ void operator()(const f32x4 (&acc)[2][2][4][2], const pg8::Unit& u, int wr, int wc, int fr, int fq) const {
        const int row0 = u.pm * 256 + wr * 64 + fr, col0 = u.pn * 256 + wc * 32 + 8 * fq, b = u.pm >> 5;
        f32x4 gt[2][2];
#pragma unroll
        for (int bj = 0; bj < 2; ++bj) { gt[bj][0] = *(const f32x4*)(MOD + b * 3072 + 2048 + col0 + bj * 128); gt[bj][1] = *(const f32x4*)(MOD + b * 3072 + 2048 + col0 + bj * 128 + 4); }
#pragma unroll
        for (int ai = 0; ai < 2; ++ai)
#pragma unroll
            for (int m = 0; m < 4; ++m) {
                const size_t row = (size_t)(row0 + ai * 128 + m * 16);
                float ss = 0.f;
#pragma unroll
                for (int bj = 0; bj < 2; ++bj) {
                    const f32x4 xa = *(const f32x4*)(x + row * 1024 + col0 + bj * 128), xb = *(const f32x4*)(x + row * 1024 + col0 + bj * 128 + 4);
                    const f32x4 o0 = xa + gt[bj][0] * acc[ai][bj][m][0], o1 = xb + gt[bj][1] * acc[ai][bj][m][1];
                    *(f32x4*)(out + row * 1024 + col0 + bj * 128) = o0; *(f32x4*)(out + row * 1024 + col0 + bj * 128 + 4) = o1;
                    ss += (o0[0] * o0[0] + o0[1] * o0[1]) + (o0[2] * o0[2] + o0[3] * o0[3]) + (o1[0] * o1[0] + o1[1] * o1[1]) + (o1[2] * o1[2] + o1[3] * o1[3]);
                }
                ss += __shfl_xor(ss, 16); ss += __shfl_xor(ss, 32);
                if (fq == 0) SSQ[row * 16 + u.pn * 4 + wc] = ss;
            }
    }
};

__device__ __forceinline__ int src_col(int n) {
    const int tile = n >> 8, loc = n & 255;
    if (tile < 8) return (loc < 128) ? tile * 128 + loc : 1024 + tile * 128 + (loc - 128);
    if (tile >= 12 && tile < 24) { const int p = loc & 63; if (p < 16) return (n & ~63) + (p & 3) + ((p >> 2) & 1) * 8 + ((p >> 3) & 1) * 4; }
    return n;
}
template <bool PERMUTE>
__device__ __forceinline__ void transpose_item(const float* W, int K, int N, bf16_t* WT, LAS float* scr, int item, int lane) {
    const int nblk = N / 32, kb = item / nblk, nb = item % nblk, k0 = 64 * kb, n0 = 32 * nb;
    const int sn = PERMUTE ? src_col(n0 + (lane & 31)) : n0 + (lane & 31);
#pragma unroll 8
    for (int i = 0; i < 32; ++i) { const int kk = 2 * i + (lane >> 5); scr[kk * 33 + (lane & 31)] = W[(size_t)(k0 + kk) * N + sn]; }
    asm volatile("s_waitcnt lgkmcnt(0)" ::: "memory");
    const int c = lane & 7;
#pragma unroll
    for (int j = 0; j < 4; ++j) { const int n = (lane >> 3) + 8 * j; const LAS float* s = scr + (8 * c) * 33 + n;
        u32x4 o; o.x = pk2(s[0 * 33], s[1 * 33]); o.y = pk2(s[2 * 33], s[3 * 33]); o.z = pk2(s[4 * 33], s[5 * 33]); o.w = pk2(s[6 * 33], s[7 * 33]);
        *(u32x4*)(WT + (size_t)(n0 + n) * K + k0 + 8 * c) = o; }
    asm volatile("s_waitcnt lgkmcnt(0)" ::: "memory");
}

__device__ __forceinline__ void conv_oct(const f32x2 (&u)[38], const f32x2 (&w)[31], const f32x2 bias, LAS f32x2* acc) {
#pragma unroll
    for (int tt = 0; tt < 8; ++tt) {
        f32x2 a = bias;
#pragma unroll
        for (int k = 0; k < 31; ++k) a += w[k] * u[tt + k];
        acc[tt * 512] = a;
    }
}
__device__ __forceinline__ void conv_slide(f32x2 (&u)[38], const unsigned* up) {
    unsigned nw[8];
#pragma unroll
    for (int i = 0; i < 8; ++i) nw[i] = up[(long)i * 512];
#pragma unroll
    for (int i = 0; i < 30; ++i) u[i] = u[i + 8];
#pragma unroll
    for (int i = 0; i < 8; ++i) u[30 + i] = (f32x2){bflo(nw[i]), bfhi(nw[i])};
}
__device__ __forceinline__ void conv_item(const Params& p, LAS unsigned char* lds, int it, int tid) {
    const bf16_t* U = (const bf16_t*)(p.ws + WS_U); bf16_t* ZC = (bf16_t*)(p.ws + WS_ZC);
    const int row0 = it * 32, s0 = row0 & (SEQ - 1), c = 2 * tid;
    f32x2 w[31];
#pragma unroll
    for (int k = 0; k < 31; ++k) w[k] = *(const f32x2*)(p.conv_w + k * 1024 + c);
    const f32x2 bias = *(const f32x2*)(p.conv_b + c);
    const unsigned* up = (const unsigned*)(U + ((long)row0 - 30) * 1024 + c);
    f32x2 u[38];
    {
        unsigned raw[38];
#pragma unroll
        for (int s = 0; s < 30; ++s) raw[s] = 0u;
        if (s0 > 0) {
#pragma unroll
            for (int s = 0; s < 30; ++s) raw[s] = up[(long)s * 512];
        }
#pragma unroll
        for (int s = 30; s < 38; ++s) raw[s] = up[(long)s * 512];
#pragma unroll
        for (int s = 0; s < 38; ++s) u[s] = (f32x2){bflo(raw[s]), bfhi(raw[s])};
    }
    LAS f32x2* red = (LAS f32x2*)lds;
    LAS f32x2* stats = (LAS f32x2*)(lds + 131072);
    conv_oct(u, w, bias, red + tid);
    conv_slide(u, up + 38L * 512); conv_oct(u, w, bias, red + 8 * 512 + tid);
    conv_slide(u, up + 46L * 512); conv_oct(u, w, bias, red + 16 * 512 + tid);
    conv_slide(u, up + 54L * 512); conv_oct(u, w, bias, red + 24 * 512 + tid);
    __syncthreads();
    {
        const int t = tid >> 4, part = tid & 15; float s1 = 0.f, s2 = 0.f;
#pragma unroll 8
        for (int i = 0; i < 32; ++i) { const f32x2 v = red[t * 512 + part + 16 * i]; s1 += v.x + v.y; s2 += v.x * v.x + v.y * v.y; }
#pragma unroll
        for (int o = 1; o < 16; o <<= 1) { s1 += __shfl_xor(s1, o); s2 += __shfl_xor(s2, o); }
        if (part == 0) { const float mean = s1 * (1.f / 1024.f); const float var = fmaxf(s2 * (1.f / 1024.f) - mean * mean, 0.f); stats[t] = (f32x2){mean, 1.0f / sqrtf(var + EPS)}; }
    }
    __syncthreads();
    const f32x2 g2 = *(const f32x2*)(p.ln_g + c), b2 = *(const f32x2*)(p.ln_b + c);
    unsigned* zp = (unsigned*)(ZC + (size_t)row0 * 1024 + c);
#pragma unroll
    for (int t = 0; t < 32; ++t) {
        const f32x2 st = stats[t], av = red[t * 512 + tid];
        float y0 = (av.x - st.x) * st.y * g2.x + b2.x, y1 = (av.y - st.x) * st.y * g2.y + b2.y;
        y0 *= sigm(y0); y1 *= sigm(y1);
        const unsigned z = zp[(size_t)t * 512];
        zp[(size_t)t * 512] = pk2(y0 * bflo(z), y1 * bfhi(z));
    }
    __syncthreads();
}

typedef short v4i16_t __attribute__((ext_vector_type(4)));
__device__ __forceinline__ s16x4 vtr(const LAS unsigned char* p) { return __builtin_bit_cast(s16x4, __builtin_amdgcn_ds_read_tr16_b64_v4i16((LAS v4i16_t*)p)); }
constexpr int KV_ROWB = 160, LDS_VOFF = 256 * KV_ROWB;
__device__ __forceinline__ void attn_item(const Params& p, LAS unsigned char* lds, int idx, int tid, int lane, int w) {
    bf16_t* Q = (bf16_t*)(p.ws + WS_Q); const bf16_t* K = (const bf16_t*)(p.ws + WS_K); const bf16_t* V = (const bf16_t*)(p.ws + WS_V); float* LSE = (float*)(p.ws + WS_LSE);
    const int q64 = idx & 63; int rest = idx >> 6; const int j = rest & 7; rest >>= 3; const int g = rest % 3, b = rest / 3;
    const int sh = 2 * g, d = 1 << sh, nbm = (64 >> sh) - 1, r = q64 >> (6 - sh), n = q64 & nbm;
    const size_t sub = ((size_t)(((b * 3 + g) * 8 + j) * SEQ) + ((size_t)r << (13 - sh))) * 64;
    {
        const int nprev = n > 0 ? n - 1 : n;
        const size_t rp = sub + (size_t)nprev * 8192 + tid * 8, rc = sub + (size_t)n * 8192 + tid * 8;
        const u32x4 k0 = *(const u32x4*)(K + rp), k1 = *(const u32x4*)(K + rp + 4096), k2 = *(const u32x4*)(K + rc), k3 = *(const u32x4*)(K + rc + 4096);
        const u32x4 v0 = *(const u32x4*)(V + rp), v1 = *(const u32x4*)(V + rp + 4096), v2 = *(const u32x4*)(V + rc), v3 = *(const u32x4*)(V + rc + 4096);
        __syncthreads();
        LAS unsigned char* dp = lds + (tid >> 3) * KV_ROWB + (tid & 7) * 16; LAS unsigned char* dc = dp + 128 * KV_ROWB;
        *(LAS u32x4*)(dp) = k0; *(LAS u32x4*)(dp + 64 * KV_ROWB) = k1; *(LAS u32x4*)(dc) = k2; *(LAS u32x4*)(dc + 64 * KV_ROWB) = k3;
        *(LAS u32x4*)(dp + LDS_VOFF) = v0; *(LAS u32x4*)(dp + LDS_VOFF + 64 * KV_ROWB) = v1; *(LAS u32x4*)(dc + LDS_VOFF) = v2; *(LAS u32x4*)(dc + LDS_VOFF + 64 * KV_ROWB) = v3;
        __syncthreads();
    }
    const int fr = lane & 15, fq = lane >> 4;
    const size_t qrow = (size_t)b * SEQ + (size_t)(n * 128 + 16 * w + fr) * d + r;
    bf16_t* qptr = Q + sub + (size_t)(n * 128 + 16 * w + fr) * 64;
    const bf16x8 qf0 = *(const bf16x8*)(qptr + 8 * fq), qf1 = *(const bf16x8*)(qptr + 32 + 8 * fq);
    f32x4 s[9];
#pragma unroll
    for (int tp = 0; tp < 9; ++tp) {
        const LAS unsigned char* kb = lds + (16 * (w + tp) + fr) * KV_ROWB + fq * 16;
        const bf16x8 ka = *(const LAS bf16x8*)kb, kc = *(const LAS bf16x8*)(kb + 64);
        f32x4 z = (f32x4){0.f, 0.f, 0.f, 0.f};
        z = __builtin_amdgcn_mfma_f32_16x16x32_bf16(ka, qf0, z, 0, 0, 0);
        s[tp] = __builtin_amdgcn_mfma_f32_16x16x32_bf16(kc, qf1, z, 0, 0, 0);
    }
    const float NEG = -1e30f;
#pragma unroll
    for (int jj = 0; jj < 4; ++jj) { const int key = 4 * fq + jj; if (key < fr) s[0][jj] = NEG; if (key > fr) s[8][jj] = NEG; }
    if (n == 0) {
#pragma unroll
        for (int tp = 0; tp < 8; ++tp) if (w + tp < 8) s[tp] = (f32x4){NEG, NEG, NEG, NEG};
    }
    float mx = NEG;
#pragma unroll
    for (int tp = 0; tp < 9; ++tp) mx = fmaxf(fmaxf(mx, fmaxf(s[tp][0], s[tp][1])), fmaxf(s[tp][2], s[tp][3]));
    mx = fmaxf(mx, __shfl_xor(mx, 16)); mx = fmaxf(mx, __shfl_xor(mx, 32));
    float l = 0.f;
#pragma unroll
    for (int tp = 0; tp < 9; ++tp)
#pragma unroll
        for (int jj = 0; jj < 4; ++jj) { const float e = __builtin_amdgcn_exp2f(s[tp][jj] - mx); s[tp][jj] = e; l += e; }
    u32x4 pw[5];
#pragma unroll
    for (int kp = 0; kp < 4; ++kp) pw[kp] = pack8(s[2 * kp], s[2 * kp + 1]);
    pw[4] = pack8(s[8], (f32x4){0.f, 0.f, 0.f, 0.f});
    f32x4 ot[4];
#pragma unroll
    for (int dt = 0; dt < 4; ++dt) ot[dt] = (f32x4){0.f, 0.f, 0.f, 0.f};
    const LAS unsigned char* vbase = lds + LDS_VOFF + (16 * w + 4 * fq + (fr >> 2)) * KV_ROWB + (fr & 3) * 8;
#pragma unroll
    for (int kp = 0; kp < 5; ++kp)
#pragma unroll
        for (int dt = 0; dt < 4; ++dt) {
            const s16x4 lo = vtr(vbase + (2 * kp) * 16 * KV_ROWB + dt * 32);
            s16x4 hi = (s16x4){0, 0, 0, 0};
            if (kp < 4) hi = vtr(vbase + (2 * kp + 1) * 16 * KV_ROWB + dt * 32);
            const bf16x8 a = (bf16x8){lo[0], lo[1], lo[2], lo[3], hi[0], hi[1], hi[2], hi[3]};
            ot[dt] = __builtin_amdgcn_mfma_f32_16x16x32_bf16(a, __builtin_bit_cast(bf16x8, pw[kp]), ot[dt], 0, 0, 0);
        }
    l += __shfl_xor(l, 16); l += __shfl_xor(l, 32);
    const float inv = 1.0f / l;
#pragma unroll
    for (int dt = 0; dt < 4; ++dt) { u32x2 o; o.x = pk2(ot[dt][0] * inv, ot[dt][1] * inv); o.y = pk2(ot[dt][2] * inv, ot[dt][3] * inv); *(u32x2*)(qptr + 16 * dt + 4 * fq) = o; }
    if (fq == 0) LSE[((size_t)g * M + qrow) * 8 + j] = mx + __log2f(l);
}

__global__ void __launch_bounds__(512, 2) fwd_megakernel(Params p) {
    extern __shared__ __attribute__((aligned(16))) unsigned char lds_raw[];
    LAS unsigned char* lds = (LAS unsigned char*)lds_raw;
    cg::grid_group grid = cg::this_grid();
    int tid, lane, wave, gw;
#define RELANE() do { int t_ = threadIdx.x; asm volatile("" : "+v"(t_)); tid = t_; lane = tid & 63; wave = __builtin_amdgcn_readfirstlane(tid >> 6); gw = bid * 8 + wave; } while (0)
    const int G = gridDim.x, bid = blockIdx.x, NGW = G * 8;
    RELANE();
    unsigned char* ws = p.ws; unsigned char* dout = (unsigned char*)p.out;
    float* MOD = (float*)(ws + WS_MOD); float* CS = (float*)(ws + WS_CS); float* SSQ = (float*)(ws + WS_SSQ);
    bf16_t* W1T = (bf16_t*)(ws + WS_W1T); bf16_t* WCO = (bf16_t*)(ws + WS_WCO); bf16_t* WAO = (bf16_t*)(ws + WS_WAO); bf16_t* WO = (bf16_t*)(ws + WS_WO);
    bf16_t* H = (bf16_t*)(dout + DO_H); bf16_t* ZA = (bf16_t*)(dout + DO_ZA); unsigned char* GC8 = dout + DO_GC;

    for (int rep0 = 0; rep0 < REP_P0; ++rep0) {
    for (int it = bid; it < 96; it += G) {
        const int n0 = it * 32, col = tid & 31, ks = tid >> 5;
        float a0 = 0.f, a1 = 0.f, a2 = 0.f, a3 = 0.f;
        const float* wp = p.w_ada + (size_t)(ks * 64) * 3072 + n0 + col; const float* cc = p.c + ks * 64;
#pragma unroll 8
        for (int k = 0; k < 64; ++k) { const float wv = wp[(size_t)k * 3072]; a0 += cc[k] * wv; a1 += cc[1024 + k] * wv; a2 += cc[2048 + k] * wv; a3 += cc[3072 + k] * wv; }
        LAS float* red = (LAS float*)lds;
        red[(ks * 4 + 0) * 32 + col] = a0; red[(ks * 4 + 1) * 32 + col] = a1; red[(ks * 4 + 2) * 32 + col] = a2; red[(ks * 4 + 3) * 32 + col] = a3;
        __syncthreads();
        if (tid < 128) { const int b = tid >> 5; float sum = p.b_ada[n0 + col];
#pragma unroll
            for (int k2 = 0; k2 < 16; ++k2) sum += red[(k2 * 4 + b) * 32 + col];
            MOD[b * 3072 + n0 + col] = sum; }
        __syncthreads();
    }
    {
        LAS float* scr = (LAS float*)(lds + wave * 16384);
        constexpr int I1 = 16 * 320, I2 = 16 * 32, I3 = 8 * 32, I4 = 16 * 32;
        for (int it = gw; it < I1 + I2 + I3 + I4; it += NGW) {
            int r = it;
            if (r < I1) { transpose_item<true>(p.w_in, 1024, NIN, W1T, scr, r, lane); continue; } r -= I1;
            if (r < I2) { transpose_item<false>(p.w_co, 1024, 1024, WCO, scr, r, lane); continue; } r -= I2;
            if (r < I3) { transpose_item<false>(p.w_ao, 512, 1024, WAO, scr, r, lane); continue; } r -= I3;
            transpose_item<false>(p.w_o, 1024, 1024, WO, scr, r, lane);
        }
    }
    for (int e = bid * 512 + tid; e < M * 8; e += G * 512) {
        const int row = e >> 3, i = e & 7;
        const float fi = i == 0 ? p.f0 : i == 1 ? p.f1 : i == 2 ? p.f2 : i == 3 ? p.f3 : i == 4 ? p.f4 : i == 5 ? p.f5 : i == 6 ? p.f6 : p.f7;
        const float ang = (float)p.pos[row] * fi;
        const double rev = (double)ang * 0.15915494309189535; const float frac = (float)(rev - __builtin_rint(rev));
        CS[row * 16 + i] = __builtin_amdgcn_cosf(frac); CS[row * 16 + 8 + i] = __builtin_amdgcn_sinf(frac);
    }
    grid.sync(); RELANE();

    for (int row = gw; row < M; row += NGW) {
        const f32x4* xr = (const f32x4*)(p.x + (size_t)row * 1024) + lane; f32x4 v[4]; float ss = 0.f;
#pragma unroll
        for (int jx = 0; jx < 4; ++jx) { v[jx] = xr[64 * jx]; ss += (v[jx][0] * v[jx][0] + v[jx][1] * v[jx][1]) + (v[jx][2] * v[jx][2] + v[jx][3] * v[jx][3]); }
        const float rstd = 1.0f / sqrtf(wave_sum(ss) * (1.f / 1024.f) + EPS);
        const float* mb = MOD + (row >> 13) * 3072;
#pragma unroll
        for (int jx = 0; jx < 4; ++jx) { const int col = 4 * lane + 256 * jx;
            const f32x4 gg = *(const f32x4*)(p.norm_g + col), scl = *(const f32x4*)(mb + 1024 + col), sft = *(const f32x4*)(mb + col);
            const f32x4 y = v[jx] * rstd * gg * (scl + 1.0f) + sft;
            u32x2 o; o.x = pk2(y[0], y[1]); o.y = pk2(y[2], y[3]); *(u32x2*)(H + (size_t)row * 1024 + col) = o; }
    }
    grid.sync(); RELANE();
    }

    for (int rep = 0; rep < REP_P1; ++rep) {
        pg8::Gemm g{H, W1T, M, NIN, 1024}; pg8::StaticOrder S; S.init(M, NIN, G, bid);
        Epi1 E{ws, dout};
        pg8::gemm_phase<Epi1, pg8::StaticOrder, true, true>(lds, g, S, E);
    }
    grid.sync(); RELANE();

    for (int it = bid; it < 1024 + 6144; it += G) {
        if (it < 1024) conv_item(p, lds, it, tid);
        else attn_item(p, lds, it - 1024, tid, lane, wave);
    }
    grid.sync(); RELANE();

    for (int rep = 0; rep < REP_P3; ++rep) {
        const bf16_t* OG = (const bf16_t*)(ws + WS_Q); const float* LSE = (const float*)(ws + WS_LSE); bf16_t* A2 = (bf16_t*)(ws + WS_A2);
        for (int e = bid * 512 + tid; e < M * 64; e += G * 512) {
            const size_t row = (size_t)(e >> 6); const int jc = e & 63, j = jc >> 3;
            const float l0 = LSE[row * 8 + j], l1 = LSE[((size_t)M + row) * 8 + j], l2 = LSE[((size_t)2 * M + row) * 8 + j];
            const float mxl = fmaxf(l0, fmaxf(l1, l2));
            float w0 = __builtin_amdgcn_exp2f(l0 - mxl), w1 = __builtin_amdgcn_exp2f(l1 - mxl), w2 = __builtin_amdgcn_exp2f(l2 - mxl);
            const float inv = 1.0f / (w0 + w1 + w2); w0 *= inv; w1 *= inv; w2 *= inv;
            const int bb = (int)(row >> 13), tt = (int)(row & (SEQ - 1)), c8 = (jc & 7) * 8;
            const u32x4 o0 = *(const u32x4*)(OG + qkv_off(bb, 0, j, tt) + c8), o1 = *(const u32x4*)(OG + qkv_off(bb, 1, j, tt) + c8), o2 = *(const u32x4*)(OG + qkv_off(bb, 2, j, tt) + c8);
            const u32x4 za = *(const u32x4*)(ZA + row * 512 + jc * 8);
            u32x4 o;
#pragma unroll
            for (int q = 0; q < 4; ++q) {
                const float lo = (w0 * bflo(o0[q]) + w1 * bflo(o1[q]) + w2 * bflo(o2[q])) * bflo(za[q]);
                const float hi = (w0 * bfhi(o0[q]) + w1 * bfhi(o1[q]) + w2 * bfhi(o2[q])) * bfhi(za[q]);
                o[q] = pk2(lo, hi);
            }
            *(u32x4*)(A2 + row * 512 + jc * 8) = o;
        }
        pg8::Gemm g{(const bf16_t*)(ws + WS_ZC), WCO, M, 1024, 1024}; pg8::StaticOrder S; S.init(M, 1024, G, bid);
        Epi3 E{GC8, (bf16_t*)(ws + WS_T)};
        pg8::gemm_phase<Epi3, pg8::StaticOrder, true, true>(lds, g, S, E);
    }
    grid.sync(); RELANE();

    for (int rep = 0; rep < REP_P4; ++rep) {
        pg8::Gemm g{(const bf16_t*)(ws + WS_A2), WAO, M, 1024, 512}; pg8::StaticOrder S; S.init(M, 1024, G, bid);
        Epi4 E{ws + WS_GA, (const bf16_t*)(ws + WS_T), (bf16_t*)(ws + WS_MG)};
        pg8::gemm_phase<Epi4, pg8::StaticOrder, true, true>(lds, g, S, E);
    }
    grid.sync(); RELANE();

    for (int rep = 0; rep < REP_P5; ++rep) {
        pg8::Gemm g{(const bf16_t*)(ws + WS_MG), WO, M, 1024, 1024}; pg8::StaticOrder S; S.init(M, 1024, G, bid);
        Epi5 E{p.x, MOD, p.out, SSQ};
        pg8::gemm_phase<Epi5, pg8::StaticOrder, true, true>(lds, g, S, E);
    }
    grid.sync(); RELANE();

    for (int row = gw; row < M; row += NGW) {
        const float part = lane < 16 ? SSQ[(size_t)row * 16 + lane] : 0.f;
        const float rstd = 1.0f / sqrtf(wave_sum(part) * (1.f / 1024.f) + EPS);
        f32x4* orow = (f32x4*)(p.out + (size_t)row * 1024) + lane;
#pragma unroll
        for (int jx = 0; jx < 4; ++jx) { const f32x4 fg = *((const f32x4*)p.final_g + lane + 64 * jx); orow[64 * jx] = orow[64 * jx] * rstd * fg; }
    }
}

extern "C" void kernel_launch(void* const* d_in, const int* in_sizes, int n_in, void* d_out, int out_size, void* d_ws, size_t ws_size, hipStream_t stream) {
    static int grid = 0;
    if (grid == 0) {
        if (n_in != 15 || out_size != M * DM || ws_size < WS_END) { fprintf(stderr, "kernel_launch: unexpected sizes (n_in %d, out %d, ws %zu)\n", n_in, out_size, ws_size); grid = -1; return; }
        int dev = 0, cus = 0, per_cu = 0;
        (void)hipGetDevice(&dev); (void)hipDeviceGetAttribute(&cus, hipDeviceAttributeMultiprocessorCount, dev);
        (void)hipFuncSetAttribute((const void*)fwd_megakernel, hipFuncAttributeMaxDynamicSharedMemorySize, LDS_BYTES);
        if (hipOccupancyMaxActiveBlocksPerMultiprocessor(&per_cu, (const void*)fwd_megakernel, 512, LDS_BYTES) != hipSuccess || per_cu < 1) per_cu = 1;
        (void)hipGetLastError();
        grid = cus * per_cu;
    }
    if (grid < 0) return;
    Params p{};
    p.x = (const float*)d_in[0]; p.c = (const float*)d_in[1]; p.pos = (const int*)d_in[2]; p.norm_g = (const float*)d_in[3]; p.w_ada = (const float*)d_in[4]; p.b_ada = (const float*)d_in[5];
    p.w_in = (const float*)d_in[6]; p.conv_w = (const float*)d_in[7]; p.conv_b = (const float*)d_in[8]; p.ln_g = (const float*)d_in[9]; p.ln_b = (const float*)d_in[10];
    p.w_co = (const float*)d_in[11]; p.w_ao = (const float*)d_in[12]; p.w_o = (const float*)d_in[13]; p.final_g = (const float*)d_in[14];
    p.out = (float*)d_out; p.ws = (unsigned char*)d_ws;
    p.f0 = 1.0f; p.f1 = 1.939227432e-01f; p.f2 = 3.760603070e-02f; p.f3 = 7.292664610e-03f; p.f4 = 1.414213562e-03f; p.f5 = 2.742481884e-04f; p.f6 = 5.318295734e-05f; p.f7 = 1.031338525e-05f;
    void* args[] = {&p};
    const hipError_t e = hipLaunchCooperativeKernel((const void*)fwd_megakernel, dim3(grid), dim3(512), args, LDS_BYTES, stream);
    if (e != hipSuccess) fprintf(stderr, "cooperative launch failed: %s (grid %d)\n", hipGetErrorString(e), grid);
}
```

```cpp
#include <hip/hip_runtime.h>
#include <hip/hip_cooperative_groups.h>
#include <cstdio>
#include <cstdint>
namespace cg = cooperative_groups;
#define LAS __attribute__((address_space(3)))
namespace pg8 {
#define PG8_LAS __attribute__((address_space(3)))
typedef unsigned short bf16_t;
typedef short bf16x8 __attribute__((ext_vector_type(8)));
typedef float f32x4 __attribute__((ext_vector_type(4)));
typedef unsigned u32x4 __attribute__((ext_vector_type(4)));
constexpr int BM = 256, BK = 64, HALF = 128, HTB = HALF * BK * 2  , STAGE_BYTES = 8 * HTB, NXCD = 8, WGM = 8;

__host__ __device__ __forceinline__ int lds_byte(int r, int c) { const int st = (r >> 4) * 2 + (c >> 5), rr = r & 15, cc = c & 31, ob = rr * 64 + cc * 2; return st * 1024 + (ob ^ (((ob >> 9) & 1) << 5)); }
__host__ __device__ __forceinline__ void stage_rc(int b, int& R, int& C) { const int st = b / 1024, sb = b % 1024, swz = sb ^ (((sb >> 9) & 1) << 5); R = (st >> 1) * 16 + swz / 64; C = (st & 1) * 32 + (swz % 64) / 2; }
__host__ __device__ __forceinline__ int perm32(int rho) { const int n = rho >> 4, i = rho & 15; return 8 * (i >> 2) + 4 * n + (i & 3); }

struct Unit { int pm, pn; };
struct Gemm { const bf16_t* A; const bf16_t* Bt; int M, N, K; };

struct StaticOrder {
    int nM, nN, nwg, G, c;
    __host__ __device__ void init(int M, int N, int G_, int c_) { nM = M / BM; nN = N / BM; nwg = nM * nN; G = G_; c = c_; }
    __host__ __device__ bool next(int i, Unit& u) const {
        const long L = (long)i * G + c; if (L >= nwg) return false;
        int wgid = (int)L; { const int q = nwg / NXCD, r = nwg % NXCD, xcd = wgid % NXCD, off = wgid / NXCD; wgid = (xcd < r ? xcd * (q + 1) : r * (q + 1) + (xcd - r) * q) + off; }
        const int nig = WGM * nN, gid = wgid / nig, fm = gid * WGM, gsz = (nM - fm) < WGM ? (nM - fm) : WGM;
        u.pm = fm + ((wgid % nig) % gsz); u.pn = (wgid % nig) / gsz; return true;
    }
    __device__ __forceinline__ void a_ready(const Unit&) const {}
    __device__ __forceinline__ void done(const Unit&) const {}
};

__device__ __forceinline__ unsigned cvt_pk_bf16(float lo, float hi) { unsigned r; asm volatile("v_cvt_pk_bf16_f32 %0, %1, %2" : "=v"(r) : "v"(lo), "v"(hi)); return r; }
typedef float f32x2 __attribute__((ext_vector_type(2)));
template <class Epi, class Sched, bool ALIGN_EPI = false, bool SP2 = false>
__device__ __forceinline__ void gemm_phase(PG8_LAS unsigned char* lds, const Gemm g, const Sched& S, const Epi& E) {
    int tid_ = threadIdx.x; asm volatile("" : "+v"(tid_));
    const int tid = tid_, wid = __builtin_amdgcn_readfirstlane(tid >> 6), lane = tid & 63, wr = wid >> 2, wc = wid & 3, fr = lane & 15, fq = lane >> 4;
    const int K = g.K, nt = K / BK;
    unsigned voffA[2], voffB[2];
#pragma unroll
    for (int i = 0; i < 2; ++i) { int R, C; stage_rc(tid * 16 + i * 8192, R, C); const int Rb = Epi::PERM ? ((R & ~31) + perm32(R & 31)) : R;
        voffA[i] = (unsigned)(R * K + C) * 2u; voffB[i] = (unsigned)(Rb * K + C) * 2u; }
    const size_t kstep = (size_t)(BK * 2);
    const size_t hstep = (size_t)HALF * K * 2;
    const size_t tstep = 2 * hstep;
    const unsigned ldsw = (unsigned)wid * 1024u;
    const int aoff = lds_byte(wr * 64 + fr, fq * 8), boff = lds_byte(wc * 32 + fr, fq * 8);
#define PG8_SA(b, h) (((b) * 2 + (h)) * HTB)
#define PG8_SB(b, h) ((4 + (b) * 2 + (h)) * HTB)
#define PG8_STAGE(bufoff, gbase, voff) do { _Pragma("unroll") for (int _i = 0; _i < 2; ++_i) \
        __builtin_amdgcn_global_load_lds((const unsigned*)((const char*)(gbase) + (voff)[_i]), (PG8_LAS unsigned*)(lds + (bufoff) + ldsw + _i * 8192), 16, 0, 0); } while (0)
#define PG8_LDA(dst, b, h) do { _Pragma("unroll") for (int m = 0; m < 4; ++m) _Pragma("unroll") for (int k = 0; k < 2; ++k) dst[m][k] = *(const PG8_LAS bf16x8*)(lds + PG8_SA(b, h) + aoff + m * 2048 + k * 1024); } while (0)
#define PG8_LDB(dst, b, h) do { _Pragma("unroll") for (int n = 0; n < 2; ++n) _Pragma("unroll") for (int k = 0; k < 2; ++k) dst[n][k] = *(const PG8_LAS bf16x8*)(lds + PG8_SB(b, h) + boff + n * 2048 + k * 1024); } while (0)
#define PG8_MMA(ai, bj, At, Bt) do { __builtin_amdgcn_s_setprio(1); _Pragma("unroll") for (int m = 0; m < 4; ++m) _Pragma("unroll") for (int n = 0; n < 2; ++n) _Pragma("unroll") for (int k = 0; k < 2; ++k) \
        acc[ai][bj][m][n] = __builtin_amdgcn_mfma_f32_16x16x32_bf16(Bt[n][k], At[m][k], acc[ai][bj][m][n], 0, 0, 0); __builtin_amdgcn_s_setprio(0); } while (0)
#define PG8_WAIT_V(n) asm volatile("s_waitcnt vmcnt(" #n ")" ::: "memory")
#define PG8_WAIT_L(n) asm volatile("s_waitcnt lgkmcnt(" #n ")" ::: "memory")
#define PG8_BAR __builtin_amdgcn_s_barrier()
#define PG8_SCHED __builtin_amdgcn_sched_barrier(0)
    Unit cur, nxt; int ui = 0;
    if (!S.next(0, cur)) return;
    f32x4 acc[2][2][4][2];
#pragma unroll
    for (int a = 0; a < 2; ++a)
#pragma unroll
        for (int b = 0; b < 2; ++b)
#pragma unroll
            for (int m = 0; m < 4; ++m)
#pragma unroll
                for (int n = 0; n < 2; ++n) acc[a][b][m][n] = (f32x4){0.f, 0.f, 0.f, 0.f};
    bf16x8 At[4][2], B0[2][2], B1[2][2];
    const char* cA = (const char*)g.A + (size_t)cur.pm * tstep; const char* cB = (const char*)g.Bt + (size_t)cur.pn * tstep;
    S.a_ready(cur);
    if constexpr (SP2) {
        PG8_STAGE(PG8_SB(0, 0), cB, voffB); PG8_STAGE(PG8_SB(0, 1), cB + hstep, voffB); PG8_STAGE(PG8_SA(0, 0), cA, voffA); PG8_STAGE(PG8_SA(0, 1), cA + hstep, voffA);
        if (wr == 1) PG8_BAR;
        PG8_WAIT_V(2); PG8_BAR;
        PG8_STAGE(PG8_SB(1, 0), cB + kstep, voffB); PG8_STAGE(PG8_SA(1, 0), cA + kstep, voffA); PG8_STAGE(PG8_SB(1, 1), cB + hstep + kstep, voffB);
        PG8_WAIT_V(6); PG8_BAR;
    } else {
        PG8_STAGE(PG8_SB(0, 0), cB, voffB); PG8_STAGE(PG8_SA(0, 0), cA, voffA); PG8_STAGE(PG8_SB(0, 1), cB + hstep, voffB); PG8_STAGE(PG8_SA(0, 1), cA + hstep, voffA);
        if (wr == 1) PG8_BAR;
        PG8_WAIT_V(4); PG8_BAR;
        PG8_STAGE(PG8_SB(1, 0), cB + kstep, voffB); PG8_STAGE(PG8_SA(1, 0), cA + kstep, voffA); PG8_STAGE(PG8_SB(1, 1), cB + hstep + kstep, voffB);
        PG8_WAIT_V(6); PG8_BAR;
    }
    for (;;) {
        const bool has_next = S.next(ui + 1, nxt);
        const char* nA = has_next ? (const char*)g.A + (size_t)nxt.pm * tstep : cA; const char* nB = has_next ? (const char*)g.Bt + (size_t)nxt.pn * tstep : cB;
        for (int t = 0; t < nt; t += 2) {
            const bool last = (t == nt - 2);
            const char* a1 = cA + (size_t)(t + 1) * kstep;
            const char* a2 = last ? nA : cA + (size_t)(t + 2) * kstep; const char* b2 = last ? nB : cB + (size_t)(t + 2) * kstep;
            const char* a3 = a2 + kstep; const char* b3 = b2 + kstep;
            if (last && has_next) S.a_ready(nxt);
            if constexpr (SP2) {
            PG8_LDB(B0, 0, 0); PG8_LDB(B1, 0, 1); PG8_SCHED; PG8_LDA(At, 0, 0); PG8_STAGE(PG8_SA(1, 1), a1 + hstep, voffA);
            PG8_WAIT_V(8); PG8_WAIT_L(0); PG8_BAR; PG8_MMA(0, 0, At, B0); PG8_MMA(0, 1, At, B1); PG8_BAR; PG8_SCHED;
            PG8_LDA(At, 0, 1); PG8_STAGE(PG8_SB(0, 0), b2, voffB); PG8_STAGE(PG8_SB(0, 1), b2 + hstep, voffB); PG8_STAGE(PG8_SA(0, 0), a2, voffA);
            PG8_WAIT_V(8); PG8_WAIT_L(0); PG8_BAR; PG8_MMA(1, 0, At, B0); PG8_MMA(1, 1, At, B1); PG8_BAR; PG8_SCHED;
            PG8_LDB(B0, 1, 0); PG8_LDB(B1, 1, 1); PG8_SCHED; PG8_LDA(At, 1, 0); PG8_STAGE(PG8_SA(0, 1), a2 + hstep, voffA);
            PG8_WAIT_V(8); PG8_WAIT_L(0); PG8_BAR; PG8_MMA(0, 0, At, B0); PG8_MMA(0, 1, At, B1); PG8_BAR; PG8_SCHED;
            PG8_LDA(At, 1, 1); PG8_STAGE(PG8_SB(1, 0), b3, voffB); PG8_STAGE(PG8_SB(1, 1), b3 + hstep, voffB); PG8_STAGE(PG8_SA(1, 0), a3, voffA);
            PG8_WAIT_V(8); PG8_WAIT_L(0); PG8_BAR; PG8_MMA(1, 0, At, B0); PG8_MMA(1, 1, At, B1); PG8_BAR; PG8_SCHED;
            } else {
            PG8_LDB(B0, 0, 0); PG8_SCHED; PG8_LDA(At, 0, 0); PG8_STAGE(PG8_SA(1, 1), a1 + hstep, voffA);
            PG8_WAIT_L(8); PG8_BAR; PG8_WAIT_L(0); PG8_MMA(0, 0, At, B0); PG8_BAR; PG8_SCHED;
            PG8_LDB(B1, 0, 1); PG8_STAGE(PG8_SB(0, 0), b2, voffB);
            PG8_BAR; PG8_WAIT_L(0); PG8_MMA(0, 1, At, B1); PG8_BAR;
            PG8_LDA(At, 0, 1); PG8_STAGE(PG8_SA(0, 0), a2, voffA);
            PG8_BAR; PG8_WAIT_L(0); PG8_MMA(1, 0, At, B0); PG8_BAR; PG8_SCHED;
            PG8_STAGE(PG8_SB(0, 1), b2 + hstep, voffB);
            PG8_WAIT_V(6); PG8_BAR; PG8_MMA(1, 1, At, B1); PG8_BAR;
            PG8_LDB(B0, 1, 0); PG8_SCHED; PG8_LDA(At, 1, 0); PG8_STAGE(PG8_SA(0, 1), a2 + hstep, voffA);
            PG8_WAIT_L(8); PG8_BAR; PG8_WAIT_L(0); PG8_MMA(0, 0, At, B0); PG8_BAR; PG8_SCHED;
            PG8_LDB(B1, 1, 1); PG8_STAGE(PG8_SB(1, 0), b3, voffB);
            PG8_BAR; PG8_WAIT_L(0); PG8_MMA(0, 1, At, B1); PG8_BAR;
            PG8_LDA(At, 1, 1); PG8_STAGE(PG8_SA(1, 0), a3, voffA);
            PG8_BAR; PG8_WAIT_L(0); PG8_MMA(1, 0, At, B0); PG8_BAR; PG8_SCHED;
            PG8_STAGE(PG8_SB(1, 1), b3 + hstep, voffB);
            PG8_WAIT_V(6); PG8_BAR; PG8_MMA(1, 1, At, B1); PG8_BAR;
            }
        }
        if constexpr (ALIGN_EPI) { if (wr == 0) PG8_BAR; }
        if constexpr (!Epi::AFTER_DRAIN) { E(acc, cur, wr, wc, fr, fq); S.done(cur); }
        if (!has_next) break;
#pragma unroll
        for (int a = 0; a < 2; ++a)
#pragma unroll
            for (int b = 0; b < 2; ++b)
#pragma unroll
                for (int m = 0; m < 4; ++m)
#pragma unroll
                    for (int n = 0; n < 2; ++n) acc[a][b][m][n] = (f32x4){0.f, 0.f, 0.f, 0.f};
        cur = nxt; cA = nA; cB = nB; ++ui;
        if constexpr (ALIGN_EPI) { if (wr == 1) PG8_BAR; }
    }
    PG8_WAIT_V(0);
    if constexpr (!ALIGN_EPI) { if (wr == 0) PG8_BAR; }
    PG8_BAR;
    if constexpr (Epi::AFTER_DRAIN) { E.fused(acc, cur, wr, wc, fr, fq, lds, wid, lane); S.done(cur); }
#undef PG8_SA
#undef PG8_SB
#undef PG8_STAGE
#undef PG8_LDA
#undef PG8_LDB
#undef PG8_MMA
#undef PG8_WAIT_V
#undef PG8_WAIT_L
#undef PG8_BAR
#undef PG8_SCHED
}
}
#define XB_TMO      128
#define XB_XCNT(j)  (256  + 64 * (j))
#define XB_XSUB(j)  (1280 + 64 * (j))
#define XB_XGEN(j)  (2304 + 64 * (j))
#define XB_TOP      3328
#define XB_TOPGEN   3392
#define XCD_BAR_WORDS 3456
#define XB_SPIN_CAP (1u << 18)

__device__ __forceinline__ unsigned xb_ld(unsigned* p)              { return __hip_atomic_load(p, __ATOMIC_RELAXED, __HIP_MEMORY_SCOPE_AGENT); }
__device__ __forceinline__ unsigned xb_add(unsigned* p, unsigned v) { return __hip_atomic_fetch_add(p, v, __ATOMIC_RELAXED, __HIP_MEMORY_SCOPE_AGENT); }
__device__ __forceinline__ unsigned xb_xcc_id() { return (unsigned)__builtin_amdgcn_s_getreg((3 << 11) | 20) & 0xFu; }
#define XB_SPIN(cond, bar) do { unsigned _sp = 0; while (cond) { __builtin_amdgcn_s_sleep(1); \
    if ((++_sp & 255u) == 0u) { if (xb_ld(&(bar)[XB_TMO])) break; if (_sp > XB_SPIN_CAP) { atomicAdd(&(bar)[XB_TMO], 1u); break; } } } } while (0)

struct XcdBarrier {
    unsigned* bar; unsigned x;
    volatile LAS unsigned* st;
};

__device__ __forceinline__ XcdBarrier xcd_barrier_post(unsigned* bar, volatile LAS unsigned* st) {
    XcdBarrier b; b.bar = bar; b.x = xb_xcc_id(); b.st = st;
    if (threadIdx.x == 0) (void)xb_add(&bar[XB_XCNT(b.x)], 1u);
    return b;
}
__device__ __forceinline__ void xcd_barrier_complete(unsigned* bar, unsigned x, unsigned& nloc, unsigned& nx) {
    const unsigned G = gridDim.x * gridDim.y * gridDim.z;
    unsigned sum, cnt, mine, sp = 0u;
    for (;;) {
        sum = 0u; cnt = 0u; mine = 0u;
#pragma unroll
        for (unsigned j = 0; j < 16; ++j) { const unsigned c = xb_ld(&bar[XB_XCNT(j)]); sum += c; cnt += (c > 0u) ? 1u : 0u; mine = (j == x) ? c : mine; }
        if (sum == G) break;
        __builtin_amdgcn_s_sleep(1);
        if ((++sp & 255u) == 0u) { if (xb_ld(&bar[XB_TMO])) break; if (sp > XB_SPIN_CAP) { atomicAdd(&bar[XB_TMO], 1u); break; } }
    }
    nloc = mine > 0u ? mine : 1u; nx = cnt > 0u ? cnt : 1u;
}

__device__ __forceinline__ void xcd_barrier(const XcdBarrier& b) {
    asm volatile("s_waitcnt vmcnt(0)" ::: "memory");
    __syncthreads();
    if (threadIdx.x == 0) {
        unsigned* bar = b.bar;
        __builtin_amdgcn_s_waitcnt(0);
        unsigned nloc = b.st[0], nx = b.st[1];
        if (nloc == 0u) { xcd_barrier_complete(bar, b.x, nloc, nx); b.st[0] = nloc; b.st[1] = nx; }
        const unsigned old = xb_add(&bar[XB_XSUB(b.x)], 1u);
        const unsigned gen = old / nloc;
        if (old + 1u == (gen + 1u) * nloc) {
            __builtin_amdgcn_fence(__ATOMIC_RELEASE, "agent");
            asm volatile("s_waitcnt vmcnt(0)" ::: "memory");
            const unsigned og = xb_add(&bar[XB_TOP], 1u);
            const unsigned tg = og / nx;
            if (og + 1u == (tg + 1u) * nx) xb_add(&bar[XB_TOPGEN], 1u);
            else XB_SPIN(xb_ld(&bar[XB_TOPGEN]) == tg, bar);
            __builtin_amdgcn_fence(__ATOMIC_ACQUIRE, "agent");
            xb_add(&bar[XB_XGEN(b.x)], 1u);
            asm volatile("s_waitcnt vmcnt(0)" ::: "memory");
        } else {
            XB_SPIN(xb_ld(&bar[XB_XGEN(b.x)]) == gen, bar);
            __builtin_amdgcn_fence(__ATOMIC_ACQUIRE, "agent");
            asm volatile("s_waitcnt vmcnt(0)" ::: "memory");
        }
    }
    __syncthreads();
}

typedef unsigned short bf16_t;
typedef short bf16x8 __attribute__((ext_vector_type(8)));
typedef short s16x4 __attribute__((ext_vector_type(4)));
typedef float f32x4 __attribute__((ext_vector_type(4)));
typedef unsigned u32x4 __attribute__((ext_vector_type(4)));
typedef unsigned u32x2 __attribute__((ext_vector_type(2)));
typedef float f32x2 __attribute__((ext_vector_type(2)));

constexpr int NB = 4, SEQ = 8192, DM = 1024, M = NB * SEQ, NIN = 10240, QP = 1536;
constexpr size_t MiB = 1u << 20;
constexpr size_t WS_BAR = 512 * 1024  , WS_MOD = 0, WS_CS = 1 * MiB, WS_SSQ = 3 * MiB, WS_LSE = 5 * MiB, WS_W1T = 8 * MiB, WS_WCO = 28 * MiB, WS_WAO = 30 * MiB, WS_WO = 31 * MiB,
                 WS_U = 36 * MiB, WS_ZC = 100 * MiB, WS_Q = 164 * MiB, WS_K = 260 * MiB, WS_V = 356 * MiB, WS_GA = 452 * MiB, WS_END = 484 * MiB;
constexpr size_t WS_MG = WS_U, WS_T = WS_K, WS_A2 = WS_V;
constexpr size_t DO_H = 0, DO_ZA = 64 * MiB, DO_GC = 96 * MiB;
constexpr int LDS_BYTES = 147456;
constexpr int REP_P0 = 1, REP_P1 = 1, REP_P3 = 1, REP_P4 = 1, REP_P5 = 1, REP_CONV = 1;
constexpr float QSCALE = 0.125f * 1.4426950408889634f;
constexpr float EPS = 1e-6f;

struct Params {
    const float *x, *c; const int* pos; const float *norm_g, *w_ada, *b_ada, *w_in, *conv_w, *conv_b, *ln_g, *ln_b, *w_co, *w_ao, *w_o, *final_g;
    float* out; unsigned char* ws;
    float f0, f1, f2, f3, f4, f5, f6, f7;
};

__device__ __forceinline__ unsigned pk2(float lo, float hi) { return pg8::cvt_pk_bf16(lo, hi); }
__device__ __forceinline__ float bflo(unsigned w) { return __uint_as_float(w << 16); }
__device__ __forceinline__ float bfhi(unsigned w) { return __uint_as_float(w & 0xffff0000u); }
__device__ __forceinline__ float sigm(float x) { return __builtin_amdgcn_rcpf(1.f + __expf(-x)); }
__device__ __forceinline__ float wave_sum(float v) {
#pragma unroll
    for (int o = 1; o < 64; o <<= 1) v += __shfl_xor(v, o);
    return v;
}
__device__ __forceinline__ u32x4 pack8(const f32x4 a, const f32x4 b) { u32x4 w; w.x = pk2(a[0], a[1]); w.y = pk2(a[2], a[3]); w.z = pk2(b[0], b[1]); w.w = pk2(b[2], b[3]); return w; }
__device__ __forceinline__ f32x4 sigm4(const f32x4 v) { return (f32x4){sigm(v[0]), sigm(v[1]), sigm(v[2]), sigm(v[3])}; }
__device__ __forceinline__ unsigned un8x4(const f32x4 s) {
    const unsigned a = (unsigned)(s[0] * 255.f + 0.5f), b = (unsigned)(s[1] * 255.f + 0.5f), c = (unsigned)(s[2] * 255.f + 0.5f), d = (unsigned)(s[3] * 255.f + 0.5f);
    return a | (b << 8) | (c << 16) | (d << 24);
}
__device__ __forceinline__ f32x4 deq8(unsigned w) { return (f32x4){(float)(w & 255u), (float)((w >> 8) & 255u), (float)((w >> 16) & 255u), (float)(w >> 24)} * (1.0f / 255.0f); }
__device__ __forceinline__ f32x4 bf4lo(unsigned w0, unsigned w1) { return (f32x4){bflo(w0), bfhi(w0), bflo(w1), bfhi(w1)}; }

__device__ __forceinline__ size_t qkv_off(int b, int g, int j, int t) { const int sh = 2 * g; return ((size_t)(((b * 3 + g) * 8 + j) * SEQ + ((t & ((1 << sh) - 1)) << (13 - sh)) + (t >> sh))) * 64; }

struct Epi1 {
    static constexpr bool PERM = true, AFTER_DRAIN = false;
    unsigned char *ws, *dout;
    __device__ __forceinline__ void operator()(const f32x4 (&acc)[2][2][4][2], const pg8::Unit& u, int wr, int wc, int fr, int fq) const {
        const int pn = u.pn, row0 = u.pm * 256 + wr * 64 + fr, cl = wc * 32 + 8 * fq;
        bf16_t* const U = (bf16_t*)(ws + WS_U); bf16_t* const ZC = (bf16_t*)(ws + WS_ZC); bf16_t* const Q = (bf16_t*)(ws + WS_Q); bf16_t* const K = (bf16_t*)(ws + WS_K); bf16_t* const V = (bf16_t*)(ws + WS_V);
        bf16_t* const ZA = (bf16_t*)(dout + DO_ZA); unsigned char* const GC8 = dout + DO_GC; unsigned char* const GA8 = ws + WS_GA; const float* const CS = (const float*)(ws + WS_CS);
        if (pn < 8) {
#pragma unroll
            for (int ai = 0; ai < 2; ++ai)
#pragma unroll
                for (int m = 0; m < 4; ++m) {
                    const size_t row = (size_t)(row0 + ai * 128 + m * 16);
                    const f32x4 a0 = acc[ai][0][m][0] * sigm4(acc[ai][1][m][0]), a1 = acc[ai][0][m][1] * sigm4(acc[ai][1][m][1]);
                    *(u32x4*)(U + row * 1024 + pn * 128 + cl) = pack8(a0, a1);
                }
        } else if (pn < 12 || pn == 30 || pn == 31) {
            bf16_t* base = pn < 12 ? ZC : ZA; const int pitch = pn < 12 ? 1024 : 512, col0 = (pn < 12 ? (pn - 8) : (pn - 30)) * 256 + cl;
#pragma unroll
            for (int ai = 0; ai < 2; ++ai)
#pragma unroll
                for (int m = 0; m < 4; ++m) {
                    const size_t row = (size_t)(row0 + ai * 128 + m * 16);
#pragma unroll
                    for (int bj = 0; bj < 2; ++bj) {
                        const f32x4 v0 = acc[ai][bj][m][0], v1 = acc[ai][bj][m][1];
                        *(u32x4*)(base + row * pitch + col0 + bj * 128) = pack8(v0 * sigm4(v0), v1 * sigm4(v1));
                    }
                }
        } else if (pn < 24) {
            const bool isq = pn < 18; bf16_t* base = isq ? Q : K; const int pl = pn - (isq ? 12 : 18), g = pl >> 1, dim0 = (wc & 1) * 32 + 8 * fq; const float sc = isq ? QSCALE : 1.0f;
            const bool rot = ((wc & 1) == 0) && (fq < 2);
#pragma unroll
            for (int ai = 0; ai < 2; ++ai)
#pragma unroll
                for (int m = 0; m < 4; ++m) {
                    const size_t row = (size_t)(row0 + ai * 128 + m * 16);
                    f32x4 cv = (f32x4){1.f, 1.f, 1.f, 1.f}, sv = (f32x4){0.f, 0.f, 0.f, 0.f};
                    if (rot) { cv = *(const f32x4*)(CS + row * 16 + 4 * fq); sv = *(const f32x4*)(CS + row * 16 + 8 + 4 * fq); }
#pragma unroll
                    for (int bj = 0; bj < 2; ++bj) {
                        const f32x4 v0 = acc[ai][bj][m][0], v1 = acc[ai][bj][m][1];
                        const f32x4 n0 = (v0 * cv - v1 * sv) * sc, n1 = (v1 * cv + v0 * sv) * sc;
                        *(u32x4*)(base + qkv_off((int)(row >> 13), g, (4 * pl + 2 * bj + (wc >> 1)) & 7, (int)(row & (SEQ - 1))) + dim0) = pack8(n0, n1);
                    }
                }
        } else if (pn < 30) {
            const int pl = pn - 24, g = pl >> 1, dim0 = (wc & 1) * 32 + 8 * fq;
#pragma unroll
            for (int ai = 0; ai < 2; ++ai)
#pragma unroll
                for (int m = 0; m < 4; ++m) {
                    const size_t row = (size_t)(row0 + ai * 128 + m * 16);
#pragma unroll
                    for (int bj = 0; bj < 2; ++bj) *(u32x4*)(V + qkv_off((int)(row >> 13), g, (4 * pl + 2 * bj + (wc >> 1)) & 7, (int)(row & (SEQ - 1))) + dim0) = pack8(acc[ai][bj][m][0], acc[ai][bj][m][1]);
                }
        } else {
            unsigned char* base = pn < 36 ? GC8 : GA8; const int col0 = (pn - (pn < 36 ? 32 : 36)) * 256 + cl;
#pragma unroll
            for (int ai = 0; ai < 2; ++ai)
#pragma unroll
                for (int m = 0; m < 4; ++m) {
                    const size_t row = (size_t)(row0 + ai * 128 + m * 16);
#pragma unroll
                    for (int bj = 0; bj < 2; ++bj) { u32x2 w; w.x = un8x4(sigm4(acc[ai][bj][m][0])); w.y = un8x4(sigm4(acc[ai][bj][m][1])); *(u32x2*)(base + row * 1024 + col0 + bj * 128) = w; }
                }
        }
    }
};
struct Epi3 {
    static constexpr bool PERM = true, AFTER_DRAIN = false;
    const unsigned char* GC8; bf16_t* T;
    __device__ __forceinline__ void operator()(const f32x4 (&acc)[2][2][4][2], const pg8::Unit& u, int wr, int wc, int fr, int fq) const {
        const int row0 = u.pm * 256 + wr * 64 + fr, col0 = u.pn * 256 + wc * 32 + 8 * fq;
#pragma unroll
        for (int ai = 0; ai < 2; ++ai)
#pragma unroll
            for (int m = 0; m < 4; ++m) {
                const size_t row = (size_t)(row0 + ai * 128 + m * 16);
#pragma unroll
                for (int bj = 0; bj < 2; ++bj) {
                    const u32x2 g = *(const u32x2*)(GC8 + row * 1024 + col0 + bj * 128);
                    *(u32x4*)(T + row * 1024 + col0 + bj * 128) = pack8(acc[ai][bj][m][0] * deq8(g.x), acc[ai][bj][m][1] * deq8(g.y));
                }
            }
    }
};
struct Epi4 {
    static constexpr bool PERM = true, AFTER_DRAIN = false;
    const unsigned char* GA8; const bf16_t* T; bf16_t* MG;
    __device__ __forceinline__ void operator()(const f32x4 (&acc)[2][2][4][2], const pg8::Unit& u, int wr, int wc, int fr, int fq) const {
        const int row0 = u.pm * 256 + wr * 64 + fr, col0 = u.pn * 256 + wc * 32 + 8 * fq;
#pragma unroll
        for (int ai = 0; ai < 2; ++ai)
#pragma unroll
            for (int m = 0; m < 4; ++m) {
                const size_t row = (size_t)(row0 + ai * 128 + m * 16);
#pragma unroll
                for (int bj = 0; bj < 2; ++bj) {
                    const u32x2 g = *(const u32x2*)(GA8 + row * 1024 + col0 + bj * 128);
                    const u32x4 t = *(const u32x4*)(T + row * 1024 + col0 + bj * 128);
                    *(u32x4*)(MG + row * 1024 + col0 + bj * 128) = pack8(bf4lo(t.x, t.y) + acc[ai][bj][m][0] * deq8(g.x), bf4lo(t.z, t.w) + acc[ai][bj][m][1] * deq8(g.y));
                }
            }
    }
};
struct Epi5 {
    static constexpr bool PERM = true, AFTER_DRAIN = false;
    const float* x; const float* MOD; float* out; float* SSQ;
    __device__ __forceinline__ void operator()(const f32x4 (&acc)[2][2][4][2], const pg8::Unit& u, int wr, int wc, int fr, int fq) const {
        const int row0 = u.pm * 256 + wr * 64 + fr, col0 = u.pn * 256 + wc * 32 + 8 * fq, b = u.pm >> 5;
        f32x4 gt[2][2];
#pragma unroll
        for (int bj = 0; bj < 2; ++bj) { gt[bj][0] = *(const f32x4*)(MOD + b * 3072 + 2048 + col0 + bj * 128); gt[bj][1] = *(const f32x4*)(MOD + b * 3072 + 2048 + col0 + bj * 128 + 4); }
#pragma unroll
        for (int ai = 0; ai < 2; ++ai)
#pragma unroll
            for (int m = 0; m < 4; ++m) {
                const size_t row = (size_t)(row0 + ai * 128 + m * 16);
                float ss = 0.f;
#pragma unroll
                for (int bj = 0; bj < 2; ++bj) {
                    const f32x4 xa = *(const f32x4*)(x + row * 1024 + col0 + bj * 128), xb = *(const f32x4*)(x + row * 1024 + col0 + bj * 128 + 4);
                    const f32x4 o0 = xa + gt[bj][0] * acc[ai][bj][m][0], o1 = xb + gt[bj][1] * acc[ai][bj][m][1];
                    *(f32x4*)(out + row * 1024 + col0 + bj * 128) = o0; *(f32x4*)(out + row * 1024 + col0 + bj * 128 + 4) = o1;
                    ss += (o0[0] * o0[0] + o0[1] * o0[1]) + (o0[2] * o0[2] + o0[3] * o0[3]) + (o1[0] * o1[0] + o1[1] * o1[1]) + (o1[2] * o1[2] + o1[3] * o1[3]);
                }
                ss += __shfl_xor(ss, 16); ss += __shfl_xor(ss, 32);
                if (fq == 0) SSQ[row * 16 + u.pn * 4 + wc] = ss;
            }
    }
};

__device__ __forceinline__ int src_col(int n) {
    const int tile = n >> 8, loc = n & 255;
    if (tile < 8) return (loc < 128) ? tile * 128 + loc : 1024 + tile * 128 + (loc - 128);
    if (tile >= 12 && tile < 24) { const int p = loc & 63; if (p < 16) return (n & ~63) + (p & 3) + ((p >> 2) & 1) * 8 + ((p >> 3) & 1) * 4; }
    return n;
}
template <bool PERMUTE>
__device__ __forceinline__ void transpose_item(const float* W, int K, int N, bf16_t* WT, LAS float* scr, int item, int lane) {
    const int nblk = N / 32, kb = item / nblk, nb = item % nblk, k0 = 64 * kb, n0 = 32 * nb;
    const int sn = PERMUTE ? src_col(n0 + (lane & 31)) : n0 + (lane & 31);
#pragma unroll 8
    for (int i = 0; i < 32; ++i) { const int kk = 2 * i + (lane >> 5); scr[kk * 33 + (lane & 31)] = W[(size_t)(k0 + kk) * N + sn]; }
    asm volatile("s_waitcnt lgkmcnt(0)" ::: "memory");
    const int c = lane & 7;
#pragma unroll
    for (int j = 0; j < 4; ++j) { const int n = (lane >> 3) + 8 * j; const LAS float* s = scr + (8 * c) * 33 + n;
        u32x4 o; o.x = pk2(s[0 * 33], s[1 * 33]); o.y = pk2(s[2 * 33], s[3 * 33]); o.z = pk2(s[4 * 33], s[5 * 33]); o.w = pk2(s[6 * 33], s[7 * 33]);
        *(u32x4*)(WT + (size_t)(n0 + n) * K + k0 + 8 * c) = o; }
    asm volatile("s_waitcnt lgkmcnt(0)" ::: "memory");
}

__device__ __forceinline__ void conv_oct(const f32x2 (&u)[38], const f32x2 (&w)[31], const f32x2 bias, LAS f32x2* acc) {
#pragma unroll
    for (int tt = 0; tt < 8; ++tt) {
        f32x2 a = bias;
#pragma unroll
        for (int k = 0; k < 31; ++k) a += w[k] * u[tt + k];
        acc[tt * 512] = a;
    }
}
__device__ __forceinline__ void conv_slide(f32x2 (&u)[38], const unsigned* up) {
    unsigned nw[8];
#pragma unroll
    for (int i = 0; i < 8; ++i) nw[i] = up[(long)i * 512];
#pragma unroll
    for (int i = 0; i < 30; ++i) u[i] = u[i + 8];
#pragma unroll
    for (int i = 0; i < 8; ++i) u[30 + i] = (f32x2){bflo(nw[i]), bfhi(nw[i])};
}
__device__ __forceinline__ void conv_item(const Params& p, LAS unsigned char* lds, int it, int tid) {
    const bf16_t* U = (const bf16_t*)(p.ws + WS_U); bf16_t* ZC = (bf16_t*)(p.ws + WS_ZC);
    const int row0 = it * 32, s0 = row0 & (SEQ - 1), c = 2 * tid;
    f32x2 w[31];
#pragma unroll
    for (int k = 0; k < 31; ++k) w[k] = *(const f32x2*)(p.conv_w + k * 1024 + c);
    const f32x2 bias = *(const f32x2*)(p.conv_b + c);
    const unsigned* up = (const unsigned*)(U + ((long)row0 - 30) * 1024 + c);
    f32x2 u[38];
    {
        unsigned raw[38];
#pragma unroll
        for (int s = 0; s < 30; ++s) raw[s] = 0u;
        if (s0 > 0) {
#pragma unroll
            for (int s = 0; s < 30; ++s) raw[s] = up[(long)s * 512];
        }
#pragma unroll
        for (int s = 30; s < 38; ++s) raw[s] = up[(long)s * 512];
#pragma unroll
        for (int s = 0; s < 38; ++s) u[s] = (f32x2){bflo(raw[s]), bfhi(raw[s])};
    }
    LAS f32x2* red = (LAS f32x2*)lds;
    LAS f32x2* stats = (LAS f32x2*)(lds + 131072);
    conv_oct(u, w, bias, red + tid);
    conv_slide(u, up + 38L * 512); conv_oct(u, w, bias, red + 8 * 512 + tid);
    conv_slide(u, up + 46L * 512); conv_oct(u, w, bias, red + 16 * 512 + tid);
    conv_slide(u, up + 54L * 512); conv_oct(u, w, bias, red + 24 * 512 + tid);
    __syncthreads();
    {
        const int t = tid >> 4, part = tid & 15; float s1 = 0.f, s2 = 0.f;
#pragma unroll 8
        for (int i = 0; i < 32; ++i) { const f32x2 v = red[t * 512 + part + 16 * i]; s1 += v.x + v.y; s2 += v.x * v.x + v.y * v.y; }
#pragma unroll
        for (int o = 1; o < 16; o <<= 1) { s1 += __shfl_xor(s1, o); s2 += __shfl_xor(s2, o); }
        if (part == 0) { const float mean = s1 * (1.f / 1024.f); const float var = fmaxf(s2 * (1.f / 1024.f) - mean * mean, 0.f); stats[t] = (f32x2){mean, 1.0f / sqrtf(var + EPS)}; }
    }
    __syncthreads();
    const f32x2 g2 = *(const f32x2*)(p.ln_g + c), b2 = *(const f32x2*)(p.ln_b + c);
    unsigned* zp = (unsigned*)(ZC + (size_t)row0 * 1024 + c);
#pragma unroll
    for (int t = 0; t < 32; ++t) {
        const f32x2 st = stats[t], av = red[t * 512 + tid];
        float y0 = (av.x - st.x) * st.y * g2.x + b2.x, y1 = (av.y - st.x) * st.y * g2.y + b2.y;
        y0 *= sigm(y0); y1 *= sigm(y1);
        const unsigned z = zp[(size_t)t * 512];
        zp[(size_t)t * 512] = pk2(y0 * bflo(z), y1 * bfhi(z));
    }
    __syncthreads();
}

typedef short v4i16_t __attribute__((ext_vector_type(4)));
__device__ __forceinline__ s16x4 vtr(const LAS unsigned char* p) { return __builtin_bit_cast(s16x4, __builtin_amdgcn_ds_read_tr16_b64_v4i16((LAS v4i16_t*)p)); }
constexpr int KV_ROWB = 160, LDS_VOFF = 256 * KV_ROWB;
struct AttnPre { u32x4 kv[8]; bf16x8 q0, q1; };
__device__ __forceinline__ void attn_decode(int idx, int& b, int& g, int& j, int& r, int& n, int& sh, size_t& sub) {
    const int q64 = idx & 63; int rest = idx >> 6; j = rest & 7; rest >>= 3; g = rest % 3; b = rest / 3;
    sh = 2 * g; r = q64 >> (6 - sh); n = q64 & ((64 >> sh) - 1);
    sub = ((size_t)(((b * 3 + g) * 8 + j) * SEQ) + ((size_t)r << (13 - sh))) * 64;
}
__device__ __forceinline__ void attn_prefetch(const Params& p, int idx, int tid, int lane, int w, AttnPre& R) {
    const bf16_t* Q = (const bf16_t*)(p.ws + WS_Q); const bf16_t* K = (const bf16_t*)(p.ws + WS_K); const bf16_t* V = (const bf16_t*)(p.ws + WS_V);
    int b, g, j, r, n, sh; size_t sub; attn_decode(idx, b, g, j, r, n, sh, sub);
    const int nprev = n > 0 ? n - 1 : n;
    const size_t rp = sub + (size_t)nprev * 8192 + tid * 8, rc = sub + (size_t)n * 8192 + tid * 8;
    R.kv[0] = *(const u32x4*)(K + rp); R.kv[1] = *(const u32x4*)(K + rp + 4096); R.kv[2] = *(const u32x4*)(K + rc); R.kv[3] = *(const u32x4*)(K + rc + 4096);
    R.kv[4] = *(const u32x4*)(V + rp); R.kv[5] = *(const u32x4*)(V + rp + 4096); R.kv[6] = *(const u32x4*)(V + rc); R.kv[7] = *(const u32x4*)(V + rc + 4096);
    const bf16_t* qptr = Q + sub + (size_t)(n * 128 + 16 * w + (lane & 15)) * 64 + 8 * (lane >> 4);
    R.q0 = *(const bf16x8*)(qptr); R.q1 = *(const bf16x8*)(qptr + 32);
}
__device__ __forceinline__ void attn_stage(LAS unsigned char* lds, int tid, const AttnPre& R) {
    LAS unsigned char* dp = lds + (tid >> 3) * KV_ROWB + (tid & 7) * 16; LAS unsigned char* dc = dp + 128 * KV_ROWB;
    *(LAS u32x4*)(dp) = R.kv[0]; *(LAS u32x4*)(dp + 64 * KV_ROWB) = R.kv[1]; *(LAS u32x4*)(dc) = R.kv[2]; *(LAS u32x4*)(dc + 64 * KV_ROWB) = R.kv[3];
    *(LAS u32x4*)(dp + LDS_VOFF) = R.kv[4]; *(LAS u32x4*)(dp + LDS_VOFF + 64 * KV_ROWB) = R.kv[5]; *(LAS u32x4*)(dc + LDS_VOFF) = R.kv[6]; *(LAS u32x4*)(dc + LDS_VOFF + 64 * KV_ROWB) = R.kv[7];
}
__device__ __forceinline__ void attn_compute(const Params& p, LAS unsigned char* lds, int idx, int lane, int w, const bf16x8 qf0, const bf16x8 qf1) {
    bf16_t* Q = (bf16_t*)(p.ws + WS_Q); float* LSE = (float*)(p.ws + WS_LSE);
    int b, g, j, r, n, sh; size_t sub; attn_decode(idx, b, g, j, r, n, sh, sub);
    const int d = 1 << sh;
    const int fr = lane & 15, fq = lane >> 4;
    const size_t qrow = (size_t)b * SEQ + (size_t)(n * 128 + 16 * w + fr) * d + r;
    bf16_t* qptr = Q + sub + (size_t)(n * 128 + 16 * w + fr) * 64;
    f32x4 s[9];
#pragma unroll
    for (int tp = 0; tp < 9; ++tp) {
        const LAS unsigned char* kb = lds + (16 * (w + tp) + fr) * KV_ROWB + fq * 16;
        const bf16x8 ka = *(const LAS bf16x8*)kb, kc = *(const LAS bf16x8*)(kb + 64);
        f32x4 z = (f32x4){0.f, 0.f, 0.f, 0.f};
        z = __builtin_amdgcn_mfma_f32_16x16x32_bf16(ka, qf0, z, 0, 0, 0);
        s[tp] = __builtin_amdgcn_mfma_f32_16x16x32_bf16(kc, qf1, z, 0, 0, 0);
    }
    const float NEG = -1e30f;
#pragma unroll
    for (int jj = 0; jj < 4; ++jj) { const int key = 4 * fq + jj; if (key < fr) s[0][jj] = NEG; if (key > fr) s[8][jj] = NEG; }
    if (n == 0) {
#pragma unroll
        for (int tp = 0; tp < 8; ++tp) if (w + tp < 8) s[tp] = (f32x4){NEG, NEG, NEG, NEG};
    }
    float mx = NEG;
#pragma unroll
    for (int tp = 0; tp < 9; ++tp) mx = fmaxf(fmaxf(mx, fmaxf(s[tp][0], s[tp][1])), fmaxf(s[tp][2], s[tp][3]));
    mx = fmaxf(mx, __shfl_xor(mx, 16)); mx = fmaxf(mx, __shfl_xor(mx, 32));
    float l = 0.f;
#pragma unroll
    for (int tp = 0; tp < 9; ++tp)
#pragma unroll
        for (int jj = 0; jj < 4; ++jj) { const float e = __builtin_amdgcn_exp2f(s[tp][jj] - mx); s[tp][jj] = e; l += e; }
    u32x4 pw[5];
#pragma unroll
    for (int kp = 0; kp < 4; ++kp) pw[kp] = pack8(s[2 * kp], s[2 * kp + 1]);
    pw[4] = pack8(s[8], (f32x4){0.f, 0.f, 0.f, 0.f});
    f32x4 ot[4];
#pragma unroll
    for (int dt = 0; dt < 4; ++dt) ot[dt] = (f32x4){0.f, 0.f, 0.f, 0.f};
    const LAS unsigned char* vbase = lds + LDS_VOFF + (16 * w + 4 * fq + (fr >> 2)) * KV_ROWB + (fr & 3) * 8;
#pragma unroll
    for (int kp = 0; kp < 5; ++kp)
#pragma unroll
        for (int dt = 0; dt < 4; ++dt) {
            const s16x4 lo = vtr(vbase + (2 * kp) * 16 * KV_ROWB + dt * 32);
            s16x4 hi = (s16x4){0, 0, 0, 0};
            if (kp < 4) hi = vtr(vbase + (2 * kp + 1) * 16 * KV_ROWB + dt * 32);
            const bf16x8 a = (bf16x8){lo[0], lo[1], lo[2], lo[3], hi[0], hi[1], hi[2], hi[3]};
            ot[dt] = __builtin_amdgcn_mfma_f32_16x16x32_bf16(a, __builtin_bit_cast(bf16x8, pw[kp]), ot[dt], 0, 0, 0);
        }
    l += __shfl_xor(l, 16); l += __shfl_xor(l, 32);
    const float inv = 1.0f / l;
#pragma unroll
    for (int dt = 0; dt < 4; ++dt) { u32x2 o; o.x = pk2(ot[dt][0] * inv, ot[dt][1] * inv); o.y = pk2(ot[dt][2] * inv, ot[dt][3] * inv); *(u32x2*)(qptr + 16 * dt + 4 * fq) = o; }
    if (fq == 0) LSE[((size_t)g * M + qrow) * 8 + j] = mx + __log2f(l);
}

__global__ void __launch_bounds__(512, 2) fwd_megakernel(Params p) {
    extern __shared__ __attribute__((aligned(16))) unsigned char lds_raw[];
    LAS unsigned char* lds = (LAS unsigned char*)lds_raw;
    cg::grid_group grid = cg::this_grid();
    int tid, lane, wave, gw;
#define RELANE() do { int t_ = threadIdx.x; asm volatile("" : "+v"(t_)); tid = t_; lane = tid & 63; wave = __builtin_amdgcn_readfirstlane(tid >> 6); gw = bid * 8 + wave; } while (0)
    const int G = gridDim.x, bid = blockIdx.x, NGW = G * 8;
    RELANE();
    unsigned char* ws = p.ws; unsigned char* dout = (unsigned char*)p.out;
    float* MOD = (float*)(ws + WS_MOD); float* CS = (float*)(ws + WS_CS); float* SSQ = (float*)(ws + WS_SSQ);
    bf16_t* W1T = (bf16_t*)(ws + WS_W1T); bf16_t* WCO = (bf16_t*)(ws + WS_WCO); bf16_t* WAO = (bf16_t*)(ws + WS_WAO); bf16_t* WO = (bf16_t*)(ws + WS_WO);
    bf16_t* H = (bf16_t*)(dout + DO_H); bf16_t* ZA = (bf16_t*)(dout + DO_ZA); unsigned char* GC8 = dout + DO_GC;
    unsigned* const barw = (unsigned*)(ws + WS_BAR);
    volatile LAS unsigned* const misc = (volatile LAS unsigned*)(lds + 131072 + 1024);
    if (tid == 0) { misc[0] = 0u; misc[1] = 0u; }
    if (bid == 0) for (int i = tid; i < XCD_BAR_WORDS; i += 512) barw[i] = 0u;
    __syncthreads();
    XcdBarrier xbar; xbar.bar = barw; xbar.x = 0; xbar.st = misc;
#define GSYNC() do { xcd_barrier(xbar); RELANE(); } while (0)

    for (int it = bid; it < 96; it += G) {
        const int n0 = it * 32, col = tid & 31, ks = tid >> 5;
        float a0 = 0.f, a1 = 0.f, a2 = 0.f, a3 = 0.f;
        const float* wp = p.w_ada + (size_t)(ks * 64) * 3072 + n0 + col; const float* cc = p.c + ks * 64;
#pragma unroll 8
        for (int k = 0; k < 64; ++k) { const float wv = wp[(size_t)k * 3072]; a0 += cc[k] * wv; a1 += cc[1024 + k] * wv; a2 += cc[2048 + k] * wv; a3 += cc[3072 + k] * wv; }
        LAS float* red = (LAS float*)lds;
        red[(ks * 4 + 0) * 32 + col] = a0; red[(ks * 4 + 1) * 32 + col] = a1; red[(ks * 4 + 2) * 32 + col] = a2; red[(ks * 4 + 3) * 32 + col] = a3;
        __syncthreads();
        if (tid < 128) { const int b = tid >> 5; float sum = p.b_ada[n0 + col];
#pragma unroll
            for (int k2 = 0; k2 < 16; ++k2) sum += red[(k2 * 4 + b) * 32 + col];
            MOD[b * 3072 + n0 + col] = sum; }
        __syncthreads();
    }
    {
        LAS float* scr = (LAS float*)(lds + wave * 16384);
        constexpr int I1 = 16 * 320, I2 = 16 * 32, I3 = 8 * 32, I4 = 16 * 32;
        for (int it = gw; it < I1 + I2 + I3 + I4; it += NGW) {
            int r = it;
            if (r < I1) { transpose_item<true>(p.w_in, 1024, NIN, W1T, scr, r, lane); continue; } r -= I1;
            if (r < I2) { transpose_item<false>(p.w_co, 1024, 1024, WCO, scr, r, lane); continue; } r -= I2;
            if (r < I3) { transpose_item<false>(p.w_ao, 512, 1024, WAO, scr, r, lane); continue; } r -= I3;
            transpose_item<false>(p.w_o, 1024, 1024, WO, scr, r, lane);
        }
    }
    for (int e = bid * 512 + tid; e < M * 8; e += G * 512) {
        const int row = e >> 3, i = e & 7;
        const float fi = i == 0 ? p.f0 : i == 1 ? p.f1 : i == 2 ? p.f2 : i == 3 ? p.f3 : i == 4 ? p.f4 : i == 5 ? p.f5 : i == 6 ? p.f6 : p.f7;
        const float ang = (float)p.pos[row] * fi;
        const double rev = (double)ang * 0.15915494309189535; const float frac = (float)(rev - __builtin_rint(rev));
        CS[row * 16 + i] = __builtin_amdgcn_cosf(frac); CS[row * 16 + 8 + i] = __builtin_amdgcn_sinf(frac);
    }
    grid.sync(); RELANE();
    xbar = xcd_barrier_post(barw, misc);

    for (int row = gw; row < M; row += NGW) {
        const f32x4* xr = (const f32x4*)(p.x + (size_t)row * 1024) + lane; f32x4 v[4]; float ss = 0.f;
#pragma unroll
        for (int jx = 0; jx < 4; ++jx) { v[jx] = xr[64 * jx]; ss += (v[jx][0] * v[jx][0] + v[jx][1] * v[jx][1]) + (v[jx][2] * v[jx][2] + v[jx][3] * v[jx][3]); }
        const float rstd = 1.0f / sqrtf(wave_sum(ss) * (1.f / 1024.f) + EPS);
        const float* mb = MOD + (row >> 13) * 3072;
#pragma unroll
        for (int jx = 0; jx < 4; ++jx) { const int col = 4 * lane + 256 * jx;
            const f32x4 gg = *(const f32x4*)(p.norm_g + col), scl = *(const f32x4*)(mb + 1024 + col), sft = *(const f32x4*)(mb + col);
            const f32x4 y = v[jx] * rstd * gg * (scl + 1.0f) + sft;
            u32x2 o; o.x = pk2(y[0], y[1]); o.y = pk2(y[2], y[3]); *(u32x2*)(H + (size_t)row * 1024 + col) = o; }
    }
    GSYNC();

    for (int rep = 0; rep < REP_P1; ++rep) {
        pg8::Gemm g{H, W1T, M, NIN, 1024}; pg8::StaticOrder S; S.init(M, NIN, G, bid);
        Epi1 E{ws, dout};
        pg8::gemm_phase<Epi1, pg8::StaticOrder, true, true>(lds, g, S, E);
    }
    GSYNC();

    for (int it = bid; it < 1024; it += G) conv_item(p, lds, it, tid);
    if (bid < 6144) {
        AttnPre R; attn_prefetch(p, bid, tid, lane, wave, R);
        for (int idx = bid; idx < 6144; idx += G) {
            __syncthreads();
            attn_stage(lds, tid, R); const bf16x8 qf0 = R.q0, qf1 = R.q1;
            __syncthreads();
            if (idx + G < 6144) attn_prefetch(p, idx + G, tid, lane, wave, R);
            attn_compute(p, lds, idx, lane, wave, qf0, qf1);
        }
    }
    GSYNC();

    for (int rep = 0; rep < REP_P3; ++rep) {
        const bf16_t* OG = (const bf16_t*)(ws + WS_Q); const float* LSE = (const float*)(ws + WS_LSE); bf16_t* A2 = (bf16_t*)(ws + WS_A2);
        for (int e = bid * 512 + tid; e < M * 64; e += G * 512) {
            const size_t row = (size_t)(e >> 6); const int jc = e & 63, j = jc >> 3;
            const float l0 = LSE[row * 8 + j], l1 = LSE[((size_t)M + row) * 8 + j], l2 = LSE[((size_t)2 * M + row) * 8 + j];
            const float mxl = fmaxf(l0, fmaxf(l1, l2));
            float w0 = __builtin_amdgcn_exp2f(l0 - mxl), w1 = __builtin_amdgcn_exp2f(l1 - mxl), w2 = __builtin_amdgcn_exp2f(l2 - mxl);
            const float inv = 1.0f / (w0 + w1 + w2); w0 *= inv; w1 *= inv; w2 *= inv;
            const int bb = (int)(row >> 13), tt = (int)(row & (SEQ - 1)), c8 = (jc & 7) * 8;
            const u32x4 o0 = *(const u32x4*)(OG + qkv_off(bb, 0, j, tt) + c8), o1 = *(const u32x4*)(OG + qkv_off(bb, 1, j, tt) + c8), o2 = *(const u32x4*)(OG + qkv_off(bb, 2, j, tt) + c8);
            const u32x4 za = *(const u32x4*)(ZA + row * 512 + jc * 8);
            u32x4 o;
#pragma unroll
            for (int q = 0; q < 4; ++q) {
                const float lo = (w0 * bflo(o0[q]) + w1 * bflo(o1[q]) + w2 * bflo(o2[q])) * bflo(za[q]);
                const float hi = (w0 * bfhi(o0[q]) + w1 * bfhi(o1[q]) + w2 * bfhi(o2[q])) * bfhi(za[q]);
                o[q] = pk2(lo, hi);
            }
            *(u32x4*)(A2 + row * 512 + jc * 8) = o;
        }
        pg8::Gemm g{(const bf16_t*)(ws + WS_ZC), WCO, M, 1024, 1024}; pg8::StaticOrder S; S.init(M, 1024, G, bid);
        Epi3 E{GC8, (bf16_t*)(ws + WS_T)};
        pg8::gemm_phase<Epi3, pg8::StaticOrder, true, true>(lds, g, S, E);
    }
    GSYNC();

    for (int rep = 0; rep < REP_P4; ++rep) {
        pg8::Gemm g{(const bf16_t*)(ws + WS_A2), WAO, M, 1024, 512}; pg8::StaticOrder S; S.init(M, 1024, G, bid);
        Epi4 E{ws + WS_GA, (const bf16_t*)(ws + WS_T), (bf16_t*)(ws + WS_MG)};
        pg8::gemm_phase<Epi4, pg8::StaticOrder, true, true>(lds, g, S, E);
    }
    GSYNC();

    for (int rep = 0; rep < REP_P5; ++rep) {
        pg8::Gemm g{(const bf16_t*)(ws + WS_MG), WO, M, 1024, 1024}; pg8::StaticOrder S; S.init(M, 1024, G, bid);
        Epi5 E{p.x, MOD, p.out, SSQ};
        pg8::gemm_phase<Epi5, pg8::StaticOrder, true, true>(lds, g, S, E);
    }
    GSYNC();

    for (int row = gw; row < M; row += NGW) {
        const float part = lane < 16 ? SSQ[(size_t)row * 16 + lane] : 0.f;
        const float rstd = 1.0f / sqrtf(wave_sum(part) * (1.f / 1024.f) + EPS);
        f32x4* orow = (f32x4*)(p.out + (size_t)row * 1024) + lane;
#pragma unroll
        for (int jx = 0; jx < 4; ++jx) { const f32x4 fg = *((const f32x4*)p.final_g + lane + 64 * jx); orow[64 * jx] = orow[64 * jx] * rstd * fg; }
    }
}

extern "C" void kernel_launch(void* const* d_in, const int* in_sizes, int n_in, void* d_out, int out_size, void* d_ws, size_t ws_size, hipStream_t stream) {
    static int grid = 0;
    if (grid == 0) {
        if (n_in != 15 || out_size != M * DM || ws_size < WS_END) { fprintf(stderr, "kernel_launch: unexpected sizes (n_in %d, out %d, ws %zu)\n", n_in, out_size, ws_size); grid = -1; return; }
        int dev = 0, cus = 0, per_cu = 0;
        (void)hipGetDevice(&dev); (void)hipDeviceGetAttribute(&cus, hipDeviceAttributeMultiprocessorCount, dev);
        (void)hipFuncSetAttribute((const void*)fwd_megakernel, hipFuncAttributeMaxDynamicSharedMemorySize, LDS_BYTES);
        if (hipOccupancyMaxActiveBlocksPerMultiprocessor(&per_cu, (const void*)fwd_megakernel, 512, LDS_BYTES) != hipSuccess || per_cu < 1) per_cu = 1;
        (void)hipGetLastError();
        grid = cus * per_cu;
    }
    if (grid < 0) return;
    Params p{};
    p.x = (const float*)d_in[0]; p.c = (const float*)d_in[1]; p.pos = (const int*)d_in[2]; p.norm_g = (const float*)d_in[3]; p.w_ada = (const float*)d_in[4]; p.b_ada = (const float*)d_in[5];
    p.w_in = (const float*)d_in[6]; p.conv_w = (const float*)d_in[7]; p.conv_b = (const float*)d_in[8]; p.ln_g = (const float*)d_in[9]; p.ln_b = (const float*)d_in[10];
    p.w_co = (const float*)d_in[11]; p.w_ao = (const float*)d_in[12]; p.w_o = (const float*)d_in[13]; p.final_g = (const float*)d_in[14];
    p.out = (float*)d_out; p.ws = (unsigned char*)d_ws;
    p.f0 = 1.0f; p.f1 = 1.939227432e-01f; p.f2 = 3.760603070e-02f; p.f3 = 7.292664610e-03f; p.f4 = 1.414213562e-03f; p.f5 = 2.742481884e-04f; p.f6 = 5.318295734e-05f; p.f7 = 1.031338525e-05f;
    void* args[] = {&p};
    const hipError_t e = hipLaunchCooperativeKernel((const void*)fwd_megakernel, dim3(grid), dim3(512), args, LDS_BYTES, stream);
    if (e != hipSuccess) fprintf(stderr, "cooperative launch failed: %s (grid %d)\n", hipGetErrorString(e), grid);
}
```

```cpp
#include <hip/hip_runtime.h>
#include <hip/hip_cooperative_groups.h>
#include <cstdio>
#include <cstdint>
namespace cg = cooperative_groups;
#define LAS __attribute__((address_space(3)))
namespace pg8 {
#define PG8_LAS __attribute__((address_space(3)))
typedef unsigned short bf16_t;
typedef short bf16x8 __attribute__((ext_vector_type(8)));
typedef float f32x4 __attribute__((ext_vector_type(4)));
typedef unsigned u32x4 __attribute__((ext_vector_type(4)));
constexpr int BM = 256, BK = 64, HALF = 128, HTB = HALF * BK * 2  , STAGE_BYTES = 8 * HTB, NXCD = 8, WGM = 8;

__host__ __device__ __forceinline__ int lds_byte(int r, int c) { const int st = (r >> 4) * 2 + (c >> 5), rr = r & 15, cc = c & 31, ob = rr * 64 + cc * 2; return st * 1024 + (ob ^ (((ob >> 9) & 1) << 5)); }
__host__ __device__ __forceinline__ void stage_rc(int b, int& R, int& C) { const int st = b / 1024, sb = b % 1024, swz = sb ^ (((sb >> 9) & 1) << 5); R = (st >> 1) * 16 + swz / 64; C = (st & 1) * 32 + (swz % 64) / 2; }
__host__ __device__ __forceinline__ int perm32(int rho) { const int n = rho >> 4, i = rho & 15; return 8 * (i >> 2) + 4 * n + (i & 3); }

struct Unit { int pm, pn; };
struct Gemm { const bf16_t* A; const bf16_t* Bt; int M, N, K; };

struct StaticOrder {
    int nM, nN, nwg, G, c;
    __host__ __device__ void init(int M, int N, int G_, int c_) { nM = M / BM; nN = N / BM; nwg = nM * nN; G = G_; c = c_; }
    __host__ __device__ bool next(int i, Unit& u) const {
        const long L = (long)i * G + c; if (L >= nwg) return false;
        int wgid = (int)L; { const int q = nwg / NXCD, r = nwg % NXCD, xcd = wgid % NXCD, off = wgid / NXCD; wgid = (xcd < r ? xcd * (q + 1) : r * (q + 1) + (xcd - r) * q) + off; }
        const int nig = WGM * nN, gid = wgid / nig, fm = gid * WGM, gsz = (nM - fm) < WGM ? (nM - fm) : WGM;
        u.pm = fm + ((wgid % nig) % gsz); u.pn = (wgid % nig) / gsz; return true;
    }
    __device__ __forceinline__ void a_ready(const Unit&) const {}
    __device__ __forceinline__ void done(const Unit&) const {}
};

__device__ __forceinline__ unsigned cvt_pk_bf16(float lo, float hi) { unsigned r; asm volatile("v_cvt_pk_bf16_f32 %0, %1, %2" : "=v"(r) : "v"(lo), "v"(hi)); return r; }
typedef float f32x2 __attribute__((ext_vector_type(2)));
template <class Epi, class Sched, bool ALIGN_EPI = false, bool SP2 = false>
__device__ __forceinline__ void gemm_phase(PG8_LAS unsigned char* lds, const Gemm g, const Sched& S, const Epi& E) {
    int tid_ = threadIdx.x; asm volatile("" : "+v"(tid_));
    const int tid = tid_, wid = __builtin_amdgcn_readfirstlane(tid >> 6), lane = tid & 63, wr = wid >> 2, wc = wid & 3, fr = lane & 15, fq = lane >> 4;
    const int K = g.K, nt = K / BK;
    unsigned voffA[2], voffB[2];
#pragma unroll
    for (int i = 0; i < 2; ++i) { int R, C; stage_rc(tid * 16 + i * 8192, R, C); const int Rb = Epi::PERM ? ((R & ~31) + perm32(R & 31)) : R;
        voffA[i] = (unsigned)(R * K + C) * 2u; voffB[i] = (unsigned)(Rb * K + C) * 2u; }
    const size_t kstep = (size_t)(BK * 2);
    const size_t hstep = (size_t)HALF * K * 2;
    const size_t tstep = 2 * hstep;
    const unsigned ldsw = (unsigned)wid * 1024u;
    const int aoff = lds_byte(wr * 64 + fr, fq * 8), boff = lds_byte(wc * 32 + fr, fq * 8);
#define PG8_SA(b, h) (((b) * 2 + (h)) * HTB)
#define PG8_SB(b, h) ((4 + (b) * 2 + (h)) * HTB)
#define PG8_STAGE(bufoff, gbase, voff) do { _Pragma("unroll") for (int _i = 0; _i < 2; ++_i) \
        __builtin_amdgcn_global_load_lds((const unsigned*)((const char*)(gbase) + (voff)[_i]), (PG8_LAS unsigned*)(lds + (bufoff) + ldsw + _i * 8192), 16, 0, 0); } while (0)
#define PG8_LDA(dst, b, h) do { _Pragma("unroll") for (int m = 0; m < 4; ++m) _Pragma("unroll") for (int k = 0; k < 2; ++k) dst[m][k] = *(const PG8_LAS bf16x8*)(lds + PG8_SA(b, h) + aoff + m * 2048 + k * 1024); } while (0)
#define PG8_LDB(dst, b, h) do { _Pragma("unroll") for (int n = 0; n < 2; ++n) _Pragma("unroll") for (int k = 0; k < 2; ++k) dst[n][k] = *(const PG8_LAS bf16x8*)(lds + PG8_SB(b, h) + boff + n * 2048 + k * 1024); } while (0)
#define PG8_MMA(ai, bj, At, Bt) do { __builtin_amdgcn_s_setprio(1); _Pragma("unroll") for (int m = 0; m < 4; ++m) _Pragma("unroll") for (int n = 0; n < 2; ++n) _Pragma("unroll") for (int k = 0; k < 2; ++k) \
        acc[ai][bj][m][n] = __builtin_amdgcn_mfma_f32_16x16x32_bf16(Bt[n][k], At[m][k], acc[ai][bj][m][n], 0, 0, 0); __builtin_amdgcn_s_setprio(0); } while (0)
#define PG8_WAIT_V(n) asm volatile("s_waitcnt vmcnt(" #n ")" ::: "memory")
#define PG8_WAIT_L(n) asm volatile("s_waitcnt lgkmcnt(" #n ")" ::: "memory")
#define PG8_BAR __builtin_amdgcn_s_barrier()
#define PG8_SCHED __builtin_amdgcn_sched_barrier(0)
    Unit cur, nxt; int ui = 0;
    if (!S.next(0, cur)) return;
    f32x4 acc[2][2][4][2];
#pragma unroll
    for (int a = 0; a < 2; ++a)
#pragma unroll
        for (int b = 0; b < 2; ++b)
#pragma unroll
            for (int m = 0; m < 4; ++m)
#pragma unroll
                for (int n = 0; n < 2; ++n) acc[a][b][m][n] = (f32x4){0.f, 0.f, 0.f, 0.f};
    bf16x8 At[4][2], B0[2][2], B1[2][2];
    const char* cA = (const char*)g.A + (size_t)cur.pm * tstep; const char* cB = (const char*)g.Bt + (size_t)cur.pn * tstep;
    S.a_ready(cur);
    if constexpr (SP2) {
        PG8_STAGE(PG8_SB(0, 0), cB, voffB); PG8_STAGE(PG8_SB(0, 1), cB + hstep, voffB); PG8_STAGE(PG8_SA(0, 0), cA, voffA); PG8_STAGE(PG8_SA(0, 1), cA + hstep, voffA);
        if (wr == 1) PG8_BAR;
        PG8_WAIT_V(2); PG8_BAR;
        PG8_STAGE(PG8_SB(1, 0), cB + kstep, voffB); PG8_STAGE(PG8_SA(1, 0), cA + kstep, voffA); PG8_STAGE(PG8_SB(1, 1), cB + hstep + kstep, voffB);
        PG8_WAIT_V(6); PG8_BAR;
    } else {
        PG8_STAGE(PG8_SB(0, 0), cB, voffB); PG8_STAGE(PG8_SA(0, 0), cA, voffA); PG8_STAGE(PG8_SB(0, 1), cB + hstep, voffB); PG8_STAGE(PG8_SA(0, 1), cA + hstep, voffA);
        if (wr == 1) PG8_BAR;
        PG8_WAIT_V(4); PG8_BAR;
        PG8_STAGE(PG8_SB(1, 0), cB + kstep, voffB); PG8_STAGE(PG8_SA(1, 0), cA + kstep, voffA); PG8_STAGE(PG8_SB(1, 1), cB + hstep + kstep, voffB);
        PG8_WAIT_V(6); PG8_BAR;
    }
    for (;;) {
        const bool has_next = S.next(ui + 1, nxt);
        const char* nA = has_next ? (const char*)g.A + (size_t)nxt.pm * tstep : cA; const char* nB = has_next ? (const char*)g.Bt + (size_t)nxt.pn * tstep : cB;
        for (int t = 0; t < nt; t += 2) {
            const bool last = (t == nt - 2);
            const char* a1 = cA + (size_t)(t + 1) * kstep;
            const char* a2 = last ? nA : cA + (size_t)(t + 2) * kstep; const char* b2 = last ? nB : cB + (size_t)(t + 2) * kstep;
            const char* a3 = a2 + kstep; const char* b3 = b2 + kstep;
            if (last && has_next) S.a_ready(nxt);
            if constexpr (SP2) {
            PG8_LDB(B0, 0, 0); PG8_LDB(B1, 0, 1); PG8_SCHED; PG8_LDA(At, 0, 0); PG8_STAGE(PG8_SA(1, 1), a1 + hstep, voffA);
            PG8_WAIT_V(8); PG8_WAIT_L(0); PG8_BAR; PG8_MMA(0, 0, At, B0); PG8_MMA(0, 1, At, B1); PG8_BAR; PG8_SCHED;
            PG8_LDA(At, 0, 1); PG8_STAGE(PG8_SB(0, 0), b2, voffB); PG8_STAGE(PG8_SB(0, 1), b2 + hstep, voffB); PG8_STAGE(PG8_SA(0, 0), a2, voffA);
            PG8_WAIT_V(8); PG8_WAIT_L(0); PG8_BAR; PG8_MMA(1, 0, At, B0); PG8_MMA(1, 1, At, B1); PG8_BAR; PG8_SCHED;
            PG8_LDB(B0, 1, 0); PG8_LDB(B1, 1, 1); PG8_SCHED; PG8_LDA(At, 1, 0); PG8_STAGE(PG8_SA(0, 1), a2 + hstep, voffA);
            PG8_WAIT_V(8); PG8_WAIT_L(0); PG8_BAR; PG8_MMA(0, 0, At, B0); PG8_MMA(0, 1, At, B1); PG8_BAR; PG8_SCHED;
            PG8_LDA(At, 1, 1); PG8_STAGE(PG8_SB(1, 0), b3, voffB); PG8_STAGE(PG8_SB(1, 1), b3 + hstep, voffB); PG8_STAGE(PG8_SA(1, 0), a3, voffA);
            PG8_WAIT_V(8); PG8_WAIT_L(0); PG8_BAR; PG8_MMA(1, 0, At, B0); PG8_MMA(1, 1, At, B1); PG8_BAR; PG8_SCHED;
            } else {
            PG8_LDB(B0, 0, 0); PG8_SCHED; PG8_LDA(At, 0, 0); PG8_STAGE(PG8_SA(1, 1), a1 + hstep, voffA);
            PG8_WAIT_L(8); PG8_BAR; PG8_WAIT_L(0); PG8_MMA(0, 0, At, B0); PG8_BAR; PG8_SCHED;
            PG8_LDB(B1, 0, 1); PG8_STAGE(PG8_SB(0, 0), b2, voffB);
            PG8_BAR; PG8_WAIT_L(0); PG8_MMA(0, 1, At, B1); PG8_BAR;
            PG8_LDA(At, 0, 1); PG8_STAGE(PG8_SA(0, 0), a2, voffA);
            PG8_BAR; PG8_WAIT_L(0); PG8_MMA(1, 0, At, B0); PG8_BAR; PG8_SCHED;
            PG8_STAGE(PG8_SB(0, 1), b2 + hstep, voffB);
            PG8_WAIT_V(6); PG8_BAR; PG8_MMA(1, 1, At, B1); PG8_BAR;
            PG8_LDB(B0, 1, 0); PG8_SCHED; PG8_LDA(At, 1, 0); PG8_STAGE(PG8_SA(0, 1), a2 + hstep, voffA);
            PG8_WAIT_L(8); PG8_BAR; PG8_WAIT_L(0); PG8_MMA(0, 0, At, B0); PG8_BAR; PG8_SCHED;
            PG8_LDB(B1, 1, 1); PG8_STAGE(PG8_SB(1, 0), b3, voffB);
            PG8_BAR; PG8_WAIT_L(0); PG8_MMA(0, 1, At, B1); PG8_BAR;
            PG8_LDA(At, 1, 1); PG8_STAGE(PG8_SA(1, 0), a3, voffA);
            PG8_BAR; PG8_WAIT_L(0); PG8_MMA(1, 0, At, B0); PG8_BAR; PG8_SCHED;
            PG8_STAGE(PG8_SB(1, 1), b3 + hstep, voffB);
            PG8_WAIT_V(6); PG8_BAR; PG8_MMA(1, 1, At, B1); PG8_BAR;
            }
        }
        if constexpr (ALIGN_EPI) { if (wr == 0) PG8_BAR; }
        if constexpr (!Epi::AFTER_DRAIN) { E(acc, cur, wr, wc, fr, fq); S.done(cur); }
        if (!has_next) break;
#pragma unroll
        for (int a = 0; a < 2; ++a)
#pragma unroll
            for (int b = 0; b < 2; ++b)
#pragma unroll
                for (int m = 0; m < 4; ++m)
#pragma unroll
                    for (int n = 0; n < 2; ++n) acc[a][b][m][n] = (f32x4){0.f, 0.f, 0.f, 0.f};
        cur = nxt; cA = nA; cB = nB; ++ui;
        if constexpr (ALIGN_EPI) { if (wr == 1) PG8_BAR; }
    }
    PG8_WAIT_V(0);
    if constexpr (!ALIGN_EPI) { if (wr == 0) PG8_BAR; }
    PG8_BAR;
    if constexpr (Epi::AFTER_DRAIN) { E.fused(acc, cur, wr, wc, fr, fq, lds, wid, lane); S.done(cur); }
#undef PG8_SA
#undef PG8_SB
#undef PG8_STAGE
#undef PG8_LDA
#undef PG8_LDB
#undef PG8_MMA
#undef PG8_WAIT_V
#undef PG8_WAIT_L
#undef PG8_BAR
#undef PG8_SCHED
}
}
#define XB_TMO      128
#define XB_XCNT(j)  (256  + 64 * (j))
#define XB_XSUB(j)  (1280 + 64 * (j))
#define XB_XGEN(j)  (2304 + 64 * (j))
#define XB_TOP      3328
#define XB_TOPGEN   3392
#define XCD_BAR_WORDS 3456
#define XB_SPIN_CAP (1u << 18)

__device__ __forceinline__ unsigned xb_ld(unsigned* p)              { return __hip_atomic_load(p, __ATOMIC_RELAXED, __HIP_MEMORY_SCOPE_AGENT); }
__device__ __forceinline__ unsigned xb_add(unsigned* p, unsigned v) { return __hip_atomic_fetch_add(p, v, __ATOMIC_RELAXED, __HIP_MEMORY_SCOPE_AGENT); }
__device__ __forceinline__ unsigned xb_xcc_id() { return (unsigned)__builtin_amdgcn_s_getreg((3 << 11) | 20) & 0xFu; }
#define XB_SPIN(cond, bar) do { unsigned _sp = 0; while (cond) { __builtin_amdgcn_s_sleep(1); \
    if ((++_sp & 255u) == 0u) { if (xb_ld(&(bar)[XB_TMO])) break; if (_sp > XB_SPIN_CAP) { atomicAdd(&(bar)[XB_TMO], 1u); break; } } } } while (0)

struct XcdBarrier {
    unsigned* bar; unsigned x;
    volatile LAS unsigned* st;
};

__device__ __forceinline__ XcdBarrier xcd_barrier_post(unsigned* bar, volatile LAS unsigned* st) {
    XcdBarrier b; b.bar = bar; b.x = xb_xcc_id(); b.st = st;
    if (threadIdx.x == 0) (void)xb_add(&bar[XB_XCNT(b.x)], 1u);
    return b;
}
__device__ __forceinline__ void xcd_barrier_complete(unsigned* bar, unsigned x, unsigned& nloc, unsigned& nx) {
    const unsigned G = gridDim.x * gridDim.y * gridDim.z;
    unsigned sum, cnt, mine, sp = 0u;
    for (;;) {
        sum = 0u; cnt = 0u; mine = 0u;
#pragma unroll
        for (unsigned j = 0; j < 16; ++j) { const unsigned c = xb_ld(&bar[XB_XCNT(j)]); sum += c; cnt += (c > 0u) ? 1u : 0u; mine = (j == x) ? c : mine; }
        if (sum == G) break;
        __builtin_amdgcn_s_sleep(1);
        if ((++sp & 255u) == 0u) { if (xb_ld(&bar[XB_TMO])) break; if (sp > XB_SPIN_CAP) { atomicAdd(&bar[XB_TMO], 1u); break; } }
    }
    nloc = mine > 0u ? mine : 1u; nx = cnt > 0u ? cnt : 1u;
}

__device__ __forceinline__ void xcd_barrier(const XcdBarrier& b) {
    asm volatile("s_waitcnt vmcnt(0)" ::: "memory");
    __syncthreads();
    if (threadIdx.x == 0) {
        unsigned* bar = b.bar;
        __builtin_amdgcn_s_waitcnt(0);
        unsigned nloc = b.st[0], nx = b.st[1];
        if (nloc == 0u) { xcd_barrier_complete(bar, b.x, nloc, nx); b.st[0] = nloc; b.st[1] = nx; }
        const unsigned old = xb_add(&bar[XB_XSUB(b.x)], 1u);
        const unsigned gen = old / nloc;
        if (old + 1u == (gen + 1u) * nloc) {
            __builtin_amdgcn_fence(__ATOMIC_RELEASE, "agent");
            asm volatile("s_waitcnt vmcnt(0)" ::: "memory");
            const unsigned og = xb_add(&bar[XB_TOP], 1u);
            const unsigned tg = og / nx;
            if (og + 1u == (tg + 1u) * nx) xb_add(&bar[XB_TOPGEN], 1u);
            else XB_SPIN(xb_ld(&bar[XB_TOPGEN]) == tg, bar);
            __builtin_amdgcn_fence(__ATOMIC_ACQUIRE, "agent");
            xb_add(&bar[XB_XGEN(b.x)], 1u);
            asm volatile("s_waitcnt vmcnt(0)" ::: "memory");
        } else {
            XB_SPIN(xb_ld(&bar[XB_XGEN(b.x)]) == gen, bar);
            __builtin_amdgcn_fence(__ATOMIC_ACQUIRE, "agent");
            asm volatile("s_waitcnt vmcnt(0)" ::: "memory");
        }
    }
    __syncthreads();
}

typedef unsigned short bf16_t;
typedef short bf16x8 __attribute__((ext_vector_type(8)));
typedef short s16x4 __attribute__((ext_vector_type(4)));
typedef float f32x4 __attribute__((ext_vector_type(4)));
typedef unsigned u32x4 __attribute__((ext_vector_type(4)));
typedef unsigned u32x2 __attribute__((ext_vector_type(2)));
typedef float f32x2 __attribute__((ext_vector_type(2)));

constexpr int NB = 4, SEQ = 8192, DM = 1024, M = NB * SEQ, NIN = 10240, QP = 1536;
constexpr size_t MiB = 1u << 20;
constexpr size_t WS_BAR = 512 * 1024  , WS_MOD = 0, WS_CS = 1 * MiB, WS_SSQ = 3 * MiB, WS_LSE = 5 * MiB, WS_W1T = 8 * MiB, WS_WCO = 28 * MiB, WS_WAO = 30 * MiB, WS_WO = 31 * MiB,
                 WS_U = 36 * MiB, WS_ZC = 100 * MiB, WS_Q = 164 * MiB, WS_K = 260 * MiB, WS_V = 356 * MiB, WS_GA = 452 * MiB, WS_END = 484 * MiB;
constexpr size_t WS_MG = WS_U, WS_T = WS_K, WS_A2 = WS_V;
constexpr size_t DO_H = 0, DO_ZA = 64 * MiB, DO_GC = 96 * MiB;
constexpr int LDS_BYTES = 147456;
constexpr int REP_P0 = 1, REP_P1 = 1, REP_P3 = 1, REP_P4 = 1, REP_P5 = 1, REP_CONV = 1, REP_ATT = 1;
constexpr float QSCALE = 0.125f * 1.4426950408889634f;
constexpr float EPS = 1e-6f;

struct Params {
    const float *x, *c; const int* pos; const float *norm_g, *w_ada, *b_ada, *w_in, *conv_w, *conv_b, *ln_g, *ln_b, *w_co, *w_ao, *w_o, *final_g;
    float* out; unsigned char* ws;
    float f0, f1, f2, f3, f4, f5, f6, f7;
};

__device__ __forceinline__ unsigned pk2(float lo, float hi) { return pg8::cvt_pk_bf16(lo, hi); }
__device__ __forceinline__ float bflo(unsigned w) { return __uint_as_float(w << 16); }
__device__ __forceinline__ float bfhi(unsigned w) { return __uint_as_float(w & 0xffff0000u); }
__device__ __forceinline__ float sigm(float x) { return __builtin_amdgcn_rcpf(1.f + __expf(-x)); }
__device__ __forceinline__ float wave_sum(float v) {
#pragma unroll
    for (int o = 1; o < 64; o <<= 1) v += __shfl_xor(v, o);
    return v;
}
__device__ __forceinline__ u32x4 pack8(const f32x4 a, const f32x4 b) { u32x4 w; w.x = pk2(a[0], a[1]); w.y = pk2(a[2], a[3]); w.z = pk2(b[0], b[1]); w.w = pk2(b[2], b[3]); return w; }
__device__ __forceinline__ f32x4 sigm4(const f32x4 v) { return (f32x4){sigm(v[0]), sigm(v[1]), sigm(v[2]), sigm(v[3])}; }
__device__ __forceinline__ unsigned un8x4(const f32x4 s) {
    const unsigned a = (unsigned)(s[0] * 255.f + 0.5f), b = (unsigned)(s[1] * 255.f + 0.5f), c = (unsigned)(s[2] * 255.f + 0.5f), d = (unsigned)(s[3] * 255.f + 0.5f);
    return a | (b << 8) | (c << 16) | (d << 24);
}
__device__ __forceinline__ f32x4 deq8(unsigned w) { return (f32x4){(float)(w & 255u), (float)((w >> 8) & 255u), (float)((w >> 16) & 255u), (float)(w >> 24)} * (1.0f / 255.0f); }
__device__ __forceinline__ f32x4 bf4lo(unsigned w0, unsigned w1) { return (f32x4){bflo(w0), bfhi(w0), bflo(w1), bfhi(w1)}; }

__device__ __forceinline__ size_t qkv_off(int b, int g, int j, int t) { const int sh = 2 * g; return ((size_t)(((b * 3 + g) * 8 + j) * SEQ + ((t & ((1 << sh) - 1)) << (13 - sh)) + (t >> sh))) * 64; }

struct Epi1 {
    static constexpr bool PERM = true, AFTER_DRAIN = false;
    unsigned char *ws, *dout;
    __device__ __forceinline__ void operator()(const f32x4 (&acc)[2][2][4][2], const pg8::Unit& u, int wr, int wc, int fr, int fq) const {
        const int pn = u.pn, row0 = u.pm * 256 + wr * 64 + fr, cl = wc * 32 + 8 * fq;
        bf16_t* const U = (bf16_t*)(ws + WS_U); bf16_t* const ZC = (bf16_t*)(ws + WS_ZC); bf16_t* const Q = (bf16_t*)(ws + WS_Q); bf16_t* const K = (bf16_t*)(ws + WS_K); bf16_t* const V = (bf16_t*)(ws + WS_V);
        bf16_t* const ZA = (bf16_t*)(dout + DO_ZA); unsigned char* const GC8 = dout + DO_GC; unsigned char* const GA8 = ws + WS_GA; const float* const CS = (const float*)(ws + WS_CS);
        if (pn < 8) {
#pragma unroll
            for (int ai = 0; ai < 2; ++ai)
#pragma unroll
                for (int m = 0; m < 4; ++m) {
                    const size_t row = (size_t)(row0 + ai * 128 + m * 16);
                    const f32x4 a0 = acc[ai][0][m][0] * sigm4(acc[ai][1][m][0]), a1 = acc[ai][0][m][1] * sigm4(acc[ai][1][m][1]);
                    *(u32x4*)(U + row * 1024 + pn * 128 + cl) = pack8(a0, a1);
                }
        } else if (pn < 12 || pn == 30 || pn == 31) {
            bf16_t* base = pn < 12 ? ZC : ZA; const int pitch = pn < 12 ? 1024 : 512, col0 = (pn < 12 ? (pn - 8) : (pn - 30)) * 256 + cl;
#pragma unroll
            for (int ai = 0; ai < 2; ++ai)
#pragma unroll
                for (int m = 0; m < 4; ++m) {
                    const size_t row = (size_t)(row0 + ai * 128 + m * 16);
#pragma unroll
                    for (int bj = 0; bj < 2; ++bj) {
                        const f32x4 v0 = acc[ai][bj][m][0], v1 = acc[ai][bj][m][1];
                        *(u32x4*)(base + row * pitch + col0 + bj * 128) = pack8(v0 * sigm4(v0), v1 * sigm4(v1));
                    }
                }
        } else if (pn < 24) {
            const bool isq = pn < 18; bf16_t* base = isq ? Q : K; const int pl = pn - (isq ? 12 : 18), g = pl >> 1, dim0 = (wc & 1) * 32 + 8 * fq; const float sc = isq ? QSCALE : 1.0f;
            const bool rot = ((wc & 1) == 0) && (fq < 2);
#pragma unroll
            for (int ai = 0; ai < 2; ++ai)
#pragma unroll
                for (int m = 0; m < 4; ++m) {
                    const size_t row = (size_t)(row0 + ai * 128 + m * 16);
                    f32x4 cv = (f32x4){1.f, 1.f, 1.f, 1.f}, sv = (f32x4){0.f, 0.f, 0.f, 0.f};
                    if (rot) { cv = *(const f32x4*)(CS + row * 16 + 4 * fq); sv = *(const f32x4*)(CS + row * 16 + 8 + 4 * fq); }
#pragma unroll
                    for (int bj = 0; bj < 2; ++bj) {
                        const f32x4 v0 = acc[ai][bj][m][0], v1 = acc[ai][bj][m][1];
                        const f32x4 n0 = (v0 * cv - v1 * sv) * sc, n1 = (v1 * cv + v0 * sv) * sc;
                        *(u32x4*)(base + qkv_off((int)(row >> 13), g, (4 * pl + 2 * bj + (wc >> 1)) & 7, (int)(row & (SEQ - 1))) + dim0) = pack8(n0, n1);
                    }
                }
        } else if (pn < 30) {
            const int pl = pn - 24, g = pl >> 1, dim0 = (wc & 1) * 32 + 8 * fq;
#pragma unroll
            for (int ai = 0; ai < 2; ++ai)
#pragma unroll
                for (int m = 0; m < 4; ++m) {
                    const size_t row = (size_t)(row0 + ai * 128 + m * 16);
#pragma unroll
                    for (int bj = 0; bj < 2; ++bj) *(u32x4*)(V + qkv_off((int)(row >> 13), g, (4 * pl + 2 * bj + (wc >> 1)) & 7, (int)(row & (SEQ - 1))) + dim0) = pack8(acc[ai][bj][m][0], acc[ai][bj][m][1]);
                }
        } else {
            unsigned char* base = pn < 36 ? GC8 : GA8; const int col0 = (pn - (pn < 36 ? 32 : 36)) * 256 + cl;
#pragma unroll
            for (int ai = 0; ai < 2; ++ai)
#pragma unroll
                for (int m = 0; m < 4; ++m) {
                    const size_t row = (size_t)(row0 + ai * 128 + m * 16);
#pragma unroll
                    for (int bj = 0; bj < 2; ++bj) { u32x2 w; w.x = un8x4(sigm4(acc[ai][bj][m][0])); w.y = un8x4(sigm4(acc[ai][bj][m][1])); *(u32x2*)(base + row * 1024 + col0 + bj * 128) = w; }
                }
        }
    }
};
struct Epi3 {
    static constexpr bool PERM = true, AFTER_DRAIN = false;
    const unsigned char* GC8; bf16_t* T;
    __device__ __forceinline__ void operator()(const f32x4 (&acc)[2][2][4][2], const pg8::Unit& u, int wr, int wc, int fr, int fq) const {
        const int row0 = u.pm * 256 + wr * 64 + fr, col0 = u.pn * 256 + wc * 32 + 8 * fq;
#pragma unroll
        for (int ai = 0; ai < 2; ++ai)
#pragma unroll
            for (int m = 0; m < 4; ++m) {
                const size_t row = (size_t)(row0 + ai * 128 + m * 16);
#pragma unroll
                for (int bj = 0; bj < 2; ++bj) {
                    const u32x2 g = *(const u32x2*)(GC8 + row * 1024 + col0 + bj * 128);
                    *(u32x4*)(T + row * 1024 + col0 + bj * 128) = pack8(acc[ai][bj][m][0] * deq8(g.x), acc[ai][bj][m][1] * deq8(g.y));
                }
            }
    }
};
struct Epi4 {
    static constexpr bool PERM = true, AFTER_DRAIN = false;
    const unsigned char* GA8; const bf16_t* T; bf16_t* MG;
    __device__ __forceinline__ void operator()(const f32x4 (&acc)[2][2][4][2], const pg8::Unit& u, int wr, int wc, int fr, int fq) const {
        const int row0 = u.pm * 256 + wr * 64 + fr, col0 = u.pn * 256 + wc * 32 + 8 * fq;
#pragma unroll
        for (int ai = 0; ai < 2; ++ai)
#pragma unroll
            for (int m = 0; m < 4; ++m) {
                const size_t row = (size_t)(row0 + ai * 128 + m * 16);
#pragma unroll
                for (int bj = 0; bj < 2; ++bj) {
                    const u32x2 g = *(const u32x2*)(GA8 + row * 1024 + col0 + bj * 128);
                    const u32x4 t = *(const u32x4*)(T + row * 1024 + col0 + bj * 128);
                    *(u32x4*)(MG + row * 1024 + col0 + bj * 128) = pack8(bf4lo(t.x, t.y) + acc[ai][bj][m][0] * deq8(g.x), bf4lo(t.z, t.w) + acc[ai][bj][m][1] * deq8(g.y));
                }
            }
    }
};
struct Epi5 {
    static constexpr bool PERM = true, AFTER_DRAIN = false;
    const float* x; const float* MOD; float* out; const float* fg; float* xbuf; unsigned* cnt; LAS unsigned char* xl;
    __device__ __forceinline__ void operator()(const f32x4 (&acc_)[2][2][4][2], const pg8::Unit& u, int wr, int wc, int fr, int fq) const {
        f32x4 (&acc)[2][2][4][2] = const_cast<f32x4 (&)[2][2][4][2]>(acc_);
        const int row0 = u.pm * 256 + wr * 64 + fr, col0 = u.pn * 256 + wc * 32 + 8 * fq, b = u.pm >> 5, wid = wr * 4 + wc, tid = wid * 64 + fq * 16 + fr;
        LAS float* P = (LAS float*)xl; LAS float* S = (LAS float*)(xl + 4096);
        {
            f32x4 gt[2][2];
#pragma unroll
            for (int bj = 0; bj < 2; ++bj) { gt[bj][0] = *(const f32x4*)(MOD + b * 3072 + 2048 + col0 + bj * 128); gt[bj][1] = *(const f32x4*)(MOD + b * 3072 + 2048 + col0 + bj * 128 + 4); }
#pragma unroll
            for (int ai = 0; ai < 2; ++ai)
#pragma unroll
                for (int m = 0; m < 4; ++m) {
                    const size_t row = (size_t)(row0 + ai * 128 + m * 16);
                    float ss = 0.f;
#pragma unroll
                    for (int bj = 0; bj < 2; ++bj) {
                        const f32x4 xa = *(const f32x4*)(x + row * 1024 + col0 + bj * 128), xb = *(const f32x4*)(x + row * 1024 + col0 + bj * 128 + 4);
                        const f32x4 o0 = xa + gt[bj][0] * acc[ai][bj][m][0], o1 = xb + gt[bj][1] * acc[ai][bj][m][1];
                        acc[ai][bj][m][0] = o0; acc[ai][bj][m][1] = o1;
                        ss += (o0[0] * o0[0] + o0[1] * o0[1]) + (o0[2] * o0[2] + o0[3] * o0[3]) + (o1[0] * o1[0] + o1[1] * o1[1]) + (o1[2] * o1[2] + o1[3] * o1[3]);
                    }
                    ss += __shfl_xor(ss, 16); ss += __shfl_xor(ss, 32);
                    if (fq == 0) P[(ai * 128 + wr * 64 + m * 16 + fr) * 4 + wc] = ss;
                }
        }
        asm volatile("s_waitcnt lgkmcnt(0)" ::: "memory"); __builtin_amdgcn_s_barrier(); asm volatile("" ::: "memory");
        if (tid < 256) {
            const float t = (P[tid * 4 + 0] + P[tid * 4 + 1]) + (P[tid * 4 + 2] + P[tid * 4 + 3]);
            __hip_atomic_store(xbuf + ((size_t)(u.pm * 256 + tid) * 4 + u.pn), t, __ATOMIC_RELAXED, __HIP_MEMORY_SCOPE_AGENT);
        }
        asm volatile("s_waitcnt vmcnt(0)" ::: "memory");
        if (wid < 4 && fq == 0 && fr == 0) __hip_atomic_fetch_add(cnt + 64 * u.pm, 1u, __ATOMIC_RELAXED, __HIP_MEMORY_SCOPE_AGENT);
        if (wid == 0) {
            unsigned sp = 0;
            while ((unsigned)__builtin_amdgcn_readfirstlane(__hip_atomic_load(cnt + 64 * u.pm, __ATOMIC_RELAXED, __HIP_MEMORY_SCOPE_AGENT)) < 16u) { __builtin_amdgcn_s_sleep(2); if (++sp > (1u << 22)) break; }
            __builtin_amdgcn_fence(__ATOMIC_ACQUIRE, "agent");
        }
        asm volatile("s_waitcnt vmcnt(0) lgkmcnt(0)" ::: "memory"); __builtin_amdgcn_s_barrier(); asm volatile("" ::: "memory");
        if (tid < 256) {
            const float* sl = xbuf + (size_t)(u.pm * 256 + tid) * 4;
            const float t = (__hip_atomic_load(sl + 0, __ATOMIC_RELAXED, __HIP_MEMORY_SCOPE_AGENT) + __hip_atomic_load(sl + 1, __ATOMIC_RELAXED, __HIP_MEMORY_SCOPE_AGENT))
                          + (__hip_atomic_load(sl + 2, __ATOMIC_RELAXED, __HIP_MEMORY_SCOPE_AGENT) + __hip_atomic_load(sl + 3, __ATOMIC_RELAXED, __HIP_MEMORY_SCOPE_AGENT));
            S[tid] = 1.0f / sqrtf(t * (1.f / 1024.f) + EPS);
        }
        asm volatile("s_waitcnt vmcnt(0) lgkmcnt(0)" ::: "memory"); __builtin_amdgcn_s_barrier(); asm volatile("" ::: "memory");
        f32x4 fv[2][2];
#pragma unroll
        for (int bj = 0; bj < 2; ++bj) { fv[bj][0] = *(const f32x4*)(fg + col0 + bj * 128); fv[bj][1] = *(const f32x4*)(fg + col0 + bj * 128 + 4); }
#pragma unroll
        for (int ai = 0; ai < 2; ++ai)
#pragma unroll
            for (int m = 0; m < 4; ++m) {
                const int rl = ai * 128 + wr * 64 + m * 16 + fr; const float sr = S[rl]; const size_t row = (size_t)(u.pm * 256 + rl);
#pragma unroll
                for (int bj = 0; bj < 2; ++bj) {
                    *(f32x4*)(out + row * 1024 + col0 + bj * 128) = acc[ai][bj][m][0] * sr * fv[bj][0];
                    *(f32x4*)(out + row * 1024 + col0 + bj * 128 + 4) = acc[ai][bj][m][1] * sr * fv[bj][1];
                }
            }
    }
};

__device__ __forceinline__ int src_col(int n) {
    const int tile = n >> 8, loc = n & 255;
    if (tile < 8) return (loc < 128) ? tile * 128 + loc : 1024 + tile * 128 + (loc - 128);
    if (tile >= 12 && tile < 24) { const int p = loc & 63; if (p < 16) return (n & ~63) + (p & 3) + ((p >> 2) & 1) * 8 + ((p >> 3) & 1) * 4; }
    return n;
}
template <bool PERMUTE>
__device__ __forceinline__ void transpose_item(const float* W, int K, int N, bf16_t* WT, LAS float* scr, int item, int lane) {
    const int nblk = N / 32, kb = item / nblk, nb = item % nblk, k0 = 64 * kb, n0 = 32 * nb;
    const int sn = PERMUTE ? src_col(n0 + (lane & 31)) : n0 + (lane & 31);
#pragma unroll 8
    for (int i = 0; i < 32; ++i) { const int kk = 2 * i + (lane >> 5); scr[kk * 33 + (lane & 31)] = W[(size_t)(k0 + kk) * N + sn]; }
    asm volatile("s_waitcnt lgkmcnt(0)" ::: "memory");
    const int c = lane & 7;
#pragma unroll
    for (int j = 0; j < 4; ++j) { const int n = (lane >> 3) + 8 * j; const LAS float* s = scr + (8 * c) * 33 + n;
        u32x4 o; o.x = pk2(s[0 * 33], s[1 * 33]); o.y = pk2(s[2 * 33], s[3 * 33]); o.z = pk2(s[4 * 33], s[5 * 33]); o.w = pk2(s[6 * 33], s[7 * 33]);
        *(u32x4*)(WT + (size_t)(n0 + n) * K + k0 + 8 * c) = o; }
    asm volatile("s_waitcnt lgkmcnt(0)" ::: "memory");
}

__device__ __forceinline__ void conv_oct(const f32x2 (&u)[38], const f32x2 (&w)[31], const f32x2 bias, LAS f32x2* acc) {
#pragma unroll
    for (int tt = 0; tt < 8; ++tt) {
        f32x2 a = bias;
#pragma unroll
        for (int k = 0; k < 31; ++k) a += w[k] * u[tt + k];
        acc[tt * 512] = a;
    }
}
__device__ __forceinline__ void conv_slide(f32x2 (&u)[38], const unsigned* up) {
    unsigned nw[8];
#pragma unroll
    for (int i = 0; i < 8; ++i) nw[i] = up[(long)i * 512];
#pragma unroll
    for (int i = 0; i < 30; ++i) u[i] = u[i + 8];
#pragma unroll
    for (int i = 0; i < 8; ++i) u[30 + i] = (f32x2){bflo(nw[i]), bfhi(nw[i])};
}
__device__ __forceinline__ void conv_item(const Params& p, LAS unsigned char* lds, int it, int tid, bool dummy = false) {
    const bf16_t* U = (const bf16_t*)(p.ws + WS_U); bf16_t* ZC = (bf16_t*)(p.ws + WS_ZC);
    const int row0 = it * 32, s0 = row0 & (SEQ - 1), c = 2 * tid;
    f32x2 w[31];
#pragma unroll
    for (int k = 0; k < 31; ++k) w[k] = *(const f32x2*)(p.conv_w + k * 1024 + c);
    const f32x2 bias = *(const f32x2*)(p.conv_b + c);
    const unsigned* up = (const unsigned*)(U + ((long)row0 - 30) * 1024 + c);
    f32x2 u[38];
    {
        unsigned raw[38];
#pragma unroll
        for (int s = 0; s < 30; ++s) raw[s] = 0u;
        if (s0 > 0) {
#pragma unroll
            for (int s = 0; s < 30; ++s) raw[s] = up[(long)s * 512];
        }
#pragma unroll
        for (int s = 30; s < 38; ++s) raw[s] = up[(long)s * 512];
#pragma unroll
        for (int s = 0; s < 38; ++s) u[s] = (f32x2){bflo(raw[s]), bfhi(raw[s])};
    }
    LAS f32x2* red = (LAS f32x2*)lds;
    LAS f32x2* stats = (LAS f32x2*)(lds + 131072);
    conv_oct(u, w, bias, red + tid);
    conv_slide(u, up + 38L * 512); conv_oct(u, w, bias, red + 8 * 512 + tid);
    conv_slide(u, up + 46L * 512); conv_oct(u, w, bias, red + 16 * 512 + tid);
    conv_slide(u, up + 54L * 512); conv_oct(u, w, bias, red + 24 * 512 + tid);
    __syncthreads();
    {
        const int t = tid >> 4, part = tid & 15; float s1 = 0.f, s2 = 0.f;
#pragma unroll 8
        for (int i = 0; i < 32; ++i) { const f32x2 v = red[t * 512 + part + 16 * i]; s1 += v.x + v.y; s2 += v.x * v.x + v.y * v.y; }
#pragma unroll
        for (int o = 1; o < 16; o <<= 1) { s1 += __shfl_xor(s1, o); s2 += __shfl_xor(s2, o); }
        if (part == 0) { const float mean = s1 * (1.f / 1024.f); const float var = fmaxf(s2 * (1.f / 1024.f) - mean * mean, 0.f); stats[t] = (f32x2){mean, 1.0f / sqrtf(var + EPS)}; }
    }
    __syncthreads();
    const f32x2 g2 = *(const f32x2*)(p.ln_g + c), b2 = *(const f32x2*)(p.ln_b + c);
    unsigned* zp = (unsigned*)(ZC + (size_t)row0 * 1024 + c); unsigned* op = dummy ? (unsigned*)((bf16_t*)p.out + (size_t)row0 * 1024 + c) : zp;
#pragma unroll
    for (int t = 0; t < 32; ++t) {
        const f32x2 st = stats[t], av = red[t * 512 + tid];
        float y0 = (av.x - st.x) * st.y * g2.x + b2.x, y1 = (av.y - st.x) * st.y * g2.y + b2.y;
        y0 *= sigm(y0); y1 *= sigm(y1);
        const unsigned z = zp[(size_t)t * 512];
        op[(size_t)t * 512] = pk2(y0 * bflo(z), y1 * bfhi(z));
    }
    __syncthreads();
}

typedef short v4i16_t __attribute__((ext_vector_type(4)));
__device__ __forceinline__ s16x4 vtr(const LAS unsigned char* p) { return __builtin_bit_cast(s16x4, __builtin_amdgcn_ds_read_tr16_b64_v4i16((LAS v4i16_t*)p)); }
constexpr int KV_ROWB = 160, LDS_VOFF = 256 * KV_ROWB;
struct AttnPre { u32x4 kv[8]; bf16x8 q0, q1; };
__device__ __forceinline__ void attn_decode(int idx, int& b, int& g, int& j, int& r, int& n, int& sh, size_t& sub) {
    const int q64 = idx & 63; int rest = idx >> 6; j = rest & 7; rest >>= 3; g = rest % 3; b = rest / 3;
    sh = 2 * g; r = q64 >> (6 - sh); n = q64 & ((64 >> sh) - 1);
    sub = ((size_t)(((b * 3 + g) * 8 + j) * SEQ) + ((size_t)r << (13 - sh))) * 64;
}
__device__ __forceinline__ void attn_prefetch(const Params& p, int idx, int tid, int lane, int w, AttnPre& R) {
    const bf16_t* Q = (const bf16_t*)(p.ws + WS_Q); const bf16_t* K = (const bf16_t*)(p.ws + WS_K); const bf16_t* V = (const bf16_t*)(p.ws + WS_V);
    int b, g, j, r, n, sh; size_t sub; attn_decode(idx, b, g, j, r, n, sh, sub);
    const int nprev = n > 0 ? n - 1 : n;
    const size_t rp = sub + (size_t)nprev * 8192 + tid * 8, rc = sub + (size_t)n * 8192 + tid * 8;
    R.kv[0] = *(const u32x4*)(K + rp); R.kv[1] = *(const u32x4*)(K + rp + 4096); R.kv[2] = *(const u32x4*)(K + rc); R.kv[3] = *(const u32x4*)(K + rc + 4096);
    R.kv[4] = *(const u32x4*)(V + rp); R.kv[5] = *(const u32x4*)(V + rp + 4096); R.kv[6] = *(const u32x4*)(V + rc); R.kv[7] = *(const u32x4*)(V + rc + 4096);
    const bf16_t* qptr = Q + sub + (size_t)(n * 128 + 16 * w + (lane & 15)) * 64 + 8 * (lane >> 4);
    R.q0 = *(const bf16x8*)(qptr); R.q1 = *(const bf16x8*)(qptr + 32);
}
__device__ __forceinline__ void attn_stage(LAS unsigned char* lds, int tid, const AttnPre& R) {
    LAS unsigned char* dp = lds + (tid >> 3) * KV_ROWB + (tid & 7) * 16; LAS unsigned char* dc = dp + 128 * KV_ROWB;
    *(LAS u32x4*)(dp) = R.kv[0]; *(LAS u32x4*)(dp + 64 * KV_ROWB) = R.kv[1]; *(LAS u32x4*)(dc) = R.kv[2]; *(LAS u32x4*)(dc + 64 * KV_ROWB) = R.kv[3];
    *(LAS u32x4*)(dp + LDS_VOFF) = R.kv[4]; *(LAS u32x4*)(dp + LDS_VOFF + 64 * KV_ROWB) = R.kv[5]; *(LAS u32x4*)(dc + LDS_VOFF) = R.kv[6]; *(LAS u32x4*)(dc + LDS_VOFF + 64 * KV_ROWB) = R.kv[7];
}
__device__ __forceinline__ void attn_compute(const Params& p, LAS unsigned char* lds, int idx, int lane, int w, const bf16x8 qf0, const bf16x8 qf1) {
    bf16_t* Q = (bf16_t*)(p.ws + WS_Q); float* LSE = (float*)(p.ws + WS_LSE);
    int b, g, j, r, n, sh; size_t sub; attn_decode(idx, b, g, j, r, n, sh, sub);
    const int d = 1 << sh;
    const int fr = lane & 15, fq = lane >> 4;
    const size_t qrow = (size_t)b * SEQ + (size_t)(n * 128 + 16 * w + fr) * d + r;
    bf16_t* qptr = Q + sub + (size_t)(n * 128 + 16 * w + fr) * 64;
    f32x4 s[9];
#pragma unroll
    for (int tp = 0; tp < 9; ++tp) {
        const LAS unsigned char* kb = lds + (16 * (w + tp) + fr) * KV_ROWB + fq * 16;
        const bf16x8 ka = *(const LAS bf16x8*)kb, kc = *(const LAS bf16x8*)(kb + 64);
        f32x4 z = (f32x4){0.f, 0.f, 0.f, 0.f};
        z = __builtin_amdgcn_mfma_f32_16x16x32_bf16(ka, qf0, z, 0, 0, 0);
        s[tp] = __builtin_amdgcn_mfma_f32_16x16x32_bf16(kc, qf1, z, 0, 0, 0);
    }
    const float NEG = -1e30f;
#pragma unroll
    for (int jj = 0; jj < 4; ++jj) { const int key = 4 * fq + jj; if (key < fr) s[0][jj] = NEG; if (key > fr) s[8][jj] = NEG; }
    if (n == 0) {
#pragma unroll
        for (int tp = 0; tp < 8; ++tp) if (w + tp < 8) s[tp] = (f32x4){NEG, NEG, NEG, NEG};
    }
    float mx = NEG;
#pragma unroll
    for (int tp = 0; tp < 9; ++tp) mx = fmaxf(fmaxf(mx, fmaxf(s[tp][0], s[tp][1])), fmaxf(s[tp][2], s[tp][3]));
    mx = fmaxf(mx, __shfl_xor(mx, 16)); mx = fmaxf(mx, __shfl_xor(mx, 32));
    float l = 0.f;
#pragma unroll
    for (int tp = 0; tp < 9; ++tp)
#pragma unroll
        for (int jj = 0; jj < 4; ++jj) { const float e = __builtin_amdgcn_exp2f(s[tp][jj] - mx); s[tp][jj] = e; l += e; }
    u32x4 pw[5];
#pragma unroll
    for (int kp = 0; kp < 4; ++kp) pw[kp] = pack8(s[2 * kp], s[2 * kp + 1]);
    pw[4] = pack8(s[8], (f32x4){0.f, 0.f, 0.f, 0.f});
    f32x4 ot[4];
#pragma unroll
    for (int dt = 0; dt < 4; ++dt) ot[dt] = (f32x4){0.f, 0.f, 0.f, 0.f};
    const LAS unsigned char* vbase = lds + LDS_VOFF + (16 * w + 4 * fq + (fr >> 2)) * KV_ROWB + (fr & 3) * 8;
#pragma unroll
    for (int kp = 0; kp < 5; ++kp)
#pragma unroll
        for (int dt = 0; dt < 4; ++dt) {
            const s16x4 lo = vtr(vbase + (2 * kp) * 16 * KV_ROWB + dt * 32);
            s16x4 hi = (s16x4){0, 0, 0, 0};
            if (kp < 4) hi = vtr(vbase + (2 * kp + 1) * 16 * KV_ROWB + dt * 32);
            const bf16x8 a = (bf16x8){lo[0], lo[1], lo[2], lo[3], hi[0], hi[1], hi[2], hi[3]};
            ot[dt] = __builtin_amdgcn_mfma_f32_16x16x32_bf16(a, __builtin_bit_cast(bf16x8, pw[kp]), ot[dt], 0, 0, 0);
        }
    l += __shfl_xor(l, 16); l += __shfl_xor(l, 32);
    const float inv = 1.0f / l;
#pragma unroll
    for (int dt = 0; dt < 4; ++dt) { u32x2 o; o.x = pk2(ot[dt][0] * inv, ot[dt][1] * inv); o.y = pk2(ot[dt][2] * inv, ot[dt][3] * inv); *(u32x2*)(qptr + 16 * dt + 4 * fq) = o; }
    if (fq == 0) LSE[((size_t)g * M + qrow) * 8 + j] = mx + __log2f(l);
}

__global__ void __launch_bounds__(512, 2) fwd_megakernel(Params p) {
    extern __shared__ __attribute__((aligned(16))) unsigned char lds_raw[];
    LAS unsigned char* lds = (LAS unsigned char*)lds_raw;
    cg::grid_group grid = cg::this_grid();
    int tid, lane, wave, gw;
#define RELANE() do { int t_ = threadIdx.x; asm volatile("" : "+v"(t_)); tid = t_; lane = tid & 63; wave = __builtin_amdgcn_readfirstlane(tid >> 6); gw = bid * 8 + wave; } while (0)
    const int G = gridDim.x, bid = blockIdx.x, NGW = G * 8;
    RELANE();
    unsigned char* ws = p.ws; unsigned char* dout = (unsigned char*)p.out;
    float* MOD = (float*)(ws + WS_MOD); float* CS = (float*)(ws + WS_CS); float* SSQ = (float*)(ws + WS_SSQ);
    bf16_t* W1T = (bf16_t*)(ws + WS_W1T); bf16_t* WCO = (bf16_t*)(ws + WS_WCO); bf16_t* WAO = (bf16_t*)(ws + WS_WAO); bf16_t* WO = (bf16_t*)(ws + WS_WO);
    bf16_t* H = (bf16_t*)(dout + DO_H); bf16_t* ZA = (bf16_t*)(dout + DO_ZA); unsigned char* GC8 = dout + DO_GC;
    unsigned* const barw = (unsigned*)(ws + WS_BAR);
    volatile LAS unsigned* const misc = (volatile LAS unsigned*)(lds + 131072 + 1024);
    if (tid == 0) { misc[0] = 0u; misc[1] = 0u; }
    unsigned* const pcnt = (unsigned*)(ws + WS_BAR + 65536);
    if (bid == 0) { for (int i = tid; i < XCD_BAR_WORDS; i += 512) barw[i] = 0u; for (int i = tid; i < 128 * 64; i += 512) pcnt[i] = 0u; }
    __syncthreads();
    XcdBarrier xbar; xbar.bar = barw; xbar.x = 0; xbar.st = misc;
#define GSYNC() do { xcd_barrier(xbar); RELANE(); } while (0)

    for (int it = bid; it < 96; it += G) {
        const int n0 = it * 32, col = tid & 31, ks = tid >> 5;
        float a0 = 0.f, a1 = 0.f, a2 = 0.f, a3 = 0.f;
        const float* wp = p.w_ada + (size_t)(ks * 64) * 3072 + n0 + col; const float* cc = p.c + ks * 64;
#pragma unroll 8
        for (int k = 0; k < 64; ++k) { const float wv = wp[(size_t)k * 3072]; a0 += cc[k] * wv; a1 += cc[1024 + k] * wv; a2 += cc[2048 + k] * wv; a3 += cc[3072 + k] * wv; }
        LAS float* red = (LAS float*)lds;
        red[(ks * 4 + 0) * 32 + col] = a0; red[(ks * 4 + 1) * 32 + col] = a1; red[(ks * 4 + 2) * 32 + col] = a2; red[(ks * 4 + 3) * 32 + col] = a3;
        __syncthreads();
        if (tid < 128) { const int b = tid >> 5; float sum = p.b_ada[n0 + col];
#pragma unroll
            for (int k2 = 0; k2 < 16; ++k2) sum += red[(k2 * 4 + b) * 32 + col];
            MOD[b * 3072 + n0 + col] = sum; }
        __syncthreads();
    }
    {
        LAS float* scr = (LAS float*)(lds + wave * 16384);
        constexpr int I1 = 16 * 320, I2 = 16 * 32, I3 = 8 * 32, I4 = 16 * 32;
        for (int it = gw; it < I1 + I2 + I3 + I4; it += NGW) {
            int r = it;
            if (r < I1) { transpose_item<true>(p.w_in, 1024, NIN, W1T, scr, r, lane); continue; } r -= I1;
            if (r < I2) { transpose_item<false>(p.w_co, 1024, 1024, WCO, scr, r, lane); continue; } r -= I2;
            if (r < I3) { transpose_item<false>(p.w_ao, 512, 1024, WAO, scr, r, lane); continue; } r -= I3;
            transpose_item<false>(p.w_o, 1024, 1024, WO, scr, r, lane);
        }
    }
    for (int e = bid * 512 + tid; e < M * 8; e += G * 512) {
        const int row = e >> 3, i = e & 7;
        const float fi = i == 0 ? p.f0 : i == 1 ? p.f1 : i == 2 ? p.f2 : i == 3 ? p.f3 : i == 4 ? p.f4 : i == 5 ? p.f5 : i == 6 ? p.f6 : p.f7;
        const float ang = (float)p.pos[row] * fi;
        const double rev = (double)ang * 0.15915494309189535; const float frac = (float)(rev - __builtin_rint(rev));
        CS[row * 16 + i] = __builtin_amdgcn_cosf(frac); CS[row * 16 + 8 + i] = __builtin_amdgcn_sinf(frac);
    }
    grid.sync(); RELANE();
    xbar = xcd_barrier_post(barw, misc);

    for (int row = gw; row < M; row += NGW) {
        const f32x4* xr = (const f32x4*)(p.x + (size_t)row * 1024) + lane; f32x4 v[4]; float ss = 0.f;
#pragma unroll
        for (int jx = 0; jx < 4; ++jx) { v[jx] = xr[64 * jx]; ss += (v[jx][0] * v[jx][0] + v[jx][1] * v[jx][1]) + (v[jx][2] * v[jx][2] + v[jx][3] * v[jx][3]); }
        const float rstd = 1.0f / sqrtf(wave_sum(ss) * (1.f / 1024.f) + EPS);
        const float* mb = MOD + (row >> 13) * 3072;
#pragma unroll
        for (int jx = 0; jx < 4; ++jx) { const int col = 4 * lane + 256 * jx;
            const f32x4 gg = *(const f32x4*)(p.norm_g + col), scl = *(const f32x4*)(mb + 1024 + col), sft = *(const f32x4*)(mb + col);
            const f32x4 y = v[jx] * rstd * gg * (scl + 1.0f) + sft;
            u32x2 o; o.x = pk2(y[0], y[1]); o.y = pk2(y[2], y[3]); *(u32x2*)(H + (size_t)row * 1024 + col) = o; }
    }
    GSYNC();

    for (int rep = 0; rep < REP_P1; ++rep) {
        pg8::Gemm g{H, W1T, M, NIN, 1024}; pg8::StaticOrder S; S.init(M, NIN, G, bid);
        Epi1 E{ws, dout};
        pg8::gemm_phase<Epi1, pg8::StaticOrder, true, true>(lds, g, S, E);
    }
    GSYNC();

    for (int it = bid; it < 1024 * REP_CONV; it += G) conv_item(p, lds, it & 1023, tid, it < 1024 * (REP_CONV - 1));
    if (bid < 6144) {
        AttnPre R; attn_prefetch(p, bid, tid, lane, wave, R);
        for (int idx = bid; idx < 6144; idx += G) {
            __syncthreads();
            attn_stage(lds, tid, R); const bf16x8 qf0 = R.q0, qf1 = R.q1;
            __syncthreads();
            if (idx + G < 6144) attn_prefetch(p, idx + G, tid, lane, wave, R);
            for (int rep = 0; rep < REP_ATT; ++rep) attn_compute(p, lds, idx, lane, wave, qf0, qf1);
        }
    }
    GSYNC();

    for (int rep = 0; rep < REP_P3; ++rep) {
        const bf16_t* OG = (const bf16_t*)(ws + WS_Q); const float* LSE = (const float*)(ws + WS_LSE); bf16_t* A2 = (bf16_t*)(ws + WS_A2);
        for (int e = bid * 512 + tid; e < M * 64; e += G * 512) {
            const size_t row = (size_t)(e >> 6); const int jc = e & 63, j = jc >> 3;
            const float l0 = LSE[row * 8 + j], l1 = LSE[((size_t)M + row) * 8 + j], l2 = LSE[((size_t)2 * M + row) * 8 + j];
            const float mxl = fmaxf(l0, fmaxf(l1, l2));
            float w0 = __builtin_amdgcn_exp2f(l0 - mxl), w1 = __builtin_amdgcn_exp2f(l1 - mxl), w2 = __builtin_amdgcn_exp2f(l2 - mxl);
            const float inv = 1.0f / (w0 + w1 + w2); w0 *= inv; w1 *= inv; w2 *= inv;
            const int bb = (int)(row >> 13), tt = (int)(row & (SEQ - 1)), c8 = (jc & 7) * 8;
            const u32x4 o0 = *(const u32x4*)(OG + qkv_off(bb, 0, j, tt) + c8), o1 = *(const u32x4*)(OG + qkv_off(bb, 1, j, tt) + c8), o2 = *(const u32x4*)(OG + qkv_off(bb, 2, j, tt) + c8);
            const u32x4 za = *(const u32x4*)(ZA + row * 512 + jc * 8);
            u32x4 o;
#pragma unroll
            for (int q = 0; q < 4; ++q) {
                const float lo = (w0 * bflo(o0[q]) + w1 * bflo(o1[q]) + w2 * bflo(o2[q])) * bflo(za[q]);
                const float hi = (w0 * bfhi(o0[q]) + w1 * bfhi(o1[q]) + w2 * bfhi(o2[q])) * bfhi(za[q]);
                o[q] = pk2(lo, hi);
            }
            *(u32x4*)(A2 + row * 512 + jc * 8) = o;
        }
        pg8::Gemm g{(const bf16_t*)(ws + WS_ZC), WCO, M, 1024, 1024}; pg8::StaticOrder S; S.init(M, 1024, G, bid);
        Epi3 E{GC8, (bf16_t*)(ws + WS_T)};
        pg8::gemm_phase<Epi3, pg8::StaticOrder, true, true>(lds, g, S, E);
    }
    GSYNC();

    for (int rep = 0; rep < REP_P4; ++rep) {
        pg8::Gemm g{(const bf16_t*)(ws + WS_A2), WAO, M, 1024, 512}; pg8::StaticOrder S; S.init(M, 1024, G, bid);
        Epi4 E{ws + WS_GA, (const bf16_t*)(ws + WS_T), (bf16_t*)(ws + WS_MG)};
        pg8::gemm_phase<Epi4, pg8::StaticOrder, true, true>(lds, g, S, E);
    }
    GSYNC();

    for (int rep = 0; rep < REP_P5; ++rep) {
        pg8::Gemm g{(const bf16_t*)(ws + WS_MG), WO, M, 1024, 1024}; pg8::StaticOrder S; S.init(M, 1024, G, bid);
        Epi5 E{p.x, MOD, p.out, p.final_g, SSQ, pcnt, lds + 131072 + 2048};
        pg8::gemm_phase<Epi5, pg8::StaticOrder, true, true>(lds, g, S, E);
    }
}

extern "C" void kernel_launch(void* const* d_in, const int* in_sizes, int n_in, void* d_out, int out_size, void* d_ws, size_t ws_size, hipStream_t stream) {
    static int grid = 0;
    if (grid == 0) {
        if (n_in != 15 || out_size != M * DM || ws_size < WS_END) { fprintf(stderr, "kernel_launch: unexpected sizes (n_in %d, out %d, ws %zu)\n", n_in, out_size, ws_size); grid = -1; return; }
        int dev = 0, cus = 0, per_cu = 0;
        (void)hipGetDevice(&dev); (void)hipDeviceGetAttribute(&cus, hipDeviceAttributeMultiprocessorCount, dev);
        (void)hipFuncSetAttribute((const void*)fwd_megakernel, hipFuncAttributeMaxDynamicSharedMemorySize, LDS_BYTES);
        if (hipOccupancyMaxActiveBlocksPerMultiprocessor(&per_cu, (const void*)fwd_megakernel, 512, LDS_BYTES) != hipSuccess || per_cu < 1) per_cu = 1;
        (void)hipGetLastError();
        grid = cus * per_cu;
    }
    if (grid < 0) return;
    Params p{};
    p.x = (const float*)d_in[0]; p.c = (const float*)d_in[1]; p.pos = (const int*)d_in[2]; p.norm_g = (const float*)d_in[3]; p.w_ada = (const float*)d_in[4]; p.b_ada = (const float*)d_in[5];
    p.w_in = (const float*)d_in[6]; p.conv_w = (const float*)d_in[7]; p.conv_b = (const float*)d_in[8]; p.ln_g = (const float*)d_in[9]; p.ln_b = (const float*)d_in[10];
    p.w_co = (const float*)d_in[11]; p.w_ao = (const float*)d_in[12]; p.w_o = (const float*)d_in[13]; p.final_g = (const float*)d_in[14];
    p.out = (float*)d_out; p.ws = (unsigned char*)d_ws;
    p.f0 = 1.0f; p.f1 = 1.939227432e-01f; p.f2 = 3.760603070e-02f; p.f3 = 7.292664610e-03f; p.f4 = 1.414213562e-03f; p.f5 = 2.742481884e-04f; p.f6 = 5.318295734e-05f; p.f7 = 1.031338525e-05f;
    void* args[] = {&p};
    const hipError_t e = hipLaunchCooperativeKernel((const void*)fwd_megakernel, dim3(grid), dim3(512), args, LDS_BYTES, stream);
    if (e != hipSuccess) fprintf(stderr, "cooperative launch failed: %s (grid %d)\n", hipGetErrorString(e), grid);
}
```

```cpp
#include <hip/hip_runtime.h>
#include <hip/hip_cooperative_groups.h>
#include <cstdio>
#include <cstdint>
namespace cg = cooperative_groups;
#define LAS __attribute__((address_space(3)))
namespace pg8 {
#define PG8_LAS __attribute__((address_space(3)))
typedef unsigned short bf16_t;
typedef short bf16x8 __attribute__((ext_vector_type(8)));
typedef float f32x4 __attribute__((ext_vector_type(4)));
typedef unsigned u32x4 __attribute__((ext_vector_type(4)));
constexpr int BM = 256, BK = 64, HALF = 128, HTB = HALF * BK * 2  , STAGE_BYTES = 8 * HTB, NXCD = 8, WGM = 8;

__host__ __device__ __forceinline__ int lds_byte(int r, int c) { const int st = (r >> 4) * 2 + (c >> 5), rr = r & 15, cc = c & 31, ob = rr * 64 + cc * 2; return st * 1024 + (ob ^ (((ob >> 9) & 1) << 5)); }
__host__ __device__ __forceinline__ void stage_rc(int b, int& R, int& C) { const int st = b / 1024, sb = b % 1024, swz = sb ^ (((sb >> 9) & 1) << 5); R = (st >> 1) * 16 + swz / 64; C = (st & 1) * 32 + (swz % 64) / 2; }
__host__ __device__ __forceinline__ int perm32(int rho) { const int n = rho >> 4, i = rho & 15; return 8 * (i >> 2) + 4 * n + (i & 3); }

struct Unit { int pm, pn; };
struct Gemm { const bf16_t* A; const bf16_t* Bt; int M, N, K; };

struct StaticOrder {
    int nM, nN, nwg, G, c;
    __host__ __device__ void init(int M, int N, int G_, int c_) { nM = M / BM; nN = N / BM; nwg = nM * nN; G = G_; c = c_; }
    __host__ __device__ bool next(int i, Unit& u) const {
        const long L = (long)i * G + c; if (L >= nwg) return false;
        int wgid = (int)L; { const int q = nwg / NXCD, r = nwg % NXCD, xcd = wgid % NXCD, off = wgid / NXCD; wgid = (xcd < r ? xcd * (q + 1) : r * (q + 1) + (xcd - r) * q) + off; }
        const int nig = WGM * nN, gid = wgid / nig, fm = gid * WGM, gsz = (nM - fm) < WGM ? (nM - fm) : WGM;
        u.pm = fm + ((wgid % nig) % gsz); u.pn = (wgid % nig) / gsz; return true;
    }
    __device__ __forceinline__ void a_ready(const Unit&) const {}
    __device__ __forceinline__ void done(const Unit&) const {}
};

__device__ __forceinline__ unsigned cvt_pk_bf16(float lo, float hi) { unsigned r; asm volatile("v_cvt_pk_bf16_f32 %0, %1, %2" : "=v"(r) : "v"(lo), "v"(hi)); return r; }
typedef float f32x2 __attribute__((ext_vector_type(2)));
template <class Epi, class Sched, bool ALIGN_EPI = false, bool SP2 = false>
__device__ __forceinline__ void gemm_phase(PG8_LAS unsigned char* lds, const Gemm g, const Sched& S, const Epi& E) {
    int tid_ = threadIdx.x; asm volatile("" : "+v"(tid_));
    const int tid = tid_, wid = __builtin_amdgcn_readfirstlane(tid >> 6), lane = tid & 63, wr = wid >> 2, wc = wid & 3, fr = lane & 15, fq = lane >> 4;
    const int K = g.K, nt = K / BK;
    unsigned voffA[2], voffB[2];
#pragma unroll
    for (int i = 0; i < 2; ++i) { int R, C; stage_rc(tid * 16 + i * 8192, R, C); const int Rb = Epi::PERM ? ((R & ~31) + perm32(R & 31)) : R;
        voffA[i] = (unsigned)(R * K + C) * 2u; voffB[i] = (unsigned)(Rb * K + C) * 2u; }
    const size_t kstep = (size_t)(BK * 2);
    const size_t hstep = (size_t)HALF * K * 2;
    const size_t tstep = 2 * hstep;
    const unsigned ldsw = (unsigned)wid * 1024u;
    const int aoff = lds_byte(wr * 64 + fr, fq * 8), boff = lds_byte(wc * 32 + fr, fq * 8);
#define PG8_SA(b, h) (((b) * 2 + (h)) * HTB)
#define PG8_SB(b, h) ((4 + (b) * 2 + (h)) * HTB)
#define PG8_STAGE(bufoff, gbase, voff) do { _Pragma("unroll") for (int _i = 0; _i < 2; ++_i) \
        __builtin_amdgcn_global_load_lds((const unsigned*)((const char*)(gbase) + (voff)[_i]), (PG8_LAS unsigned*)(lds + (bufoff) + ldsw + _i * 8192), 16, 0, 0); } while (0)
#define PG8_LDA(dst, b, h) do { _Pragma("unroll") for (int m = 0; m < 4; ++m) _Pragma("unroll") for (int k = 0; k < 2; ++k) dst[m][k] = *(const PG8_LAS bf16x8*)(lds + PG8_SA(b, h) + aoff + m * 2048 + k * 1024); } while (0)
#define PG8_LDB(dst, b, h) do { _Pragma("unroll") for (int n = 0; n < 2; ++n) _Pragma("unroll") for (int k = 0; k < 2; ++k) dst[n][k] = *(const PG8_LAS bf16x8*)(lds + PG8_SB(b, h) + boff + n * 2048 + k * 1024); } while (0)
#define PG8_MMA(ai, bj, At, Bt) do { __builtin_amdgcn_s_setprio(1); _Pragma("unroll") for (int m = 0; m < 4; ++m) _Pragma("unroll") for (int n = 0; n < 2; ++n) _Pragma("unroll") for (int k = 0; k < 2; ++k) \
        acc[ai][bj][m][n] = __builtin_amdgcn_mfma_f32_16x16x32_bf16(Bt[n][k], At[m][k], acc[ai][bj][m][n], 0, 0, 0); __builtin_amdgcn_s_setprio(0); } while (0)
#define PG8_WAIT_V(n) asm volatile("s_waitcnt vmcnt(" #n ")" ::: "memory")
#define PG8_WAIT_L(n) asm volatile("s_waitcnt lgkmcnt(" #n ")" ::: "memory")
#define PG8_BAR __builtin_amdgcn_s_barrier()
#define PG8_SCHED __builtin_amdgcn_sched_barrier(0)
    Unit cur, nxt; int ui = 0;
    if (!S.next(0, cur)) return;
    f32x4 acc[2][2][4][2];
#pragma unroll
    for (int a = 0; a < 2; ++a)
#pragma unroll
        for (int b = 0; b < 2; ++b)
#pragma unroll
            for (int m = 0; m < 4; ++m)
#pragma unroll
                for (int n = 0; n < 2; ++n) acc[a][b][m][n] = (f32x4){0.f, 0.f, 0.f, 0.f};
    bf16x8 At[4][2], B0[2][2], B1[2][2];
    const char* cA = (const char*)g.A + (size_t)cur.pm * tstep; const char* cB = (const char*)g.Bt + (size_t)cur.pn * tstep;
    S.a_ready(cur);
    if constexpr (SP2) {
        PG8_STAGE(PG8_SB(0, 0), cB, voffB); PG8_STAGE(PG8_SB(0, 1), cB + hstep, voffB); PG8_STAGE(PG8_SA(0, 0), cA, voffA); PG8_STAGE(PG8_SA(0, 1), cA + hstep, voffA);
        if (wr == 1) PG8_BAR;
        PG8_WAIT_V(2); PG8_BAR;
        PG8_STAGE(PG8_SB(1, 0), cB + kstep, voffB); PG8_STAGE(PG8_SA(1, 0), cA + kstep, voffA); PG8_STAGE(PG8_SB(1, 1), cB + hstep + kstep, voffB);
        PG8_WAIT_V(6); PG8_BAR;
    } else {
        PG8_STAGE(PG8_SB(0, 0), cB, voffB); PG8_STAGE(PG8_SA(0, 0), cA, voffA); PG8_STAGE(PG8_SB(0, 1), cB + hstep, voffB); PG8_STAGE(PG8_SA(0, 1), cA + hstep, voffA);
        if (wr == 1) PG8_BAR;
        PG8_WAIT_V(4); PG8_BAR;
        PG8_STAGE(PG8_SB(1, 0), cB + kstep, voffB); PG8_STAGE(PG8_SA(1, 0), cA + kstep, voffA); PG8_STAGE(PG8_SB(1, 1), cB + hstep + kstep, voffB);
        PG8_WAIT_V(6); PG8_BAR;
    }
    for (;;) {
        const bool has_next = S.next(ui + 1, nxt);
        const char* nA = has_next ? (const char*)g.A + (size_t)nxt.pm * tstep : cA; const char* nB = has_next ? (const char*)g.Bt + (size_t)nxt.pn * tstep : cB;
        for (int t = 0; t < nt; t += 2) {
            const bool last = (t == nt - 2);
            const char* a1 = cA + (size_t)(t + 1) * kstep;
            const char* a2 = last ? nA : cA + (size_t)(t + 2) * kstep; const char* b2 = last ? nB : cB + (size_t)(t + 2) * kstep;
            const char* a3 = a2 + kstep; const char* b3 = b2 + kstep;
            if (last && has_next) S.a_ready(nxt);
            if constexpr (SP2) {
            PG8_LDB(B0, 0, 0); PG8_LDB(B1, 0, 1); PG8_SCHED; PG8_LDA(At, 0, 0); PG8_STAGE(PG8_SA(1, 1), a1 + hstep, voffA);
            PG8_WAIT_V(8); PG8_WAIT_L(0); PG8_BAR; PG8_MMA(0, 0, At, B0); PG8_MMA(0, 1, At, B1); PG8_BAR; PG8_SCHED;
            PG8_LDA(At, 0, 1); PG8_STAGE(PG8_SB(0, 0), b2, voffB); PG8_STAGE(PG8_SB(0, 1), b2 + hstep, voffB); PG8_STAGE(PG8_SA(0, 0), a2, voffA);
            PG8_WAIT_V(8); PG8_WAIT_L(0); PG8_BAR; PG8_MMA(1, 0, At, B0); PG8_MMA(1, 1, At, B1); PG8_BAR; PG8_SCHED;
            PG8_LDB(B0, 1, 0); PG8_LDB(B1, 1, 1); PG8_SCHED; PG8_LDA(At, 1, 0); PG8_STAGE(PG8_SA(0, 1), a2 + hstep, voffA);
            PG8_WAIT_V(8); PG8_WAIT_L(0); PG8_BAR; PG8_MMA(0, 0, At, B0); PG8_MMA(0, 1, At, B1); PG8_BAR; PG8_SCHED;
            PG8_LDA(At, 1, 1); PG8_STAGE(PG8_SB(1, 0), b3, voffB); PG8_STAGE(PG8_SB(1, 1), b3 + hstep, voffB); PG8_STAGE(PG8_SA(1, 0), a3, voffA);
            PG8_WAIT_V(8); PG8_WAIT_L(0); PG8_BAR; PG8_MMA(1, 0, At, B0); PG8_MMA(1, 1, At, B1); PG8_BAR; PG8_SCHED;
            } else {
            PG8_LDB(B0, 0, 0); PG8_SCHED; PG8_LDA(At, 0, 0); PG8_STAGE(PG8_SA(1, 1), a1 + hstep, voffA);
            PG8_WAIT_L(8); PG8_BAR; PG8_WAIT_L(0); PG8_MMA(0, 0, At, B0); PG8_BAR; PG8_SCHED;
            PG8_LDB(B1, 0, 1); PG8_STAGE(PG8_SB(0, 0), b2, voffB);
            PG8_BAR; PG8_WAIT_L(0); PG8_MMA(0, 1, At, B1); PG8_BAR;
            PG8_LDA(At, 0, 1); PG8_STAGE(PG8_SA(0, 0), a2, voffA);
            PG8_BAR; PG8_WAIT_L(0); PG8_MMA(1, 0, At, B0); PG8_BAR; PG8_SCHED;
            PG8_STAGE(PG8_SB(0, 1), b2 + hstep, voffB);
            PG8_WAIT_V(6); PG8_BAR; PG8_MMA(1, 1, At, B1); PG8_BAR;
            PG8_LDB(B0, 1, 0); PG8_SCHED; PG8_LDA(At, 1, 0); PG8_STAGE(PG8_SA(0, 1), a2 + hstep, voffA);
            PG8_WAIT_L(8); PG8_BAR; PG8_WAIT_L(0); PG8_MMA(0, 0, At, B0); PG8_BAR; PG8_SCHED;
            PG8_LDB(B1, 1, 1); PG8_STAGE(PG8_SB(1, 0), b3, voffB);
            PG8_BAR; PG8_WAIT_L(0); PG8_MMA(0, 1, At, B1); PG8_BAR;
            PG8_LDA(At, 1, 1); PG8_STAGE(PG8_SA(1, 0), a3, voffA);
            PG8_BAR; PG8_WAIT_L(0); PG8_MMA(1, 0, At, B0); PG8_BAR; PG8_SCHED;
            PG8_STAGE(PG8_SB(1, 1), b3 + hstep, voffB);
            PG8_WAIT_V(6); PG8_BAR; PG8_MMA(1, 1, At, B1); PG8_BAR;
            }
        }
        if constexpr (ALIGN_EPI) { if (wr == 0) PG8_BAR; }
        if constexpr (!Epi::AFTER_DRAIN) { E(acc, cur, wr, wc, fr, fq); S.done(cur); }
        if (!has_next) break;
#pragma unroll
        for (int a = 0; a < 2; ++a)
#pragma unroll
            for (int b = 0; b < 2; ++b)
#pragma unroll
                for (int m = 0; m < 4; ++m)
#pragma unroll
                    for (int n = 0; n < 2; ++n) acc[a][b][m][n] = (f32x4){0.f, 0.f, 0.f, 0.f};
        cur = nxt; cA = nA; cB = nB; ++ui;
        if constexpr (ALIGN_EPI) { if (wr == 1) PG8_BAR; }
    }
    PG8_WAIT_V(0);
    if constexpr (!ALIGN_EPI) { if (wr == 0) PG8_BAR; }
    PG8_BAR;
    if constexpr (Epi::AFTER_DRAIN) { E.fused(acc, cur, wr, wc, fr, fq, lds, wid, lane); S.done(cur); }
#undef PG8_SA
#undef PG8_SB
#undef PG8_STAGE
#undef PG8_LDA
#undef PG8_LDB
#undef PG8_MMA
#undef PG8_WAIT_V
#undef PG8_WAIT_L
#undef PG8_BAR
#undef PG8_SCHED
}
}
#define XB_TMO      128
#define XB_XCNT(j)  (256  + 64 * (j))
#define XB_XSUB(j)  (1280 + 64 * (j))
#define XB_XGEN(j)  (2304 + 64 * (j))
#define XB_TOP      3328
#define XB_TOPGEN   3392
#define XCD_BAR_WORDS 3456
#define XB_SPIN_CAP (1u << 18)

__device__ __forceinline__ unsigned xb_ld(unsigned* p)              { return __hip_atomic_load(p, __ATOMIC_RELAXED, __HIP_MEMORY_SCOPE_AGENT); }
__device__ __forceinline__ unsigned xb_add(unsigned* p, unsigned v) { return __hip_atomic_fetch_add(p, v, __ATOMIC_RELAXED, __HIP_MEMORY_SCOPE_AGENT); }
__device__ __forceinline__ unsigned xb_xcc_id() { return (unsigned)__builtin_amdgcn_s_getreg((3 << 11) | 20) & 0xFu; }
#define XB_SPIN(cond, bar) do { unsigned _sp = 0; while (cond) { __builtin_amdgcn_s_sleep(1); \
    if ((++_sp & 255u) == 0u) { if (xb_ld(&(bar)[XB_TMO])) break; if (_sp > XB_SPIN_CAP) { atomicAdd(&(bar)[XB_TMO], 1u); break; } } } } while (0)

struct XcdBarrier {
    unsigned* bar; unsigned x;
    volatile LAS unsigned* st;
};

__device__ __forceinline__ XcdBarrier xcd_barrier_post(unsigned* bar, volatile LAS unsigned* st) {
    XcdBarrier b; b.bar = bar; b.x = xb_xcc_id(); b.st = st;
    if (threadIdx.x == 0) (void)xb_add(&bar[XB_XCNT(b.x)], 1u);
    return b;
}
__device__ __forceinline__ void xcd_barrier_complete(unsigned* bar, unsigned x, unsigned& nloc, unsigned& nx) {
    const unsigned G = gridDim.x * gridDim.y * gridDim.z;
    unsigned sum, cnt, mine, sp = 0u;
    for (;;) {
        sum = 0u; cnt = 0u; mine = 0u;
#pragma unroll
        for (unsigned j = 0; j < 16; ++j) { const unsigned c = xb_ld(&bar[XB_XCNT(j)]); sum += c; cnt += (c > 0u) ? 1u : 0u; mine = (j == x) ? c : mine; }
        if (sum == G) break;
        __builtin_amdgcn_s_sleep(1);
        if ((++sp & 255u) == 0u) { if (xb_ld(&bar[XB_TMO])) break; if (sp > XB_SPIN_CAP) { atomicAdd(&bar[XB_TMO], 1u); break; } }
    }
    nloc = mine > 0u ? mine : 1u; nx = cnt > 0u ? cnt : 1u;
}

__device__ __forceinline__ void xcd_barrier(const XcdBarrier& b) {
    asm volatile("s_waitcnt vmcnt(0)" ::: "memory");
    __syncthreads();
    if (threadIdx.x == 0) {
        unsigned* bar = b.bar;
        __builtin_amdgcn_s_waitcnt(0);
        unsigned nloc = b.st[0], nx = b.st[1];
        if (nloc == 0u) { xcd_barrier_complete(bar, b.x, nloc, nx); b.st[0] = nloc; b.st[1] = nx; }
        const unsigned old = xb_add(&bar[XB_XSUB(b.x)], 1u);
        const unsigned gen = old / nloc;
        if (old + 1u == (gen + 1u) * nloc) {
            __builtin_amdgcn_fence(__ATOMIC_RELEASE, "agent");
            asm volatile("s_waitcnt vmcnt(0)" ::: "memory");
            const unsigned og = xb_add(&bar[XB_TOP], 1u);
            const unsigned tg = og / nx;
            if (og + 1u == (tg + 1u) * nx) xb_add(&bar[XB_TOPGEN], 1u);
            else XB_SPIN(xb_ld(&bar[XB_TOPGEN]) == tg, bar);
            __builtin_amdgcn_fence(__ATOMIC_ACQUIRE, "agent");
            xb_add(&bar[XB_XGEN(b.x)], 1u);
            asm volatile("s_waitcnt vmcnt(0)" ::: "memory");
        } else {
            XB_SPIN(xb_ld(&bar[XB_XGEN(b.x)]) == gen, bar);
            __builtin_amdgcn_fence(__ATOMIC_ACQUIRE, "agent");
            asm volatile("s_waitcnt vmcnt(0)" ::: "memory");
        }
    }
    __syncthreads();
}

typedef unsigned short bf16_t;
typedef short bf16x8 __attribute__((ext_vector_type(8)));
typedef short s16x4 __attribute__((ext_vector_type(4)));
typedef float f32x4 __attribute__((ext_vector_type(4)));
typedef unsigned u32x4 __attribute__((ext_vector_type(4)));
typedef unsigned u32x2 __attribute__((ext_vector_type(2)));
typedef float f32x2 __attribute__((ext_vector_type(2)));

constexpr int NB = 4, SEQ = 8192, DM = 1024, M = NB * SEQ, NIN = 10240, QP = 1536;
constexpr size_t MiB = 1u << 20;
constexpr size_t WS_BAR = 512 * 1024  , WS_MOD = 0, WS_CS = 1 * MiB, WS_SSQ = 3 * MiB, WS_LSE = 5 * MiB, WS_W1T = 8 * MiB, WS_WCO = 28 * MiB, WS_WAO = 30 * MiB, WS_WO = 31 * MiB,
                 WS_U = 36 * MiB, WS_ZC = 100 * MiB, WS_Q = 164 * MiB, WS_K = 260 * MiB, WS_V = 356 * MiB, WS_GA = 452 * MiB, WS_END = 484 * MiB;
constexpr size_t WS_MG = WS_U, WS_T = WS_K, WS_A2 = WS_V;
constexpr size_t DO_H = 0, DO_ZA = 64 * MiB, DO_GC = 96 * MiB;
constexpr int LDS_BYTES = 147456;
constexpr int REP_P0 = 1, REP_P1 = 1, REP_P3 = 1, REP_P4 = 1, REP_P5 = 1, REP_CONV = 1, REP_ATT = 1;
constexpr float QSCALE = 0.125f * 1.4426950408889634f;
constexpr float EPS = 1e-6f;

struct Params {
    const float *x, *c; const int* pos; const float *norm_g, *w_ada, *b_ada, *w_in, *conv_w, *conv_b, *ln_g, *ln_b, *w_co, *w_ao, *w_o, *final_g;
    float* out; unsigned char* ws;
    float f0, f1, f2, f3, f4, f5, f6, f7;
};

__device__ __forceinline__ unsigned pk2(float lo, float hi) { return pg8::cvt_pk_bf16(lo, hi); }
__device__ __forceinline__ float bflo(unsigned w) { return __uint_as_float(w << 16); }
__device__ __forceinline__ float bfhi(unsigned w) { return __uint_as_float(w & 0xffff0000u); }
__device__ __forceinline__ float sigm(float x) { return __builtin_amdgcn_rcpf(1.f + __expf(-x)); }
__device__ __forceinline__ float wave_sum(float v) {
#pragma unroll
    for (int o = 1; o < 64; o <<= 1) v += __shfl_xor(v, o);
    return v;
}
__device__ __forceinline__ u32x4 pack8(const f32x4 a, const f32x4 b) { u32x4 w; w.x = pk2(a[0], a[1]); w.y = pk2(a[2], a[3]); w.z = pk2(b[0], b[1]); w.w = pk2(b[2], b[3]); return w; }
__device__ __forceinline__ f32x4 sigm4(const f32x4 v) { return (f32x4){sigm(v[0]), sigm(v[1]), sigm(v[2]), sigm(v[3])}; }
__device__ __forceinline__ unsigned un8x4(const f32x4 s) {
    const unsigned a = (unsigned)(s[0] * 255.f + 0.5f), b = (unsigned)(s[1] * 255.f + 0.5f), c = (unsigned)(s[2] * 255.f + 0.5f), d = (unsigned)(s[3] * 255.f + 0.5f);
    return a | (b << 8) | (c << 16) | (d << 24);
}
__device__ __forceinline__ f32x4 deq8(unsigned w) { return (f32x4){(float)(w & 255u), (float)((w >> 8) & 255u), (float)((w >> 16) & 255u), (float)(w >> 24)} * (1.0f / 255.0f); }
__device__ __forceinline__ f32x4 bf4lo(unsigned w0, unsigned w1) { return (f32x4){bflo(w0), bfhi(w0), bflo(w1), bfhi(w1)}; }

__device__ __forceinline__ size_t qkv_off(int b, int g, int j, int t) { const int sh = 2 * g; return ((size_t)(((b * 3 + g) * 8 + j) * SEQ + ((t & ((1 << sh) - 1)) << (13 - sh)) + (t >> sh))) * 64; }

struct Epi1 {
    static constexpr bool PERM = true, AFTER_DRAIN = false;
    unsigned char *ws, *dout;
    __device__ __forceinline__ void operator()(const f32x4 (&acc)[2][2][4][2], const pg8::Unit& u, int wr, int wc, int fr, int fq) const {
        const int pn = u.pn, row0 = u.pm * 256 + wr * 64 + fr, cl = wc * 32 + 8 * fq;
        bf16_t* const U = (bf16_t*)(ws + WS_U); bf16_t* const ZC = (bf16_t*)(ws + WS_ZC); bf16_t* const Q = (bf16_t*)(ws + WS_Q); bf16_t* const K = (bf16_t*)(ws + WS_K); bf16_t* const V = (bf16_t*)(ws + WS_V);
        bf16_t* const ZA = (bf16_t*)(dout + DO_ZA); unsigned char* const GC8 = dout + DO_GC; unsigned char* const GA8 = ws + WS_GA; const float* const CS = (const float*)(ws + WS_CS);
        if (pn < 8) {
#pragma unroll
            for (int ai = 0; ai < 2; ++ai)
#pragma unroll
                for (int m = 0; m < 4; ++m) {
                    const size_t row = (size_t)(row0 + ai * 128 + m * 16);
                    const f32x4 a0 = acc[ai][0][m][0] * sigm4(acc[ai][1][m][0]), a1 = acc[ai][0][m][1] * sigm4(acc[ai][1][m][1]);
                    *(u32x4*)(U + row * 1024 + pn * 128 + cl) = pack8(a0, a1);
                }
        } else if (pn < 12 || pn == 30 || pn == 31) {
            bf16_t* base = pn < 12 ? ZC : ZA; const int pitch = pn < 12 ? 1024 : 512, col0 = (pn < 12 ? (pn - 8) : (pn - 30)) * 256 + cl;
#pragma unroll
            for (int ai = 0; ai < 2; ++ai)
#pragma unroll
                for (int m = 0; m < 4; ++m) {
                    const size_t row = (size_t)(row0 + ai * 128 + m * 16);
#pragma unroll
                    for (int bj = 0; bj < 2; ++bj) {
                        const f32x4 v0 = acc[ai][bj][m][0], v1 = acc[ai][bj][m][1];
                        *(u32x4*)(base + row * pitch + col0 + bj * 128) = pack8(v0 * sigm4(v0), v1 * sigm4(v1));
                    }
                }
        } else if (pn < 24) {
            const bool isq = pn < 18; bf16_t* base = isq ? Q : K; const int pl = pn - (isq ? 12 : 18), g = pl >> 1, dim0 = (wc & 1) * 32 + 8 * fq; const float sc = isq ? QSCALE : 1.0f;
            const bool rot = ((wc & 1) == 0) && (fq < 2);
#pragma unroll
            for (int ai = 0; ai < 2; ++ai)
#pragma unroll
                for (int m = 0; m < 4; ++m) {
                    const size_t row = (size_t)(row0 + ai * 128 + m * 16);
                    f32x4 cv = (f32x4){1.f, 1.f, 1.f, 1.f}, sv = (f32x4){0.f, 0.f, 0.f, 0.f};
                    if (rot) { cv = *(const f32x4*)(CS + row * 16 + 4 * fq); sv = *(const f32x4*)(CS + row * 16 + 8 + 4 * fq); }
#pragma unroll
                    for (int bj = 0; bj < 2; ++bj) {
                        const f32x4 v0 = acc[ai][bj][m][0], v1 = acc[ai][bj][m][1];
                        const f32x4 n0 = (v0 * cv - v1 * sv) * sc, n1 = (v1 * cv + v0 * sv) * sc;
                        *(u32x4*)(base + qkv_off((int)(row >> 13), g, (4 * pl + 2 * bj + (wc >> 1)) & 7, (int)(row & (SEQ - 1))) + dim0) = pack8(n0, n1);
                    }
                }
        } else if (pn < 30) {
            const int pl = pn - 24, g = pl >> 1, dim0 = (wc & 1) * 32 + 8 * fq;
#pragma unroll
            for (int ai = 0; ai < 2; ++ai)
#pragma unroll
                for (int m = 0; m < 4; ++m) {
                    const size_t row = (size_t)(row0 + ai * 128 + m * 16);
#pragma unroll
                    for (int bj = 0; bj < 2; ++bj) *(u32x4*)(V + qkv_off((int)(row >> 13), g, (4 * pl + 2 * bj + (wc >> 1)) & 7, (int)(row & (SEQ - 1))) + dim0) = pack8(acc[ai][bj][m][0], acc[ai][bj][m][1]);
                }
        } else {
            unsigned char* base = pn < 36 ? GC8 : GA8; const int col0 = (pn - (pn < 36 ? 32 : 36)) * 256 + cl;
#pragma unroll
            for (int ai = 0; ai < 2; ++ai)
#pragma unroll
                for (int m = 0; m < 4; ++m) {
                    const size_t row = (size_t)(row0 + ai * 128 + m * 16);
#pragma unroll
                    for (int bj = 0; bj < 2; ++bj) { u32x2 w; w.x = un8x4(sigm4(acc[ai][bj][m][0])); w.y = un8x4(sigm4(acc[ai][bj][m][1])); *(u32x2*)(base + row * 1024 + col0 + bj * 128) = w; }
                }
        }
    }
};
struct Epi3 {
    static constexpr bool PERM = true, AFTER_DRAIN = false;
    const unsigned char* GC8; bf16_t* T;
    __device__ __forceinline__ void operator()(const f32x4 (&acc)[2][2][4][2], const pg8::Unit& u, int wr, int wc, int fr, int fq) const {
        const int row0 = u.pm * 256 + wr * 64 + fr, col0 = u.pn * 256 + wc * 32 + 8 * fq;
#pragma unroll
        for (int ai = 0; ai < 2; ++ai)
#pragma unroll
            for (int m = 0; m < 4; ++m) {
                const size_t row = (size_t)(row0 + ai * 128 + m * 16);
#pragma unroll
                for (int bj = 0; bj < 2; ++bj) {
                    const u32x2 g = *(const u32x2*)(GC8 + row * 1024 + col0 + bj * 128);
                    *(u32x4*)(T + row * 1024 + col0 + bj * 128) = pack8(acc[ai][bj][m][0] * deq8(g.x), acc[ai][bj][m][1] * deq8(g.y));
                }
            }
    }
};
struct Epi4 {
    static constexpr bool PERM = true, AFTER_DRAIN = false;
    const unsigned char* GA8; const bf16_t* T; bf16_t* MG;
    __device__ __forceinline__ void operator()(const f32x4 (&acc)[2][2][4][2], const pg8::Unit& u, int wr, int wc, int fr, int fq) const {
        const int row0 = u.pm * 256 + wr * 64 + fr, col0 = u.pn * 256 + wc * 32 + 8 * fq;
#pragma unroll
        for (int ai = 0; ai < 2; ++ai)
#pragma unroll
            for (int m = 0; m < 4; ++m) {
                const size_t row = (size_t)(row0 + ai * 128 + m * 16);
#pragma unroll
                for (int bj = 0; bj < 2; ++bj) {
                    const u32x2 g = *(const u32x2*)(GA8 + row * 1024 + col0 + bj * 128);
                    const u32x4 t = *(const u32x4*)(T + row * 1024 + col0 + bj * 128);
                    *(u32x4*)(MG + row * 1024 + col0 + bj * 128) = pack8(bf4lo(t.x, t.y) + acc[ai][bj][m][0] * deq8(g.x), bf4lo(t.z, t.w) + acc[ai][bj][m][1] * deq8(g.y));
                }
            }
    }
};
struct Epi5 {
    static constexpr bool PERM = true, AFTER_DRAIN = false;
    const float* x; const float* MOD; float* out; const float* fg; float* xbuf; unsigned* cnt; LAS unsigned char* xl;
    __device__ __forceinline__ void operator()(const f32x4 (&acc_)[2][2][4][2], const pg8::Unit& u, int wr, int wc, int fr, int fq) const {
        f32x4 (&acc)[2][2][4][2] = const_cast<f32x4 (&)[2][2][4][2]>(acc_);
        const int row0 = u.pm * 256 + wr * 64 + fr, col0 = u.pn * 256 + wc * 32 + 8 * fq, b = u.pm >> 5, wid = wr * 4 + wc, tid = wid * 64 + fq * 16 + fr;
        LAS float* P = (LAS float*)xl; LAS float* S = (LAS float*)(xl + 4096);
        {
            f32x4 gt[2][2];
#pragma unroll
            for (int bj = 0; bj < 2; ++bj) { gt[bj][0] = *(const f32x4*)(MOD + b * 3072 + 2048 + col0 + bj * 128); gt[bj][1] = *(const f32x4*)(MOD + b * 3072 + 2048 + col0 + bj * 128 + 4); }
#pragma unroll
            for (int ai = 0; ai < 2; ++ai)
#pragma unroll
                for (int m = 0; m < 4; ++m) {
                    const size_t row = (size_t)(row0 + ai * 128 + m * 16);
                    float ss = 0.f;
#pragma unroll
                    for (int bj = 0; bj < 2; ++bj) {
                        const f32x4 xa = *(const f32x4*)(x + row * 1024 + col0 + bj * 128), xb = *(const f32x4*)(x + row * 1024 + col0 + bj * 128 + 4);
                        const f32x4 o0 = xa + gt[bj][0] * acc[ai][bj][m][0], o1 = xb + gt[bj][1] * acc[ai][bj][m][1];
                        acc[ai][bj][m][0] = o0; acc[ai][bj][m][1] = o1;
                        ss += (o0[0] * o0[0] + o0[1] * o0[1]) + (o0[2] * o0[2] + o0[3] * o0[3]) + (o1[0] * o1[0] + o1[1] * o1[1]) + (o1[2] * o1[2] + o1[3] * o1[3]);
                    }
                    ss += __shfl_xor(ss, 16); ss += __shfl_xor(ss, 32);
                    if (fq == 0) P[(ai * 128 + wr * 64 + m * 16 + fr) * 4 + wc] = ss;
                }
        }
        asm volatile("s_waitcnt lgkmcnt(0)" ::: "memory"); __builtin_amdgcn_s_barrier(); asm volatile("" ::: "memory");
        if (tid < 256) {
            const float t = (P[tid * 4 + 0] + P[tid * 4 + 1]) + (P[tid * 4 + 2] + P[tid * 4 + 3]);
            __hip_atomic_store(xbuf + ((size_t)(u.pm * 256 + tid) * 4 + u.pn), t, __ATOMIC_RELAXED, __HIP_MEMORY_SCOPE_AGENT);
        }
        asm volatile("s_waitcnt vmcnt(0)" ::: "memory");
        if (wid < 4 && fq == 0 && fr == 0) __hip_atomic_fetch_add(cnt + 64 * u.pm, 1u, __ATOMIC_RELAXED, __HIP_MEMORY_SCOPE_AGENT);
        if (wid == 0) {
            unsigned sp = 0;
            while ((unsigned)__builtin_amdgcn_readfirstlane(__hip_atomic_load(cnt + 64 * u.pm, __ATOMIC_RELAXED, __HIP_MEMORY_SCOPE_AGENT)) < 16u) { __builtin_amdgcn_s_sleep(2); if (++sp > (1u << 22)) break; }
            __builtin_amdgcn_fence(__ATOMIC_ACQUIRE, "agent");
        }
        asm volatile("s_waitcnt vmcnt(0) lgkmcnt(0)" ::: "memory"); __builtin_amdgcn_s_barrier(); asm volatile("" ::: "memory");
        if (tid < 256) {
            const float* sl = xbuf + (size_t)(u.pm * 256 + tid) * 4;
            const float t = (__hip_atomic_load(sl + 0, __ATOMIC_RELAXED, __HIP_MEMORY_SCOPE_AGENT) + __hip_atomic_load(sl + 1, __ATOMIC_RELAXED, __HIP_MEMORY_SCOPE_AGENT))
                          + (__hip_atomic_load(sl + 2, __ATOMIC_RELAXED, __HIP_MEMORY_SCOPE_AGENT) + __hip_atomic_load(sl + 3, __ATOMIC_RELAXED, __HIP_MEMORY_SCOPE_AGENT));
            S[tid] = 1.0f / sqrtf(t * (1.f / 1024.f) + EPS);
        }
        asm volatile("s_waitcnt vmcnt(0) lgkmcnt(0)" ::: "memory"); __builtin_amdgcn_s_barrier(); asm volatile("" ::: "memory");
        f32x4 fv[2][2];
#pragma unroll
        for (int bj = 0; bj < 2; ++bj) { fv[bj][0] = *(const f32x4*)(fg + col0 + bj * 128); fv[bj][1] = *(const f32x4*)(fg + col0 + bj * 128 + 4); }
#pragma unroll
        for (int ai = 0; ai < 2; ++ai)
#pragma unroll
            for (int m = 0; m < 4; ++m) {
                const int rl = ai * 128 + wr * 64 + m * 16 + fr; const float sr = S[rl]; const size_t row = (size_t)(u.pm * 256 + rl);
#pragma unroll
                for (int bj = 0; bj < 2; ++bj) {
                    *(f32x4*)(out + row * 1024 + col0 + bj * 128) = acc[ai][bj][m][0] * sr * fv[bj][0];
                    *(f32x4*)(out + row * 1024 + col0 + bj * 128 + 4) = acc[ai][bj][m][1] * sr * fv[bj][1];
                }
            }
    }
};

__device__ __forceinline__ int src_col(int n) {
    const int tile = n >> 8, loc = n & 255;
    if (tile < 8) return (loc < 128) ? tile * 128 + loc : 1024 + tile * 128 + (loc - 128);
    if (tile >= 12 && tile < 24) { const int p = loc & 63; if (p < 16) return (n & ~63) + (p & 3) + ((p >> 2) & 1) * 8 + ((p >> 3) & 1) * 4; }
    return n;
}
template <bool PERMUTE>
__device__ __forceinline__ void transpose_item(const float* W, int K, int N, bf16_t* WT, LAS float* scr, int item, int lane) {
    const int nblk = N / 32, kb = item / nblk, nb = item % nblk, k0 = 64 * kb, n0 = 32 * nb;
    const int sn = PERMUTE ? src_col(n0 + (lane & 31)) : n0 + (lane & 31);
#pragma unroll 8
    for (int i = 0; i < 32; ++i) { const int kk = 2 * i + (lane >> 5); scr[kk * 33 + (lane & 31)] = W[(size_t)(k0 + kk) * N + sn]; }
    asm volatile("s_waitcnt lgkmcnt(0)" ::: "memory");
    const int c = lane & 7;
#pragma unroll
    for (int j = 0; j < 4; ++j) { const int n = (lane >> 3) + 8 * j; const LAS float* s = scr + (8 * c) * 33 + n;
        u32x4 o; o.x = pk2(s[0 * 33], s[1 * 33]); o.y = pk2(s[2 * 33], s[3 * 33]); o.z = pk2(s[4 * 33], s[5 * 33]); o.w = pk2(s[6 * 33], s[7 * 33]);
        *(u32x4*)(WT + (size_t)(n0 + n) * K + k0 + 8 * c) = o; }
    asm volatile("s_waitcnt lgkmcnt(0)" ::: "memory");
}

__device__ __forceinline__ void conv_oct(const f32x2 (&u)[38], const f32x2 (&w)[31], const f32x2 bias, LAS f32x2* acc) {
#pragma unroll
    for (int tt = 0; tt < 8; ++tt) {
        f32x2 a = bias;
#pragma unroll
        for (int k = 0; k < 31; ++k) a += w[k] * u[tt + k];
        acc[tt * 512] = a;
    }
}
__device__ __forceinline__ void conv_slide(f32x2 (&u)[38], const unsigned* up) {
    unsigned nw[8];
#pragma unroll
    for (int i = 0; i < 8; ++i) nw[i] = up[(long)i * 512];
#pragma unroll
    for (int i = 0; i < 30; ++i) u[i] = u[i + 8];
#pragma unroll
    for (int i = 0; i < 8; ++i) u[30 + i] = (f32x2){bflo(nw[i]), bfhi(nw[i])};
}
__device__ __forceinline__ void conv_item(const Params& p, LAS unsigned char* lds, int it, int tid, bool dummy = false) {
    const bf16_t* U = (const bf16_t*)(p.ws + WS_U); bf16_t* ZC = (bf16_t*)(p.ws + WS_ZC);
    const int row0 = it * 32, s0 = row0 & (SEQ - 1), c = 2 * tid;
    f32x2 w[31];
#pragma unroll
    for (int k = 0; k < 31; ++k) w[k] = *(const f32x2*)(p.conv_w + k * 1024 + c);
    const f32x2 bias = *(const f32x2*)(p.conv_b + c);
    const unsigned* up = (const unsigned*)(U + ((long)row0 - 30) * 1024 + c);
    f32x2 u[38];
    {
        unsigned raw[38];
#pragma unroll
        for (int s = 0; s < 30; ++s) raw[s] = 0u;
        if (s0 > 0) {
#pragma unroll
            for (int s = 0; s < 30; ++s) raw[s] = up[(long)s * 512];
        }
#pragma unroll
        for (int s = 30; s < 38; ++s) raw[s] = up[(long)s * 512];
#pragma unroll
        for (int s = 0; s < 38; ++s) u[s] = (f32x2){bflo(raw[s]), bfhi(raw[s])};
    }
    LAS f32x2* red = (LAS f32x2*)lds;
    LAS f32x2* stats = (LAS f32x2*)(lds + 131072);
    conv_oct(u, w, bias, red + tid);
    conv_slide(u, up + 38L * 512); conv_oct(u, w, bias, red + 8 * 512 + tid);
    conv_slide(u, up + 46L * 512); conv_oct(u, w, bias, red + 16 * 512 + tid);
    conv_slide(u, up + 54L * 512); conv_oct(u, w, bias, red + 24 * 512 + tid);
    __syncthreads();
    {
        const int t = tid >> 4, part = tid & 15; float s1 = 0.f, s2 = 0.f;
#pragma unroll 8
        for (int i = 0; i < 32; ++i) { const f32x2 v = red[t * 512 + part + 16 * i]; s1 += v.x + v.y; s2 += v.x * v.x + v.y * v.y; }
#pragma unroll
        for (int o = 1; o < 16; o <<= 1) { s1 += __shfl_xor(s1, o); s2 += __shfl_xor(s2, o); }
        if (part == 0) { const float mean = s1 * (1.f / 1024.f); const float var = fmaxf(s2 * (1.f / 1024.f) - mean * mean, 0.f); stats[t] = (f32x2){mean, 1.0f / sqrtf(var + EPS)}; }
    }
    __syncthreads();
    const f32x2 g2 = *(const f32x2*)(p.ln_g + c), b2 = *(const f32x2*)(p.ln_b + c);
    unsigned* zp = (unsigned*)(ZC + (size_t)row0 * 1024 + c); unsigned* op = dummy ? (unsigned*)((bf16_t*)p.out + (size_t)row0 * 1024 + c) : zp;
#pragma unroll
    for (int t = 0; t < 32; ++t) {
        const f32x2 st = stats[t], av = red[t * 512 + tid];
        float y0 = (av.x - st.x) * st.y * g2.x + b2.x, y1 = (av.y - st.x) * st.y * g2.y + b2.y;
        y0 *= sigm(y0); y1 *= sigm(y1);
        const unsigned z = zp[(size_t)t * 512];
        op[(size_t)t * 512] = pk2(y0 * bflo(z), y1 * bfhi(z));
    }
    __syncthreads();
}

typedef short v4i16_t __attribute__((ext_vector_type(4)));
__device__ __forceinline__ s16x4 vtr(const LAS unsigned char* p) { return __builtin_bit_cast(s16x4, __builtin_amdgcn_ds_read_tr16_b64_v4i16((LAS v4i16_t*)p)); }
constexpr int KV_ROWB = 160, LDS_VOFF = 256 * KV_ROWB;
struct AttnPre { u32x4 kv[8]; bf16x8 q0, q1; };
__device__ __forceinline__ void attn_decode(int idx, int& b, int& g, int& j, int& r, int& n, int& sh, size_t& sub) {
    const int q64 = idx & 63; int rest = idx >> 6; j = rest & 7; rest >>= 3; g = rest % 3; b = rest / 3;
    sh = 2 * g; r = q64 >> (6 - sh); n = q64 & ((64 >> sh) - 1);
    sub = ((size_t)(((b * 3 + g) * 8 + j) * SEQ) + ((size_t)r << (13 - sh))) * 64;
}
__device__ __forceinline__ void attn_prefetch(const Params& p, int idx, int tid, int lane, int w, AttnPre& R) {
    const bf16_t* Q = (const bf16_t*)(p.ws + WS_Q); const bf16_t* K = (const bf16_t*)(p.ws + WS_K); const bf16_t* V = (const bf16_t*)(p.ws + WS_V);
    int b, g, j, r, n, sh; size_t sub; attn_decode(idx, b, g, j, r, n, sh, sub);
    const int nprev = n > 0 ? n - 1 : n;
    const size_t rp = sub + (size_t)nprev * 8192 + tid * 8, rc = sub + (size_t)n * 8192 + tid * 8;
    R.kv[0] = *(const u32x4*)(K + rp); R.kv[1] = *(const u32x4*)(K + rp + 4096); R.kv[2] = *(const u32x4*)(K + rc); R.kv[3] = *(const u32x4*)(K + rc + 4096);
    R.kv[4] = *(const u32x4*)(V + rp); R.kv[5] = *(const u32x4*)(V + rp + 4096); R.kv[6] = *(const u32x4*)(V + rc); R.kv[7] = *(const u32x4*)(V + rc + 4096);
    const bf16_t* qptr = Q + sub + (size_t)(n * 128 + 16 * w + (lane & 15)) * 64 + 8 * (lane >> 4);
    R.q0 = *(const bf16x8*)(qptr); R.q1 = *(const bf16x8*)(qptr + 32);
}
__device__ __forceinline__ void attn_stage(LAS unsigned char* lds, int tid, const AttnPre& R) {
    LAS unsigned char* dp = lds + (tid >> 3) * KV_ROWB + (tid & 7) * 16; LAS unsigned char* dc = dp + 128 * KV_ROWB;
    *(LAS u32x4*)(dp) = R.kv[0]; *(LAS u32x4*)(dp + 64 * KV_ROWB) = R.kv[1]; *(LAS u32x4*)(dc) = R.kv[2]; *(LAS u32x4*)(dc + 64 * KV_ROWB) = R.kv[3];
    *(LAS u32x4*)(dp + LDS_VOFF) = R.kv[4]; *(LAS u32x4*)(dp + LDS_VOFF + 64 * KV_ROWB) = R.kv[5]; *(LAS u32x4*)(dc + LDS_VOFF) = R.kv[6]; *(LAS u32x4*)(dc + LDS_VOFF + 64 * KV_ROWB) = R.kv[7];
}
__device__ __forceinline__ void attn_compute(const Params& p, LAS unsigned char* lds, int idx, int lane, int w, const bf16x8 qf0, const bf16x8 qf1) {
    bf16_t* Q = (bf16_t*)(p.ws + WS_Q); float* LSE = (float*)(p.ws + WS_LSE);
    int b, g, j, r, n, sh; size_t sub; attn_decode(idx, b, g, j, r, n, sh, sub);
    const int d = 1 << sh;
    const int fr = lane & 15, fq = lane >> 4;
    const size_t qrow = (size_t)b * SEQ + (size_t)(n * 128 + 16 * w + fr) * d + r;
    bf16_t* qptr = Q + sub + (size_t)(n * 128 + 16 * w + fr) * 64;
    f32x4 s[9];
#pragma unroll
    for (int tp = 0; tp < 9; ++tp) {
        const LAS unsigned char* kb = lds + (16 * (w + tp) + fr) * KV_ROWB + fq * 16;
        const bf16x8 ka = *(const LAS bf16x8*)kb, kc = *(const LAS bf16x8*)(kb + 64);
        f32x4 z = (f32x4){0.f, 0.f, 0.f, 0.f};
        z = __builtin_amdgcn_mfma_f32_16x16x32_bf16(ka, qf0, z, 0, 0, 0);
        s[tp] = __builtin_amdgcn_mfma_f32_16x16x32_bf16(kc, qf1, z, 0, 0, 0);
    }
    const float NEG = -1e30f;
#pragma unroll
    for (int jj = 0; jj < 4; ++jj) { const int key = 4 * fq + jj; if (key < fr) s[0][jj] = NEG; if (key > fr) s[8][jj] = NEG; }
    if (n == 0) {
#pragma unroll
        for (int tp = 0; tp < 8; ++tp) if (w + tp < 8) s[tp] = (f32x4){NEG, NEG, NEG, NEG};
    }
    float mx = NEG;
#pragma unroll
    for (int tp = 0; tp < 9; ++tp) mx = fmaxf(fmaxf(mx, fmaxf(s[tp][0], s[tp][1])), fmaxf(s[tp][2], s[tp][3]));
    mx = fmaxf(mx, __shfl_xor(mx, 16)); mx = fmaxf(mx, __shfl_xor(mx, 32));
    float l = 0.f;
#pragma unroll
    for (int tp = 0; tp < 9; ++tp)
#pragma unroll
        for (int jj = 0; jj < 4; ++jj) { const float e = __builtin_amdgcn_exp2f(s[tp][jj] - mx); s[tp][jj] = e; l += e; }
    u32x4 pw[5];
#pragma unroll
    for (int kp = 0; kp < 4; ++kp) pw[kp] = pack8(s[2 * kp], s[2 * kp + 1]);
    pw[4] = pack8(s[8], (f32x4){0.f, 0.f, 0.f, 0.f});
    f32x4 ot[4];
#pragma unroll
    for (int dt = 0; dt < 4; ++dt) ot[dt] = (f32x4){0.f, 0.f, 0.f, 0.f};
    const LAS unsigned char* vbase = lds + LDS_VOFF + (16 * w + 4 * fq + (fr >> 2)) * KV_ROWB + (fr & 3) * 8;
#pragma unroll
    for (int kp = 0; kp < 5; ++kp)
#pragma unroll
        for (int dt = 0; dt < 4; ++dt) {
            const s16x4 lo = vtr(vbase + (2 * kp) * 16 * KV_ROWB + dt * 32);
            s16x4 hi = (s16x4){0, 0, 0, 0};
            if (kp < 4) hi = vtr(vbase + (2 * kp + 1) * 16 * KV_ROWB + dt * 32);
            const bf16x8 a = (bf16x8){lo[0], lo[1], lo[2], lo[3], hi[0], hi[1], hi[2], hi[3]};
            ot[dt] = __builtin_amdgcn_mfma_f32_16x16x32_bf16(a, __builtin_bit_cast(bf16x8, pw[kp]), ot[dt], 0, 0, 0);
        }
    l += __shfl_xor(l, 16); l += __shfl_xor(l, 32);
    const float inv = 1.0f / l;
#pragma unroll
    for (int dt = 0; dt < 4; ++dt) { u32x2 o; o.x = pk2(ot[dt][0] * inv, ot[dt][1] * inv); o.y = pk2(ot[dt][2] * inv, ot[dt][3] * inv); *(u32x2*)(qptr + 16 * dt + 4 * fq) = o; }
    if (fq == 0) LSE[((size_t)g * M + qrow) * 8 + j] = mx + __log2f(l);
}

__global__ void __launch_bounds__(512, 2) fwd_megakernel(Params p) {
    extern __shared__ __attribute__((aligned(16))) unsigned char lds_raw[];
    LAS unsigned char* lds = (LAS unsigned char*)lds_raw;
    cg::grid_group grid = cg::this_grid();
    int tid, lane, wave, gw;
#define RELANE() do { int t_ = threadIdx.x; asm volatile("" : "+v"(t_)); tid = t_; lane = tid & 63; wave = __builtin_amdgcn_readfirstlane(tid >> 6); gw = bid * 8 + wave; } while (0)
    const int G = gridDim.x, bid = blockIdx.x, NGW = G * 8;
    RELANE();
    unsigned char* ws = p.ws; unsigned char* dout = (unsigned char*)p.out;
    float* MOD = (float*)(ws + WS_MOD); float* CS = (float*)(ws + WS_CS); float* SSQ = (float*)(ws + WS_SSQ);
    bf16_t* W1T = (bf16_t*)(ws + WS_W1T); bf16_t* WCO = (bf16_t*)(ws + WS_WCO); bf16_t* WAO = (bf16_t*)(ws + WS_WAO); bf16_t* WO = (bf16_t*)(ws + WS_WO);
    bf16_t* H = (bf16_t*)(dout + DO_H); bf16_t* ZA = (bf16_t*)(dout + DO_ZA); unsigned char* GC8 = dout + DO_GC;
    unsigned* const barw = (unsigned*)(ws + WS_BAR);
    unsigned* const pcnt = (unsigned*)(ws + WS_BAR + 65536);
    volatile LAS unsigned* const misc = (volatile LAS unsigned*)(lds + 131072 + 1024);
    if (tid == 0) { misc[0] = 0u; misc[1] = 0u; }
    __syncthreads();
    XcdBarrier xbar = xcd_barrier_post(barw, misc);
    if (G == 0x7fffffff) grid.sync();
#define GSYNC() do { xcd_barrier(xbar); RELANE(); } while (0)

    for (int it = bid; it < 96 * 8; it += G) {
        const int cgp = it % 96, kc = it / 96, n0 = cgp * 32, col = tid & 31, ks = tid >> 5;
        float a0 = 0.f, a1 = 0.f, a2 = 0.f, a3 = 0.f;
        const int kb = kc * 128 + ks * 8;
        const float* wp = p.w_ada + (size_t)kb * 3072 + n0 + col; const float* cc = p.c + kb;
#pragma unroll
        for (int k = 0; k < 8; ++k) { const float wv = wp[(size_t)k * 3072]; a0 += cc[k] * wv; a1 += cc[1024 + k] * wv; a2 += cc[2048 + k] * wv; a3 += cc[3072 + k] * wv; }
        LAS float* red = (LAS float*)lds;
        red[(ks * 4 + 0) * 32 + col] = a0; red[(ks * 4 + 1) * 32 + col] = a1; red[(ks * 4 + 2) * 32 + col] = a2; red[(ks * 4 + 3) * 32 + col] = a3;
        __syncthreads();
        if (tid < 128) { const int bb = tid >> 5; float sum = kc == 0 ? p.b_ada[n0 + col] : 0.f;
#pragma unroll
            for (int k2 = 0; k2 < 16; ++k2) sum += red[(k2 * 4 + bb) * 32 + col];
            atomicAdd(MOD + bb * 3072 + n0 + col, sum); }
        __syncthreads();
    }
    GSYNC();

    {
        LAS float* scr = (LAS float*)(lds + wave * 16384);
        constexpr int I1 = 16 * 320, I2 = 16 * 32, I3 = 8 * 32, I4 = 16 * 32;
        for (int it = gw; it < I1 + I2 + I3 + I4; it += NGW) {
            int r = it;
            if (r < I1) { transpose_item<true>(p.w_in, 1024, NIN, W1T, scr, r, lane); continue; } r -= I1;
            if (r < I2) { transpose_item<false>(p.w_co, 1024, 1024, WCO, scr, r, lane); continue; } r -= I2;
            if (r < I3) { transpose_item<false>(p.w_ao, 512, 1024, WAO, scr, r, lane); continue; } r -= I3;
            transpose_item<false>(p.w_o, 1024, 1024, WO, scr, r, lane);
        }
    }
    for (int e = bid * 512 + tid; e < M * 8; e += G * 512) {
        const int row = e >> 3, i = e & 7;
        const float fi = i == 0 ? p.f0 : i == 1 ? p.f1 : i == 2 ? p.f2 : i == 3 ? p.f3 : i == 4 ? p.f4 : i == 5 ? p.f5 : i == 6 ? p.f6 : p.f7;
        const float ang = (float)p.pos[row] * fi;
        const double rev = (double)ang * 0.15915494309189535; const float frac = (float)(rev - __builtin_rint(rev));
        CS[row * 16 + i] = __builtin_amdgcn_cosf(frac); CS[row * 16 + 8 + i] = __builtin_amdgcn_sinf(frac);
    }
    for (int row = gw; row < M; row += NGW) {
        const f32x4* xr = (const f32x4*)(p.x + (size_t)row * 1024) + lane; f32x4 v[4]; float ss = 0.f;
#pragma unroll
        for (int jx = 0; jx < 4; ++jx) { v[jx] = xr[64 * jx]; ss += (v[jx][0] * v[jx][0] + v[jx][1] * v[jx][1]) + (v[jx][2] * v[jx][2] + v[jx][3] * v[jx][3]); }
        const float rstd = 1.0f / sqrtf(wave_sum(ss) * (1.f / 1024.f) + EPS);
        const float* mb = MOD + (row >> 13) * 3072;
#pragma unroll
        for (int jx = 0; jx < 4; ++jx) { const int col = 4 * lane + 256 * jx;
            const f32x4 gg = *(const f32x4*)(p.norm_g + col), scl = *(const f32x4*)(mb + 1024 + col), sft = *(const f32x4*)(mb + col);
            const f32x4 y = v[jx] * rstd * gg * (scl + 1.0f) + sft;
            u32x2 o; o.x = pk2(y[0], y[1]); o.y = pk2(y[2], y[3]); *(u32x2*)(H + (size_t)row * 1024 + col) = o; }
    }
    GSYNC();

    for (int rep = 0; rep < REP_P1; ++rep) {
        pg8::Gemm g{H, W1T, M, NIN, 1024}; pg8::StaticOrder S; S.init(M, NIN, G, bid);
        Epi1 E{ws, dout};
        pg8::gemm_phase<Epi1, pg8::StaticOrder, true, true>(lds, g, S, E);
    }
    GSYNC();

    for (int it = bid; it < 1024 * REP_CONV; it += G) conv_item(p, lds, it & 1023, tid, it < 1024 * (REP_CONV - 1));
    if (bid < 6144) {
        AttnPre R; attn_prefetch(p, bid, tid, lane, wave, R);
        for (int idx = bid; idx < 6144; idx += G) {
            __syncthreads();
            attn_stage(lds, tid, R); const bf16x8 qf0 = R.q0, qf1 = R.q1;
            __syncthreads();
            if (idx + G < 6144) attn_prefetch(p, idx + G, tid, lane, wave, R);
            for (int rep = 0; rep < REP_ATT; ++rep) attn_compute(p, lds, idx, lane, wave, qf0, qf1);
        }
    }
    GSYNC();

    for (int rep = 0; rep < REP_P3; ++rep) {
        const bf16_t* OG = (const bf16_t*)(ws + WS_Q); const float* LSE = (const float*)(ws + WS_LSE); bf16_t* A2 = (bf16_t*)(ws + WS_A2);
        for (int e = bid * 512 + tid; e < M * 64; e += G * 512) {
            const size_t row = (size_t)(e >> 6); const int jc = e & 63, j = jc >> 3;
            const float l0 = LSE[row * 8 + j], l1 = LSE[((size_t)M + row) * 8 + j], l2 = LSE[((size_t)2 * M + row) * 8 + j];
            const float mxl = fmaxf(l0, fmaxf(l1, l2));
            float w0 = __builtin_amdgcn_exp2f(l0 - mxl), w1 = __builtin_amdgcn_exp2f(l1 - mxl), w2 = __builtin_amdgcn_exp2f(l2 - mxl);
            const float inv = 1.0f / (w0 + w1 + w2); w0 *= inv; w1 *= inv; w2 *= inv;
            const int bb = (int)(row >> 13), tt = (int)(row & (SEQ - 1)), c8 = (jc & 7) * 8;
            const u32x4 o0 = *(const u32x4*)(OG + qkv_off(bb, 0, j, tt) + c8), o1 = *(const u32x4*)(OG + qkv_off(bb, 1, j, tt) + c8), o2 = *(const u32x4*)(OG + qkv_off(bb, 2, j, tt) + c8);
            const u32x4 za = *(const u32x4*)(ZA + row * 512 + jc * 8);
            u32x4 o;
#pragma unroll
            for (int q = 0; q < 4; ++q) {
                const float lo = (w0 * bflo(o0[q]) + w1 * bflo(o1[q]) + w2 * bflo(o2[q])) * bflo(za[q]);
                const float hi = (w0 * bfhi(o0[q]) + w1 * bfhi(o1[q]) + w2 * bfhi(o2[q])) * bfhi(za[q]);
                o[q] = pk2(lo, hi);
            }
            *(u32x4*)(A2 + row * 512 + jc * 8) = o;
        }
        pg8::Gemm g{(const bf16_t*)(ws + WS_ZC), WCO, M, 1024, 1024}; pg8::StaticOrder S; S.init(M, 1024, G, bid);
        Epi3 E{GC8, (bf16_t*)(ws + WS_T)};
        pg8::gemm_phase<Epi3, pg8::StaticOrder, true, true>(lds, g, S, E);
    }
    GSYNC();

    for (int rep = 0; rep < REP_P4; ++rep) {
        pg8::Gemm g{(const bf16_t*)(ws + WS_A2), WAO, M, 1024, 512}; pg8::StaticOrder S; S.init(M, 1024, G, bid);
        Epi4 E{ws + WS_GA, (const bf16_t*)(ws + WS_T), (bf16_t*)(ws + WS_MG)};
        pg8::gemm_phase<Epi4, pg8::StaticOrder, true, true>(lds, g, S, E);
    }
    GSYNC();

    for (int rep = 0; rep < REP_P5; ++rep) {
        pg8::Gemm g{(const bf16_t*)(ws + WS_MG), WO, M, 1024, 1024}; pg8::StaticOrder S; S.init(M, 1024, G, bid);
        Epi5 E{p.x, MOD, p.out, p.final_g, SSQ, pcnt, lds + 131072 + 2048};
        pg8::gemm_phase<Epi5, pg8::StaticOrder, true, true>(lds, g, S, E);
    }
}

extern "C" void kernel_launch(void* const* d_in, const int* in_sizes, int n_in, void* d_out, int out_size, void* d_ws, size_t ws_size, hipStream_t stream) {
    static int grid = 0;
    if (grid == 0) {
        if (n_in != 15 || out_size != M * DM || ws_size < WS_END) { fprintf(stderr, "kernel_launch: unexpected sizes (n_in %d, out %d, ws %zu)\n", n_in, out_size, ws_size); grid = -1; return; }
        int dev = 0, cus = 0, per_cu = 0;
        (void)hipGetDevice(&dev); (void)hipDeviceGetAttribute(&cus, hipDeviceAttributeMultiprocessorCount, dev);
        (void)hipFuncSetAttribute((const void*)fwd_megakernel, hipFuncAttributeMaxDynamicSharedMemorySize, LDS_BYTES);
        if (hipOccupancyMaxActiveBlocksPerMultiprocessor(&per_cu, (const void*)fwd_megakernel, 512, LDS_BYTES) != hipSuccess || per_cu < 1) per_cu = 1;
        (void)hipGetLastError();
        grid = cus * per_cu;
    }
    if (grid < 0) return;
    Params p{};
    p.x = (const float*)d_in[0]; p.c = (const float*)d_in[1]; p.pos = (const int*)d_in[2]; p.norm_g = (const float*)d_in[3]; p.w_ada = (const float*)d_in[4]; p.b_ada = (const float*)d_in[5];
    p.w_in = (const float*)d_in[6]; p.conv_w = (const float*)d_in[7]; p.conv_b = (const float*)d_in[8]; p.ln_g = (const float*)d_in[9]; p.ln_b = (const float*)d_in[10];
    p.w_co = (const float*)d_in[11]; p.w_ao = (const float*)d_in[12]; p.w_o = (const float*)d_in[13]; p.final_g = (const float*)d_in[14];
    p.out = (float*)d_out; p.ws = (unsigned char*)d_ws;
    p.f0 = 1.0f; p.f1 = 1.939227432e-01f; p.f2 = 3.760603070e-02f; p.f3 = 7.292664610e-03f; p.f4 = 1.414213562e-03f; p.f5 = 2.742481884e-04f; p.f6 = 5.318295734e-05f; p.f7 = 1.031338525e-05f;
    if (hipMemsetAsync(d_ws, 0, 1 * MiB, stream) != hipSuccess) { fprintf(stderr, "kernel_launch: memset of the control words failed\n"); return; }
    void* args[] = {&p};
    const hipError_t e = hipLaunchCooperativeKernel((const void*)fwd_megakernel, dim3(grid), dim3(512), args, LDS_BYTES, stream);
    if (e != hipSuccess) fprintf(stderr, "cooperative launch failed: %s (grid %d)\n", hipGetErrorString(e), grid);
}
```

```cpp
#include <hip/hip_runtime.h>
#include <hip/hip_cooperative_groups.h>
#include <cstdio>
#include <cstdint>
namespace cg = cooperative_groups;
#define LAS __attribute__((address_space(3)))
namespace pg8 {
#define PG8_LAS __attribute__((address_space(3)))
typedef unsigned short bf16_t;
typedef short bf16x8 __attribute__((ext_vector_type(8)));
typedef float f32x4 __attribute__((ext_vector_type(4)));
typedef unsigned u32x4 __attribute__((ext_vector_type(4)));
constexpr int BM = 256, BK = 64, HALF = 128, HTB = HALF * BK * 2  , STAGE_BYTES = 8 * HTB, NXCD = 8, WGM = 8;

__host__ __device__ __forceinline__ int lds_byte(int r, int c) { const int st = (r >> 4) * 2 + (c >> 5), rr = r & 15, cc = c & 31, ob = rr * 64 + cc * 2; return st * 1024 + (ob ^ (((ob >> 9) & 1) << 5)); }
__host__ __device__ __forceinline__ void stage_rc(int b, int& R, int& C) { const int st = b / 1024, sb = b % 1024, swz = sb ^ (((sb >> 9) & 1) << 5); R = (st >> 1) * 16 + swz / 64; C = (st & 1) * 32 + (swz % 64) / 2; }
__host__ __device__ __forceinline__ int perm32(int rho) { const int n = rho >> 4, i = rho & 15; return 8 * (i >> 2) + 4 * n + (i & 3); }

struct Unit { int pm, pn, kind; };
struct Gemm { const bf16_t* A; const bf16_t* Bt; int M, N, K; const bf16_t* A1; const bf16_t* Bt1; int nt0, nt1; };

struct StaticOrder {
    int nM, nN, nwg, G, c;
    __host__ __device__ void init(int M, int N, int G_, int c_) { nM = M / BM; nN = N / BM; nwg = nM * nN; G = G_; c = c_; }
    __host__ __device__ bool next(int i, Unit& u) const {
        const long L = (long)i * G + c; if (L >= nwg) return false;
        int wgid = (int)L; { const int q = nwg / NXCD, r = nwg % NXCD, xcd = wgid % NXCD, off = wgid / NXCD; wgid = (xcd < r ? xcd * (q + 1) : r * (q + 1) + (xcd - r) * q) + off; }
        const int nig = WGM * nN, gid = wgid / nig, fm = gid * WGM, gsz = (nM - fm) < WGM ? (nM - fm) : WGM;
        u.pm = fm + ((wgid % nig) % gsz); u.pn = (wgid % nig) / gsz; u.kind = 0; return true;
    }
    __device__ __forceinline__ void a_ready(const Unit&) const {}
    __device__ __forceinline__ void done(const Unit&) const {}
};

__device__ __forceinline__ unsigned cvt_pk_bf16(float lo, float hi) { unsigned r; asm volatile("v_cvt_pk_bf16_f32 %0, %1, %2" : "=v"(r) : "v"(lo), "v"(hi)); return r; }
typedef float f32x2 __attribute__((ext_vector_type(2)));
struct PairOrder {
    StaticOrder base;
    __host__ __device__ void init(int M, int N, int G_, int c_) { base.init(M, N, G_, c_); }
    __host__ __device__ bool next(int i, Unit& u) const { if (!base.next(i >> 1, u)) return false; u.kind = i & 1; return true; }
    __device__ __forceinline__ void a_ready(const Unit&) const {}
    __device__ __forceinline__ void done(const Unit&) const {}
};
template <class Epi, class Sched, bool ALIGN_EPI = false, bool SP2 = false>
__device__ __forceinline__ void gemm_phase(PG8_LAS unsigned char* lds, const Gemm g, const Sched& S, const Epi& E) {
    int tid_ = threadIdx.x; asm volatile("" : "+v"(tid_));
    const int tid = tid_, wid = __builtin_amdgcn_readfirstlane(tid >> 6), lane = tid & 63, wr = wid >> 2, wc = wid & 3, fr = lane & 15, fq = lane >> 4;
    const int K = g.K;
    unsigned voffA[2], voffB[2];
#pragma unroll
    for (int i = 0; i < 2; ++i) { int R, C; stage_rc(tid * 16 + i * 8192, R, C); const int Rb = Epi::PERM ? ((R & ~31) + perm32(R & 31)) : R;
        voffA[i] = (unsigned)(R * K + C) * 2u; voffB[i] = (unsigned)(Rb * K + C) * 2u; }
    const size_t kstep = (size_t)(BK * 2);
    const size_t hstep = (size_t)HALF * K * 2;
    const size_t tstep = 2 * hstep;
    const unsigned ldsw = (unsigned)wid * 1024u;
    const int aoff = lds_byte(wr * 64 + fr, fq * 8), boff = lds_byte(wc * 32 + fr, fq * 8);
#define PG8_SA(b, h) (((b) * 2 + (h)) * HTB)
#define PG8_SB(b, h) ((4 + (b) * 2 + (h)) * HTB)
#define PG8_STAGE(bufoff, gbase, voff) do { _Pragma("unroll") for (int _i = 0; _i < 2; ++_i) \
        __builtin_amdgcn_global_load_lds((const unsigned*)((const char*)(gbase) + (voff)[_i]), (PG8_LAS unsigned*)(lds + (bufoff) + ldsw + _i * 8192), 16, 0, 0); } while (0)
#define PG8_LDA(dst, b, h) do { _Pragma("unroll") for (int m = 0; m < 4; ++m) _Pragma("unroll") for (int k = 0; k < 2; ++k) dst[m][k] = *(const PG8_LAS bf16x8*)(lds + PG8_SA(b, h) + aoff + m * 2048 + k * 1024); } while (0)
#define PG8_LDB(dst, b, h) do { _Pragma("unroll") for (int n = 0; n < 2; ++n) _Pragma("unroll") for (int k = 0; k < 2; ++k) dst[n][k] = *(const PG8_LAS bf16x8*)(lds + PG8_SB(b, h) + boff + n * 2048 + k * 1024); } while (0)
#define PG8_MMA(ai, bj, At, Bt) do { __builtin_amdgcn_s_setprio(1); _Pragma("unroll") for (int m = 0; m < 4; ++m) _Pragma("unroll") for (int n = 0; n < 2; ++n) _Pragma("unroll") for (int k = 0; k < 2; ++k) \
        acc[ai][bj][m][n] = __builtin_amdgcn_mfma_f32_16x16x32_bf16(Bt[n][k], At[m][k], acc[ai][bj][m][n], 0, 0, 0); __builtin_amdgcn_s_setprio(0); } while (0)
#define PG8_WAIT_V(n) asm volatile("s_waitcnt vmcnt(" #n ")" ::: "memory")
#define PG8_WAIT_L(n) asm volatile("s_waitcnt lgkmcnt(" #n ")" ::: "memory")
#define PG8_BAR __builtin_amdgcn_s_barrier()
#define PG8_SCHED __builtin_amdgcn_sched_barrier(0)
    Unit cur, nxt; int ui = 0;
    if (!S.next(0, cur)) return;
    f32x4 acc[2][2][4][2];
#pragma unroll
    for (int a = 0; a < 2; ++a)
#pragma unroll
        for (int b = 0; b < 2; ++b)
#pragma unroll
            for (int m = 0; m < 4; ++m)
#pragma unroll
                for (int n = 0; n < 2; ++n) acc[a][b][m][n] = (f32x4){0.f, 0.f, 0.f, 0.f};
    bf16x8 At[4][2], B0[2][2], B1[2][2];
    const char* cA = (const char*)(cur.kind ? g.A1 : g.A) + (size_t)cur.pm * tstep; const char* cB = (const char*)(cur.kind ? g.Bt1 : g.Bt) + (size_t)cur.pn * tstep;
    S.a_ready(cur);
    if constexpr (SP2) {
        PG8_STAGE(PG8_SB(0, 0), cB, voffB); PG8_STAGE(PG8_SB(0, 1), cB + hstep, voffB); PG8_STAGE(PG8_SA(0, 0), cA, voffA); PG8_STAGE(PG8_SA(0, 1), cA + hstep, voffA);
        if (wr == 1) PG8_BAR;
        PG8_WAIT_V(2); PG8_BAR;
        PG8_STAGE(PG8_SB(1, 0), cB + kstep, voffB); PG8_STAGE(PG8_SA(1, 0), cA + kstep, voffA); PG8_STAGE(PG8_SB(1, 1), cB + hstep + kstep, voffB);
        PG8_WAIT_V(6); PG8_BAR;
    } else {
        PG8_STAGE(PG8_SB(0, 0), cB, voffB); PG8_STAGE(PG8_SA(0, 0), cA, voffA); PG8_STAGE(PG8_SB(0, 1), cB + hstep, voffB); PG8_STAGE(PG8_SA(0, 1), cA + hstep, voffA);
        if (wr == 1) PG8_BAR;
        PG8_WAIT_V(4); PG8_BAR;
        PG8_STAGE(PG8_SB(1, 0), cB + kstep, voffB); PG8_STAGE(PG8_SA(1, 0), cA + kstep, voffA); PG8_STAGE(PG8_SB(1, 1), cB + hstep + kstep, voffB);
        PG8_WAIT_V(6); PG8_BAR;
    }
    for (;;) {
        const bool has_next = S.next(ui + 1, nxt);
        const char* nA = has_next ? (const char*)(nxt.kind ? g.A1 : g.A) + (size_t)nxt.pm * tstep : cA; const char* nB = has_next ? (const char*)(nxt.kind ? g.Bt1 : g.Bt) + (size_t)nxt.pn * tstep : cB;
        const int nt = cur.kind ? g.nt1 : g.nt0;
        for (int t = 0; t < nt; t += 2) {
            const bool last = (t == nt - 2);
            const char* a1 = cA + (size_t)(t + 1) * kstep;
            const char* a2 = last ? nA : cA + (size_t)(t + 2) * kstep; const char* b2 = last ? nB : cB + (size_t)(t + 2) * kstep;
            const char* a3 = a2 + kstep; const char* b3 = b2 + kstep;
            if (last && has_next) S.a_ready(nxt);
            if constexpr (SP2) {
            PG8_LDB(B0, 0, 0); PG8_LDB(B1, 0, 1); PG8_SCHED; PG8_LDA(At, 0, 0); PG8_STAGE(PG8_SA(1, 1), a1 + hstep, voffA);
            PG8_WAIT_V(8); PG8_WAIT_L(0); PG8_BAR; PG8_MMA(0, 0, At, B0); PG8_MMA(0, 1, At, B1); PG8_BAR; PG8_SCHED;
            PG8_LDA(At, 0, 1); PG8_STAGE(PG8_SB(0, 0), b2, voffB); PG8_STAGE(PG8_SB(0, 1), b2 + hstep, voffB); PG8_STAGE(PG8_SA(0, 0), a2, voffA);
            PG8_WAIT_V(8); PG8_WAIT_L(0); PG8_BAR; PG8_MMA(1, 0, At, B0); PG8_MMA(1, 1, At, B1); PG8_BAR; PG8_SCHED;
            PG8_LDB(B0, 1, 0); PG8_LDB(B1, 1, 1); PG8_SCHED; PG8_LDA(At, 1, 0); PG8_STAGE(PG8_SA(0, 1), a2 + hstep, voffA);
            PG8_WAIT_V(8); PG8_WAIT_L(0); PG8_BAR; PG8_MMA(0, 0, At, B0); PG8_MMA(0, 1, At, B1); PG8_BAR; PG8_SCHED;
            PG8_LDA(At, 1, 1); PG8_STAGE(PG8_SB(1, 0), b3, voffB); PG8_STAGE(PG8_SB(1, 1), b3 + hstep, voffB); PG8_STAGE(PG8_SA(1, 0), a3, voffA);
            PG8_WAIT_V(8); PG8_WAIT_L(0); PG8_BAR; PG8_MMA(1, 0, At, B0); PG8_MMA(1, 1, At, B1); PG8_BAR; PG8_SCHED;
            } else {
            PG8_LDB(B0, 0, 0); PG8_SCHED; PG8_LDA(At, 0, 0); PG8_STAGE(PG8_SA(1, 1), a1 + hstep, voffA);
            PG8_WAIT_L(8); PG8_BAR; PG8_WAIT_L(0); PG8_MMA(0, 0, At, B0); PG8_BAR; PG8_SCHED;
            PG8_LDB(B1, 0, 1); PG8_STAGE(PG8_SB(0, 0), b2, voffB);
            PG8_BAR; PG8_WAIT_L(0); PG8_MMA(0, 1, At, B1); PG8_BAR;
            PG8_LDA(At, 0, 1); PG8_STAGE(PG8_SA(0, 0), a2, voffA);
            PG8_BAR; PG8_WAIT_L(0); PG8_MMA(1, 0, At, B0); PG8_BAR; PG8_SCHED;
            PG8_STAGE(PG8_SB(0, 1), b2 + hstep, voffB);
            PG8_WAIT_V(6); PG8_BAR; PG8_MMA(1, 1, At, B1); PG8_BAR;
            PG8_LDB(B0, 1, 0); PG8_SCHED; PG8_LDA(At, 1, 0); PG8_STAGE(PG8_SA(0, 1), a2 + hstep, voffA);
            PG8_WAIT_L(8); PG8_BAR; PG8_WAIT_L(0); PG8_MMA(0, 0, At, B0); PG8_BAR; PG8_SCHED;
            PG8_LDB(B1, 1, 1); PG8_STAGE(PG8_SB(1, 0), b3, voffB);
            PG8_BAR; PG8_WAIT_L(0); PG8_MMA(0, 1, At, B1); PG8_BAR;
            PG8_LDA(At, 1, 1); PG8_STAGE(PG8_SA(1, 0), a3, voffA);
            PG8_BAR; PG8_WAIT_L(0); PG8_MMA(1, 0, At, B0); PG8_BAR; PG8_SCHED;
            PG8_STAGE(PG8_SB(1, 1), b3 + hstep, voffB);
            PG8_WAIT_V(6); PG8_BAR; PG8_MMA(1, 1, At, B1); PG8_BAR;
            }
        }
        if constexpr (ALIGN_EPI) { if (wr == 0) PG8_BAR; }
        bool keep = false;
        if constexpr (Epi::PAIRED) keep = (cur.kind == 0);
        if constexpr (!Epi::AFTER_DRAIN) { if constexpr (Epi::PAIRED) { if (keep) E.mid(acc, cur, wr, wc, fr, fq); else E(acc, cur, wr, wc, fr, fq); } else E(acc, cur, wr, wc, fr, fq); S.done(cur); }
        if (!has_next) break;
        if (!keep) {
#pragma unroll
        for (int a = 0; a < 2; ++a)
#pragma unroll
            for (int b = 0; b < 2; ++b)
#pragma unroll
                for (int m = 0; m < 4; ++m)
#pragma unroll
                    for (int n = 0; n < 2; ++n) acc[a][b][m][n] = (f32x4){0.f, 0.f, 0.f, 0.f};
        }
        cur = nxt; cA = nA; cB = nB; ++ui;
        if constexpr (ALIGN_EPI) { if (wr == 1) PG8_BAR; }
    }
    PG8_WAIT_V(0);
    if constexpr (!ALIGN_EPI) { if (wr == 0) PG8_BAR; }
    PG8_BAR;
    if constexpr (Epi::AFTER_DRAIN) { E.fused(acc, cur, wr, wc, fr, fq, lds, wid, lane); S.done(cur); }
#undef PG8_SA
#undef PG8_SB
#undef PG8_STAGE
#undef PG8_LDA
#undef PG8_LDB
#undef PG8_MMA
#undef PG8_WAIT_V
#undef PG8_WAIT_L
#undef PG8_BAR
#undef PG8_SCHED
}
}
#define XB_TMO      128
#define XB_XCNT(j)  (256  + 64 * (j))
#define XB_XSUB(j)  (1280 + 64 * (j))
#define XB_XGEN(j)  (2304 + 64 * (j))
#define XB_TOP      3328
#define XB_TOPGEN   3392
#define XCD_BAR_WORDS 3456
#define XB_SPIN_CAP (1u << 18)

__device__ __forceinline__ unsigned xb_ld(unsigned* p)              { return __hip_atomic_load(p, __ATOMIC_RELAXED, __HIP_MEMORY_SCOPE_AGENT); }
__device__ __forceinline__ unsigned xb_add(unsigned* p, unsigned v) { return __hip_atomic_fetch_add(p, v, __ATOMIC_RELAXED, __HIP_MEMORY_SCOPE_AGENT); }
__device__ __forceinline__ unsigned xb_xcc_id() { return (unsigned)__builtin_amdgcn_s_getreg((3 << 11) | 20) & 0xFu; }
#define XB_SPIN(cond, bar) do { unsigned _sp = 0; while (cond) { __builtin_amdgcn_s_sleep(1); \
    if ((++_sp & 255u) == 0u) { if (xb_ld(&(bar)[XB_TMO])) break; if (_sp > XB_SPIN_CAP) { atomicAdd(&(bar)[XB_TMO], 1u); break; } } } } while (0)

struct XcdBarrier {
    unsigned* bar; unsigned x;
    volatile LAS unsigned* st;
};

__device__ __forceinline__ XcdBarrier xcd_barrier_post(unsigned* bar, volatile LAS unsigned* st) {
    XcdBarrier b; b.bar = bar; b.x = xb_xcc_id(); b.st = st;
    if (threadIdx.x == 0) (void)xb_add(&bar[XB_XCNT(b.x)], 1u);
    return b;
}
__device__ __forceinline__ void xcd_barrier_complete(unsigned* bar, unsigned x, unsigned& nloc, unsigned& nx) {
    const unsigned G = gridDim.x * gridDim.y * gridDim.z;
    unsigned sum, cnt, mine, sp = 0u;
    for (;;) {
        sum = 0u; cnt = 0u; mine = 0u;
#pragma unroll
        for (unsigned j = 0; j < 16; ++j) { const unsigned c = xb_ld(&bar[XB_XCNT(j)]); sum += c; cnt += (c > 0u) ? 1u : 0u; mine = (j == x) ? c : mine; }
        if (sum == G) break;
        __builtin_amdgcn_s_sleep(1);
        if ((++sp & 255u) == 0u) { if (xb_ld(&bar[XB_TMO])) break; if (sp > XB_SPIN_CAP) { atomicAdd(&bar[XB_TMO], 1u); break; } }
    }
    nloc = mine > 0u ? mine : 1u; nx = cnt > 0u ? cnt : 1u;
}

__device__ __forceinline__ void xcd_barrier(const XcdBarrier& b) {
    asm volatile("s_waitcnt vmcnt(0)" ::: "memory");
    __syncthreads();
    if (threadIdx.x == 0) {
        unsigned* bar = b.bar;
        __builtin_amdgcn_s_waitcnt(0);
        unsigned nloc = b.st[0], nx = b.st[1];
        if (nloc == 0u) { xcd_barrier_complete(bar, b.x, nloc, nx); b.st[0] = nloc; b.st[1] = nx; }
        const unsigned old = xb_add(&bar[XB_XSUB(b.x)], 1u);
        const unsigned gen = old / nloc;
        if (old + 1u == (gen + 1u) * nloc) {
            __builtin_amdgcn_fence(__ATOMIC_RELEASE, "agent");
            asm volatile("s_waitcnt vmcnt(0)" ::: "memory");
            const unsigned og = xb_add(&bar[XB_TOP], 1u);
            const unsigned tg = og / nx;
            if (og + 1u == (tg + 1u) * nx) xb_add(&bar[XB_TOPGEN], 1u);
            else XB_SPIN(xb_ld(&bar[XB_TOPGEN]) == tg, bar);
            __builtin_amdgcn_fence(__ATOMIC_ACQUIRE, "agent");
            xb_add(&bar[XB_XGEN(b.x)], 1u);
            asm volatile("s_waitcnt vmcnt(0)" ::: "memory");
        } else {
            XB_SPIN(xb_ld(&bar[XB_XGEN(b.x)]) == gen, bar);
            __builtin_amdgcn_fence(__ATOMIC_ACQUIRE, "agent");
            asm volatile("s_waitcnt vmcnt(0)" ::: "memory");
        }
    }
    __syncthreads();
}

typedef unsigned short bf16_t;
typedef short bf16x8 __attribute__((ext_vector_type(8)));
typedef short s16x4 __attribute__((ext_vector_type(4)));
typedef float f32x4 __attribute__((ext_vector_type(4)));
typedef unsigned u32x4 __attribute__((ext_vector_type(4)));
typedef unsigned u32x2 __attribute__((ext_vector_type(2)));
typedef float f32x2 __attribute__((ext_vector_type(2)));

constexpr int NB = 4, SEQ = 8192, DM = 1024, M = NB * SEQ, NIN = 10240, QP = 1536;
constexpr size_t MiB = 1u << 20;
constexpr size_t WS_BAR = 512 * 1024  , WS_MOD = 0, WS_CS = 1 * MiB, WS_SSQ = 3 * MiB, WS_LSE = 5 * MiB, WS_W1T = 8 * MiB, WS_WCO = 28 * MiB, WS_WAO = 30 * MiB, WS_WO = 32 * MiB,
                 WS_U = 36 * MiB, WS_ZC = 100 * MiB, WS_Q = 164 * MiB, WS_K = 260 * MiB, WS_V = 356 * MiB, WS_GA = 452 * MiB, WS_END = 484 * MiB;
constexpr size_t WS_MG = WS_U, WS_A2 = WS_V;
constexpr size_t DO_H = 0, DO_ZA = 64 * MiB, DO_GC = 96 * MiB;
constexpr int LDS_BYTES = 147456;
constexpr int REP_P0 = 1, REP_P1 = 1, REP_P3 = 1, REP_P4 = 1, REP_P5 = 1, REP_CONV = 1, REP_ATT = 1;
constexpr float QSCALE = 0.125f * 1.4426950408889634f;
constexpr float EPS = 1e-6f;

struct Params {
    const float *x, *c; const int* pos; const float *norm_g, *w_ada, *b_ada, *w_in, *conv_w, *conv_b, *ln_g, *ln_b, *w_co, *w_ao, *w_o, *final_g;
    float* out; unsigned char* ws;
    float f0, f1, f2, f3, f4, f5, f6, f7;
};

__device__ __forceinline__ unsigned pk2(float lo, float hi) { return pg8::cvt_pk_bf16(lo, hi); }
__device__ __forceinline__ float bflo(unsigned w) { return __uint_as_float(w << 16); }
__device__ __forceinline__ float bfhi(unsigned w) { return __uint_as_float(w & 0xffff0000u); }
__device__ __forceinline__ float sigm(float x) { return __builtin_amdgcn_rcpf(1.f + __expf(-x)); }
__device__ __forceinline__ float wave_sum(float v) {
#pragma unroll
    for (int o = 1; o < 64; o <<= 1) v += __shfl_xor(v, o);
    return v;
}
__device__ __forceinline__ u32x4 pack8(const f32x4 a, const f32x4 b) { u32x4 w; w.x = pk2(a[0], a[1]); w.y = pk2(a[2], a[3]); w.z = pk2(b[0], b[1]); w.w = pk2(b[2], b[3]); return w; }
__device__ __forceinline__ f32x4 sigm4(const f32x4 v) { return (f32x4){sigm(v[0]), sigm(v[1]), sigm(v[2]), sigm(v[3])}; }
__device__ __forceinline__ unsigned un8x4(const f32x4 s) {
    const unsigned a = (unsigned)(s[0] * 255.f + 0.5f), b = (unsigned)(s[1] * 255.f + 0.5f), c = (unsigned)(s[2] * 255.f + 0.5f), d = (unsigned)(s[3] * 255.f + 0.5f);
    return a | (b << 8) | (c << 16) | (d << 24);
}
__device__ __forceinline__ f32x4 deq8(unsigned w) { return (f32x4){(float)(w & 255u), (float)((w >> 8) & 255u), (float)((w >> 16) & 255u), (float)(w >> 24)} * (1.0f / 255.0f); }
__device__ __forceinline__ f32x4 byte4(unsigned w) { return (f32x4){(float)(w & 255u), (float)((w >> 8) & 255u), (float)((w >> 16) & 255u), (float)(w >> 24)}; }
__device__ __forceinline__ f32x4 clamp1(const f32x4 v) { return (f32x4){fmaxf(v[0], 1.f), fmaxf(v[1], 1.f), fmaxf(v[2], 1.f), fmaxf(v[3], 1.f)}; }
__device__ __forceinline__ f32x4 deq8c(unsigned w) { return clamp1(byte4(w)) * (1.0f / 255.0f); }
__device__ __forceinline__ f32x4 ratio8(unsigned num, unsigned den) { const f32x4 d = clamp1(byte4(den)); return byte4(num) * (f32x4){__builtin_amdgcn_rcpf(d[0]), __builtin_amdgcn_rcpf(d[1]), __builtin_amdgcn_rcpf(d[2]), __builtin_amdgcn_rcpf(d[3])}; }
__device__ __forceinline__ f32x4 bf4lo(unsigned w0, unsigned w1) { return (f32x4){bflo(w0), bfhi(w0), bflo(w1), bfhi(w1)}; }

__device__ __forceinline__ size_t qkv_off(int b, int g, int j, int t) { const int sh = 2 * g; return ((size_t)(((b * 3 + g) * 8 + j) * SEQ + ((t & ((1 << sh) - 1)) << (13 - sh)) + (t >> sh))) * 64; }

struct Epi1 {
    static constexpr bool PERM = true, AFTER_DRAIN = false, PAIRED = false;
    unsigned char *ws, *dout;
    __device__ __forceinline__ void operator()(const f32x4 (&acc)[2][2][4][2], const pg8::Unit& u, int wr, int wc, int fr, int fq) const {
        const int pn = u.pn, row0 = u.pm * 256 + wr * 64 + fr, cl = wc * 32 + 8 * fq;
        bf16_t* const U = (bf16_t*)(ws + WS_U); bf16_t* const ZC = (bf16_t*)(ws + WS_ZC); bf16_t* const Q = (bf16_t*)(ws + WS_Q); bf16_t* const K = (bf16_t*)(ws + WS_K); bf16_t* const V = (bf16_t*)(ws + WS_V);
        bf16_t* const ZA = (bf16_t*)(dout + DO_ZA); unsigned char* const GC8 = dout + DO_GC; unsigned char* const GA8 = ws + WS_GA; const float* const CS = (const float*)(ws + WS_CS);
        if (pn < 8) {
#pragma unroll
            for (int ai = 0; ai < 2; ++ai)
#pragma unroll
                for (int m = 0; m < 4; ++m) {
                    const size_t row = (size_t)(row0 + ai * 128 + m * 16);
                    const f32x4 a0 = acc[ai][0][m][0] * sigm4(acc[ai][1][m][0]), a1 = acc[ai][0][m][1] * sigm4(acc[ai][1][m][1]);
                    *(u32x4*)(U + row * 1024 + pn * 128 + cl) = pack8(a0, a1);
                }
        } else if (pn < 12 || pn == 30 || pn == 31) {
            bf16_t* base = pn < 12 ? ZC : ZA; const int pitch = pn < 12 ? 1024 : 512, col0 = (pn < 12 ? (pn - 8) : (pn - 30)) * 256 + cl;
#pragma unroll
            for (int ai = 0; ai < 2; ++ai)
#pragma unroll
                for (int m = 0; m < 4; ++m) {
                    const size_t row = (size_t)(row0 + ai * 128 + m * 16);
#pragma unroll
                    for (int bj = 0; bj < 2; ++bj) {
                        const f32x4 v0 = acc[ai][bj][m][0], v1 = acc[ai][bj][m][1];
                        *(u32x4*)(base + row * pitch + col0 + bj * 128) = pack8(v0 * sigm4(v0), v1 * sigm4(v1));
                    }
                }
        } else if (pn < 24) {
            const bool isq = pn < 18; bf16_t* base = isq ? Q : K; const int pl = pn - (isq ? 12 : 18), g = pl >> 1, dim0 = (wc & 1) * 32 + 8 * fq; const float sc = isq ? QSCALE : 1.0f;
            const bool rot = ((wc & 1) == 0) && (fq < 2);
#pragma unroll
            for (int ai = 0; ai < 2; ++ai)
#pragma unroll
                for (int m = 0; m < 4; ++m) {
                    const size_t row = (size_t)(row0 + ai * 128 + m * 16);
                    f32x4 cv = (f32x4){1.f, 1.f, 1.f, 1.f}, sv = (f32x4){0.f, 0.f, 0.f, 0.f};
                    if (rot) { cv = *(const f32x4*)(CS + row * 16 + 4 * fq); sv = *(const f32x4*)(CS + row * 16 + 8 + 4 * fq); }
#pragma unroll
                    for (int bj = 0; bj < 2; ++bj) {
                        const f32x4 v0 = acc[ai][bj][m][0], v1 = acc[ai][bj][m][1];
                        const f32x4 n0 = (v0 * cv - v1 * sv) * sc, n1 = (v1 * cv + v0 * sv) * sc;
                        *(u32x4*)(base + qkv_off((int)(row >> 13), g, (4 * pl + 2 * bj + (wc >> 1)) & 7, (int)(row & (SEQ - 1))) + dim0) = pack8(n0, n1);
                    }
                }
        } else if (pn < 30) {
            const int pl = pn - 24, g = pl >> 1, dim0 = (wc & 1) * 32 + 8 * fq;
#pragma unroll
            for (int ai = 0; ai < 2; ++ai)
#pragma unroll
                for (int m = 0; m < 4; ++m) {
                    const size_t row = (size_t)(row0 + ai * 128 + m * 16);
#pragma unroll
                    for (int bj = 0; bj < 2; ++bj) *(u32x4*)(V + qkv_off((int)(row >> 13), g, (4 * pl + 2 * bj + (wc >> 1)) & 7, (int)(row & (SEQ - 1))) + dim0) = pack8(acc[ai][bj][m][0], acc[ai][bj][m][1]);
                }
        } else {
            unsigned char* base = pn < 36 ? GC8 : GA8; const int col0 = (pn - (pn < 36 ? 32 : 36)) * 256 + cl;
#pragma unroll
            for (int ai = 0; ai < 2; ++ai)
#pragma unroll
                for (int m = 0; m < 4; ++m) {
                    const size_t row = (size_t)(row0 + ai * 128 + m * 16);
#pragma unroll
                    for (int bj = 0; bj < 2; ++bj) { u32x2 w; w.x = un8x4(sigm4(acc[ai][bj][m][0])); w.y = un8x4(sigm4(acc[ai][bj][m][1])); *(u32x2*)(base + row * 1024 + col0 + bj * 128) = w; }
                }
        }
    }
};
struct Epi34 {
    static constexpr bool PERM = true, AFTER_DRAIN = false, PAIRED = true;
    const unsigned char* GC8; const unsigned char* GA8; bf16_t* MG;
    __device__ __forceinline__ void mid(f32x4 (&acc)[2][2][4][2], const pg8::Unit& u, int wr, int wc, int fr, int fq) const {
        const int row0 = u.pm * 256 + wr * 64 + fr, col0 = u.pn * 256 + wc * 32 + 8 * fq;
#pragma unroll
        for (int ai = 0; ai < 2; ++ai)
#pragma unroll
            for (int m = 0; m < 4; ++m) {
                const size_t row = (size_t)(row0 + ai * 128 + m * 16);
#pragma unroll
                for (int bj = 0; bj < 2; ++bj) {
                    const u32x2 gc = *(const u32x2*)(GC8 + row * 1024 + col0 + bj * 128), ga = *(const u32x2*)(GA8 + row * 1024 + col0 + bj * 128);
                    acc[ai][bj][m][0] *= ratio8(gc.x, ga.x); acc[ai][bj][m][1] *= ratio8(gc.y, ga.y);
                }
            }
    }
    __device__ __forceinline__ void operator()(const f32x4 (&acc)[2][2][4][2], const pg8::Unit& u, int wr, int wc, int fr, int fq) const {
        const int row0 = u.pm * 256 + wr * 64 + fr, col0 = u.pn * 256 + wc * 32 + 8 * fq;
#pragma unroll
        for (int ai = 0; ai < 2; ++ai)
#pragma unroll
            for (int m = 0; m < 4; ++m) {
                const size_t row = (size_t)(row0 + ai * 128 + m * 16);
#pragma unroll
                for (int bj = 0; bj < 2; ++bj) {
                    const u32x2 ga = *(const u32x2*)(GA8 + row * 1024 + col0 + bj * 128);
                    *(u32x4*)(MG + row * 1024 + col0 + bj * 128) = pack8(acc[ai][bj][m][0] * deq8c(ga.x), acc[ai][bj][m][1] * deq8c(ga.y));
                }
            }
    }
};
struct Epi5 {
    static constexpr bool PERM = true, AFTER_DRAIN = false, PAIRED = false;
    const float* x; const float* MOD; float* out; const float* fg; float* xbuf; unsigned* cnt; LAS unsigned char* xl;
    __device__ __forceinline__ void operator()(const f32x4 (&acc_)[2][2][4][2], const pg8::Unit& u, int wr, int wc, int fr, int fq) const {
        f32x4 (&acc)[2][2][4][2] = const_cast<f32x4 (&)[2][2][4][2]>(acc_);
        const int row0 = u.pm * 256 + wr * 64 + fr, col0 = u.pn * 256 + wc * 32 + 8 * fq, b = u.pm >> 5, wid = wr * 4 + wc, tid = wid * 64 + fq * 16 + fr;
        LAS float* P = (LAS float*)xl; LAS float* S = (LAS float*)(xl + 4096);
        {
            f32x4 gt[2][2];
#pragma unroll
            for (int bj = 0; bj < 2; ++bj) { gt[bj][0] = *(const f32x4*)(MOD + b * 3072 + 2048 + col0 + bj * 128); gt[bj][1] = *(const f32x4*)(MOD + b * 3072 + 2048 + col0 + bj * 128 + 4); }
#pragma unroll
            for (int ai = 0; ai < 2; ++ai)
#pragma unroll
                for (int m = 0; m < 4; ++m) {
                    const size_t row = (size_t)(row0 + ai * 128 + m * 16);
                    float ss = 0.f;
#pragma unroll
                    for (int bj = 0; bj < 2; ++bj) {
                        const f32x4 xa = *(const f32x4*)(x + row * 1024 + col0 + bj * 128), xb = *(const f32x4*)(x + row * 1024 + col0 + bj * 128 + 4);
                        const f32x4 o0 = xa + gt[bj][0] * acc[ai][bj][m][0], o1 = xb + gt[bj][1] * acc[ai][bj][m][1];
                        acc[ai][bj][m][0] = o0; acc[ai][bj][m][1] = o1;
                        ss += (o0[0] * o0[0] + o0[1] * o0[1]) + (o0[2] * o0[2] + o0[3] * o0[3]) + (o1[0] * o1[0] + o1[1] * o1[1]) + (o1[2] * o1[2] + o1[3] * o1[3]);
                    }
                    ss += __shfl_xor(ss, 16); ss += __shfl_xor(ss, 32);
                    if (fq == 0) P[(ai * 128 + wr * 64 + m * 16 + fr) * 4 + wc] = ss;
                }
        }
        asm volatile("s_waitcnt lgkmcnt(0)" ::: "memory"); __builtin_amdgcn_s_barrier(); asm volatile("" ::: "memory");
        if (tid < 256) {
            const float t = (P[tid * 4 + 0] + P[tid * 4 + 1]) + (P[tid * 4 + 2] + P[tid * 4 + 3]);
            __hip_atomic_store(xbuf + ((size_t)(u.pm * 256 + tid) * 4 + u.pn), t, __ATOMIC_RELAXED, __HIP_MEMORY_SCOPE_AGENT);
        }
        asm volatile("s_waitcnt vmcnt(0)" ::: "memory");
        if (wid < 4 && fq == 0 && fr == 0) __hip_atomic_fetch_add(cnt + 64 * u.pm, 1u, __ATOMIC_RELAXED, __HIP_MEMORY_SCOPE_AGENT);
        if (wid == 0) {
            unsigned sp = 0;
            while ((unsigned)__builtin_amdgcn_readfirstlane(__hip_atomic_load(cnt + 64 * u.pm, __ATOMIC_RELAXED, __HIP_MEMORY_SCOPE_AGENT)) < 16u) { __builtin_amdgcn_s_sleep(2); if (++sp > (1u << 22)) break; }
            __builtin_amdgcn_fence(__ATOMIC_ACQUIRE, "agent");
        }
        asm volatile("s_waitcnt vmcnt(0) lgkmcnt(0)" ::: "memory"); __builtin_amdgcn_s_barrier(); asm volatile("" ::: "memory");
        if (tid < 256) {
            const float* sl = xbuf + (size_t)(u.pm * 256 + tid) * 4;
            const float t = (__hip_atomic_load(sl + 0, __ATOMIC_RELAXED, __HIP_MEMORY_SCOPE_AGENT) + __hip_atomic_load(sl + 1, __ATOMIC_RELAXED, __HIP_MEMORY_SCOPE_AGENT))
                          + (__hip_atomic_load(sl + 2, __ATOMIC_RELAXED, __HIP_MEMORY_SCOPE_AGENT) + __hip_atomic_load(sl + 3, __ATOMIC_RELAXED, __HIP_MEMORY_SCOPE_AGENT));
            S[tid] = 1.0f / sqrtf(t * (1.f / 1024.f) + EPS);
        }
        asm volatile("s_waitcnt vmcnt(0) lgkmcnt(0)" ::: "memory"); __builtin_amdgcn_s_barrier(); asm volatile("" ::: "memory");
        f32x4 fv[2][2];
#pragma unroll
        for (int bj = 0; bj < 2; ++bj) { fv[bj][0] = *(const f32x4*)(fg + col0 + bj * 128); fv[bj][1] = *(const f32x4*)(fg + col0 + bj * 128 + 4); }
#pragma unroll
        for (int ai = 0; ai < 2; ++ai)
#pragma unroll
            for (int m = 0; m < 4; ++m) {
                const int rl = ai * 128 + wr * 64 + m * 16 + fr; const float sr = S[rl]; const size_t row = (size_t)(u.pm * 256 + rl);
#pragma unroll
                for (int bj = 0; bj < 2; ++bj) {
                    *(f32x4*)(out + row * 1024 + col0 + bj * 128) = acc[ai][bj][m][0] * sr * fv[bj][0];
                    *(f32x4*)(out + row * 1024 + col0 + bj * 128 + 4) = acc[ai][bj][m][1] * sr * fv[bj][1];
                }
            }
    }
};

__device__ __forceinline__ int src_col(int n) {
    const int tile = n >> 8, loc = n & 255;
    if (tile < 8) return (loc < 128) ? tile * 128 + loc : 1024 + tile * 128 + (loc - 128);
    if (tile >= 12 && tile < 24) { const int p = loc & 63; if (p < 16) return (n & ~63) + (p & 3) + ((p >> 2) & 1) * 8 + ((p >> 3) & 1) * 4; }
    return n;
}
template <bool PERMUTE>
__device__ __forceinline__ void transpose_item(const float* W, int K, int N, bf16_t* WT, LAS float* scr, int item, int lane) {
    const int nblk = N / 32, kb = item / nblk, nb = item % nblk, k0 = 64 * kb, n0 = 32 * nb;
    const int sn = PERMUTE ? src_col(n0 + (lane & 31)) : n0 + (lane & 31);
#pragma unroll 8
    for (int i = 0; i < 32; ++i) { const int kk = 2 * i + (lane >> 5); scr[kk * 33 + (lane & 31)] = W[(size_t)(k0 + kk) * N + sn]; }
    asm volatile("s_waitcnt lgkmcnt(0)" ::: "memory");
    const int c = lane & 7;
#pragma unroll
    for (int j = 0; j < 4; ++j) { const int n = (lane >> 3) + 8 * j; const LAS float* s = scr + (8 * c) * 33 + n;
        u32x4 o; o.x = pk2(s[0 * 33], s[1 * 33]); o.y = pk2(s[2 * 33], s[3 * 33]); o.z = pk2(s[4 * 33], s[5 * 33]); o.w = pk2(s[6 * 33], s[7 * 33]);
        *(u32x4*)(WT + (size_t)(n0 + n) * K + k0 + 8 * c) = o; }
    asm volatile("s_waitcnt lgkmcnt(0)" ::: "memory");
}

__device__ __forceinline__ void conv_oct(const f32x2 (&u)[38], const f32x2 (&w)[31], const f32x2 bias, LAS f32x2* acc) {
#pragma unroll
    for (int tt = 0; tt < 8; ++tt) {
        f32x2 a = bias;
#pragma unroll
        for (int k = 0; k < 31; ++k) a += w[k] * u[tt + k];
        acc[tt * 512] = a;
    }
}
__device__ __forceinline__ void conv_slide(f32x2 (&u)[38], const unsigned* up) {
    unsigned nw[8];
#pragma unroll
    for (int i = 0; i < 8; ++i) nw[i] = up[(long)i * 512];
#pragma unroll
    for (int i = 0; i < 30; ++i) u[i] = u[i + 8];
#pragma unroll
    for (int i = 0; i < 8; ++i) u[30 + i] = (f32x2){bflo(nw[i]), bfhi(nw[i])};
}
__device__ __forceinline__ void conv_item(const Params& p, LAS unsigned char* lds, int it, int tid, bool dummy = false) {
    const bf16_t* U = (const bf16_t*)(p.ws + WS_U); bf16_t* ZC = (bf16_t*)(p.ws + WS_ZC);
    const int row0 = it * 32, s0 = row0 & (SEQ - 1), c = 2 * tid;
    f32x2 w[31];
#pragma unroll
    for (int k = 0; k < 31; ++k) w[k] = *(const f32x2*)(p.conv_w + k * 1024 + c);
    const f32x2 bias = *(const f32x2*)(p.conv_b + c);
    const unsigned* up = (const unsigned*)(U + ((long)row0 - 30) * 1024 + c);
    f32x2 u[38];
    {
        unsigned raw[38];
#pragma unroll
        for (int s = 0; s < 30; ++s) raw[s] = 0u;
        if (s0 > 0) {
#pragma unroll
            for (int s = 0; s < 30; ++s) raw[s] = up[(long)s * 512];
        }
#pragma unroll
        for (int s = 30; s < 38; ++s) raw[s] = up[(long)s * 512];
#pragma unroll
        for (int s = 0; s < 38; ++s) u[s] = (f32x2){bflo(raw[s]), bfhi(raw[s])};
    }
    LAS f32x2* red = (LAS f32x2*)lds;
    LAS f32x2* stats = (LAS f32x2*)(lds + 131072);
    conv_oct(u, w, bias, red + tid);
    conv_slide(u, up + 38L * 512); conv_oct(u, w, bias, red + 8 * 512 + tid);
    conv_slide(u, up + 46L * 512); conv_oct(u, w, bias, red + 16 * 512 + tid);
    conv_slide(u, up + 54L * 512); conv_oct(u, w, bias, red + 24 * 512 + tid);
    __syncthreads();
    {
        const int t = tid >> 4, part = tid & 15; float s1 = 0.f, s2 = 0.f;
#pragma unroll 8
        for (int i = 0; i < 32; ++i) { const f32x2 v = red[t * 512 + part + 16 * i]; s1 += v.x + v.y; s2 += v.x * v.x + v.y * v.y; }
#pragma unroll
        for (int o = 1; o < 16; o <<= 1) { s1 += __shfl_xor(s1, o); s2 += __shfl_xor(s2, o); }
        if (part == 0) { const float mean = s1 * (1.f / 1024.f); const float var = fmaxf(s2 * (1.f / 1024.f) - mean * mean, 0.f); stats[t] = (f32x2){mean, 1.0f / sqrtf(var + EPS)}; }
    }
    __syncthreads();
    const f32x2 g2 = *(const f32x2*)(p.ln_g + c), b2 = *(const f32x2*)(p.ln_b + c);
    unsigned* zp = (unsigned*)(ZC + (size_t)row0 * 1024 + c); unsigned* op = dummy ? (unsigned*)((bf16_t*)p.out + (size_t)row0 * 1024 + c) : zp;
#pragma unroll
    for (int t = 0; t < 32; ++t) {
        const f32x2 st = stats[t], av = red[t * 512 + tid];
        float y0 = (av.x - st.x) * st.y * g2.x + b2.x, y1 = (av.y - st.x) * st.y * g2.y + b2.y;
        y0 *= sigm(y0); y1 *= sigm(y1);
        const unsigned z = zp[(size_t)t * 512];
        op[(size_t)t * 512] = pk2(y0 * bflo(z), y1 * bfhi(z));
    }
    __syncthreads();
}

typedef short v4i16_t __attribute__((ext_vector_type(4)));
__device__ __forceinline__ s16x4 vtr(const LAS unsigned char* p) { return __builtin_bit_cast(s16x4, __builtin_amdgcn_ds_read_tr16_b64_v4i16((LAS v4i16_t*)p)); }
constexpr int KV_ROWB = 160, LDS_VOFF = 256 * KV_ROWB;
struct AttnPre { u32x4 kv[8]; bf16x8 q0, q1; };
__device__ __forceinline__ void attn_decode(int idx, int& b, int& g, int& j, int& r, int& n, int& sh, size_t& sub) {
    const int q64 = idx & 63; int rest = idx >> 6; j = rest & 7; rest >>= 3; g = rest % 3; b = rest / 3;
    sh = 2 * g; r = q64 >> (6 - sh); n = q64 & ((64 >> sh) - 1);
    sub = ((size_t)(((b * 3 + g) * 8 + j) * SEQ) + ((size_t)r << (13 - sh))) * 64;
}
__device__ __forceinline__ void attn_prefetch(const Params& p, int idx, int tid, int lane, int w, AttnPre& R) {
    const bf16_t* Q = (const bf16_t*)(p.ws + WS_Q); const bf16_t* K = (const bf16_t*)(p.ws + WS_K); const bf16_t* V = (const bf16_t*)(p.ws + WS_V);
    int b, g, j, r, n, sh; size_t sub; attn_decode(idx, b, g, j, r, n, sh, sub);
    const int nprev = n > 0 ? n - 1 : n;
    const size_t rp = sub + (size_t)nprev * 8192 + tid * 8, rc = sub + (size_t)n * 8192 + tid * 8;
    R.kv[0] = *(const u32x4*)(K + rp); R.kv[1] = *(const u32x4*)(K + rp + 4096); R.kv[2] = *(const u32x4*)(K + rc); R.kv[3] = *(const u32x4*)(K + rc + 4096);
    R.kv[4] = *(const u32x4*)(V + rp); R.kv[5] = *(const u32x4*)(V + rp + 4096); R.kv[6] = *(const u32x4*)(V + rc); R.kv[7] = *(const u32x4*)(V + rc + 4096);
    const bf16_t* qptr = Q + sub + (size_t)(n * 128 + 16 * w + (lane & 15)) * 64 + 8 * (lane >> 4);
    R.q0 = *(const bf16x8*)(qptr); R.q1 = *(const bf16x8*)(qptr + 32);
}
__device__ __forceinline__ void attn_stage(LAS unsigned char* lds, int tid, const AttnPre& R) {
    LAS unsigned char* dp = lds + (tid >> 3) * KV_ROWB + (tid & 7) * 16; LAS unsigned char* dc = dp + 128 * KV_ROWB;
    *(LAS u32x4*)(dp) = R.kv[0]; *(LAS u32x4*)(dp + 64 * KV_ROWB) = R.kv[1]; *(LAS u32x4*)(dc) = R.kv[2]; *(LAS u32x4*)(dc + 64 * KV_ROWB) = R.kv[3];
    *(LAS u32x4*)(dp + LDS_VOFF) = R.kv[4]; *(LAS u32x4*)(dp + LDS_VOFF + 64 * KV_ROWB) = R.kv[5]; *(LAS u32x4*)(dc + LDS_VOFF) = R.kv[6]; *(LAS u32x4*)(dc + LDS_VOFF + 64 * KV_ROWB) = R.kv[7];
}
__device__ __forceinline__ void attn_compute(const Params& p, LAS unsigned char* lds, int idx, int lane, int w, const bf16x8 qf0, const bf16x8 qf1) {
    bf16_t* Q = (bf16_t*)(p.ws + WS_Q); float* LSE = (float*)(p.ws + WS_LSE);
    int b, g, j, r, n, sh; size_t sub; attn_decode(idx, b, g, j, r, n, sh, sub);
    const int d = 1 << sh;
    const int fr = lane & 15, fq = lane >> 4;
    const size_t qrow = (size_t)b * SEQ + (size_t)(n * 128 + 16 * w + fr) * d + r;
    bf16_t* qptr = Q + sub + (size_t)(n * 128 + 16 * w + fr) * 64;
    f32x4 s[9];
#pragma unroll
    for (int tp = 0; tp < 9; ++tp) {
        const LAS unsigned char* kb = lds + (16 * (w + tp) + fr) * KV_ROWB + fq * 16;
        const bf16x8 ka = *(const LAS bf16x8*)kb, kc = *(const LAS bf16x8*)(kb + 64);
        f32x4 z = (f32x4){0.f, 0.f, 0.f, 0.f};
        z = __builtin_amdgcn_mfma_f32_16x16x32_bf16(ka, qf0, z, 0, 0, 0);
        s[tp] = __builtin_amdgcn_mfma_f32_16x16x32_bf16(kc, qf1, z, 0, 0, 0);
    }
    const float NEG = -1e30f;
#pragma unroll
    for (int jj = 0; jj < 4; ++jj) { const int key = 4 * fq + jj; if (key < fr) s[0][jj] = NEG; if (key > fr) s[8][jj] = NEG; }
    if (n == 0) {
#pragma unroll
        for (int tp = 0; tp < 8; ++tp) if (w + tp < 8) s[tp] = (f32x4){NEG, NEG, NEG, NEG};
    }
    float mx = NEG;
#pragma unroll
    for (int tp = 0; tp < 9; ++tp) mx = fmaxf(fmaxf(mx, fmaxf(s[tp][0], s[tp][1])), fmaxf(s[tp][2], s[tp][3]));
    mx = fmaxf(mx, __shfl_xor(mx, 16)); mx = fmaxf(mx, __shfl_xor(mx, 32));
    float l = 0.f;
#pragma unroll
    for (int tp = 0; tp < 9; ++tp)
#pragma unroll
        for (int jj = 0; jj < 4; ++jj) { const float e = __builtin_amdgcn_exp2f(s[tp][jj] - mx); s[tp][jj] = e; l += e; }
    u32x4 pw[5];
#pragma unroll
    for (int kp = 0; kp < 4; ++kp) pw[kp] = pack8(s[2 * kp], s[2 * kp + 1]);
    pw[4] = pack8(s[8], (f32x4){0.f, 0.f, 0.f, 0.f});
    f32x4 ot[4];
#pragma unroll
    for (int dt = 0; dt < 4; ++dt) ot[dt] = (f32x4){0.f, 0.f, 0.f, 0.f};
    const LAS unsigned char* vbase = lds + LDS_VOFF + (16 * w + 4 * fq + (fr >> 2)) * KV_ROWB + (fr & 3) * 8;
#pragma unroll
    for (int kp = 0; kp < 5; ++kp)
#pragma unroll
        for (int dt = 0; dt < 4; ++dt) {
            const s16x4 lo = vtr(vbase + (2 * kp) * 16 * KV_ROWB + dt * 32);
            s16x4 hi = (s16x4){0, 0, 0, 0};
            if (kp < 4) hi = vtr(vbase + (2 * kp + 1) * 16 * KV_ROWB + dt * 32);
            const bf16x8 a = (bf16x8){lo[0], lo[1], lo[2], lo[3], hi[0], hi[1], hi[2], hi[3]};
            ot[dt] = __builtin_amdgcn_mfma_f32_16x16x32_bf16(a, __builtin_bit_cast(bf16x8, pw[kp]), ot[dt], 0, 0, 0);
        }
    l += __shfl_xor(l, 16); l += __shfl_xor(l, 32);
    const float inv = 1.0f / l;
#pragma unroll
    for (int dt = 0; dt < 4; ++dt) { u32x2 o; o.x = pk2(ot[dt][0] * inv, ot[dt][1] * inv); o.y = pk2(ot[dt][2] * inv, ot[dt][3] * inv); *(u32x2*)(qptr + 16 * dt + 4 * fq) = o; }
    if (fq == 0) LSE[((size_t)g * M + qrow) * 8 + j] = mx + __log2f(l);
}

__global__ void __launch_bounds__(512, 2) fwd_megakernel(Params p) {
    extern __shared__ __attribute__((aligned(16))) unsigned char lds_raw[];
    LAS unsigned char* lds = (LAS unsigned char*)lds_raw;
    cg::grid_group grid = cg::this_grid();
    int tid, lane, wave, gw;
#define RELANE() do { int t_ = threadIdx.x; asm volatile("" : "+v"(t_)); tid = t_; lane = tid & 63; wave = __builtin_amdgcn_readfirstlane(tid >> 6); gw = bid * 8 + wave; } while (0)
    const int G = gridDim.x, bid = blockIdx.x, NGW = G * 8;
    RELANE();
    unsigned char* ws = p.ws; unsigned char* dout = (unsigned char*)p.out;
    float* MOD = (float*)(ws + WS_MOD); float* CS = (float*)(ws + WS_CS); float* SSQ = (float*)(ws + WS_SSQ);
    bf16_t* W1T = (bf16_t*)(ws + WS_W1T); bf16_t* WCO = (bf16_t*)(ws + WS_WCO); bf16_t* WAO = (bf16_t*)(ws + WS_WAO); bf16_t* WO = (bf16_t*)(ws + WS_WO);
    bf16_t* H = (bf16_t*)(dout + DO_H); bf16_t* ZA = (bf16_t*)(dout + DO_ZA); unsigned char* GC8 = dout + DO_GC;
    unsigned* const barw = (unsigned*)(ws + WS_BAR);
    unsigned* const pcnt = (unsigned*)(ws + WS_BAR + 65536);
    volatile LAS unsigned* const misc = (volatile LAS unsigned*)(lds + 131072 + 1024);
    if (tid == 0) { misc[0] = 0u; misc[1] = 0u; }
    __syncthreads();
    XcdBarrier xbar = xcd_barrier_post(barw, misc);
    if (G == 0x7fffffff) grid.sync();
#define GSYNC() do { xcd_barrier(xbar); RELANE(); } while (0)

    for (int it = bid; it < 96 * 8; it += G) {
        const int cgp = it % 96, kc = it / 96, n0 = cgp * 32, col = tid & 31, ks = tid >> 5;
        float a0 = 0.f, a1 = 0.f, a2 = 0.f, a3 = 0.f;
        const int kb = kc * 128 + ks * 8;
        const float* wp = p.w_ada + (size_t)kb * 3072 + n0 + col; const float* cc = p.c + kb;
#pragma unroll
        for (int k = 0; k < 8; ++k) { const float wv = wp[(size_t)k * 3072]; a0 += cc[k] * wv; a1 += cc[1024 + k] * wv; a2 += cc[2048 + k] * wv; a3 += cc[3072 + k] * wv; }
        LAS float* red = (LAS float*)lds;
        red[(ks * 4 + 0) * 32 + col] = a0; red[(ks * 4 + 1) * 32 + col] = a1; red[(ks * 4 + 2) * 32 + col] = a2; red[(ks * 4 + 3) * 32 + col] = a3;
        __syncthreads();
        if (tid < 128) { const int bb = tid >> 5; float sum = kc == 0 ? p.b_ada[n0 + col] : 0.f;
#pragma unroll
            for (int k2 = 0; k2 < 16; ++k2) sum += red[(k2 * 4 + bb) * 32 + col];
            atomicAdd(MOD + bb * 3072 + n0 + col, sum); }
        __syncthreads();
    }
    GSYNC();

    {
        LAS float* scr = (LAS float*)(lds + wave * 16384);
        constexpr int I1 = 16 * 320, I2 = 16 * 32, I3 = 8 * 32, I4 = 16 * 32;
        for (int it = gw; it < I1 + I2 + I3 + I4; it += NGW) {
            int r = it;
            if (r < I1) { transpose_item<true>(p.w_in, 1024, NIN, W1T, scr, r, lane); continue; } r -= I1;
            if (r < I2) { transpose_item<false>(p.w_co, 1024, 1024, WCO, scr, r, lane); continue; } r -= I2;
            if (r < I3) { transpose_item<false>(p.w_ao, 1024  , 1024, WAO, scr, r, lane); continue; } r -= I3;
            transpose_item<false>(p.w_o, 1024, 1024, WO, scr, r, lane);
        }
    }
    for (int e = bid * 512 + tid; e < M * 8; e += G * 512) {
        const int row = e >> 3, i = e & 7;
        const float fi = i == 0 ? p.f0 : i == 1 ? p.f1 : i == 2 ? p.f2 : i == 3 ? p.f3 : i == 4 ? p.f4 : i == 5 ? p.f5 : i == 6 ? p.f6 : p.f7;
        const float ang = (float)p.pos[row] * fi;
        const double rev = (double)ang * 0.15915494309189535; const float frac = (float)(rev - __builtin_rint(rev));
        CS[row * 16 + i] = __builtin_amdgcn_cosf(frac); CS[row * 16 + 8 + i] = __builtin_amdgcn_sinf(frac);
    }
    for (int row = gw; row < M; row += NGW) {
        const f32x4* xr = (const f32x4*)(p.x + (size_t)row * 1024) + lane; f32x4 v[4]; float ss = 0.f;
#pragma unroll
        for (int jx = 0; jx < 4; ++jx) { v[jx] = xr[64 * jx]; ss += (v[jx][0] * v[jx][0] + v[jx][1] * v[jx][1]) + (v[jx][2] * v[jx][2] + v[jx][3] * v[jx][3]); }
        const float rstd = 1.0f / sqrtf(wave_sum(ss) * (1.f / 1024.f) + EPS);
        const float* mb = MOD + (row >> 13) * 3072;
#pragma unroll
        for (int jx = 0; jx < 4; ++jx) { const int col = 4 * lane + 256 * jx;
            const f32x4 gg = *(const f32x4*)(p.norm_g + col), scl = *(const f32x4*)(mb + 1024 + col), sft = *(const f32x4*)(mb + col);
            const f32x4 y = v[jx] * rstd * gg * (scl + 1.0f) + sft;
            u32x2 o; o.x = pk2(y[0], y[1]); o.y = pk2(y[2], y[3]); *(u32x2*)(H + (size_t)row * 1024 + col) = o; }
    }
    GSYNC();

    for (int rep = 0; rep < REP_P1; ++rep) {
        pg8::Gemm g{H, W1T, M, NIN, 1024, H, W1T, 16, 16}; pg8::StaticOrder S; S.init(M, NIN, G, bid);
        Epi1 E{ws, dout};
        pg8::gemm_phase<Epi1, pg8::StaticOrder, true, true>(lds, g, S, E);
    }
    GSYNC();

    for (int it = bid; it < 1024 * REP_CONV; it += G) conv_item(p, lds, it & 1023, tid, it < 1024 * (REP_CONV - 1));
    if (bid < 6144) {
        AttnPre R; attn_prefetch(p, bid, tid, lane, wave, R);
        for (int idx = bid; idx < 6144; idx += G) {
            __syncthreads();
            attn_stage(lds, tid, R); const bf16x8 qf0 = R.q0, qf1 = R.q1;
            __syncthreads();
            if (idx + G < 6144) attn_prefetch(p, idx + G, tid, lane, wave, R);
            for (int rep = 0; rep < REP_ATT; ++rep) attn_compute(p, lds, idx, lane, wave, qf0, qf1);
        }
    }
    GSYNC();

    for (int rep = 0; rep < REP_P3; ++rep) {
        const bf16_t* OG = (const bf16_t*)(ws + WS_Q); const float* LSE = (const float*)(ws + WS_LSE); bf16_t* A2 = (bf16_t*)(ws + WS_A2);
        for (int e = bid * 512 + tid; e < M * 64; e += G * 512) {
            const size_t row = (size_t)(e >> 6); const int jc = e & 63, j = jc >> 3;
            const float l0 = LSE[row * 8 + j], l1 = LSE[((size_t)M + row) * 8 + j], l2 = LSE[((size_t)2 * M + row) * 8 + j];
            const float mxl = fmaxf(l0, fmaxf(l1, l2));
            float w0 = __builtin_amdgcn_exp2f(l0 - mxl), w1 = __builtin_amdgcn_exp2f(l1 - mxl), w2 = __builtin_amdgcn_exp2f(l2 - mxl);
            const float inv = 1.0f / (w0 + w1 + w2); w0 *= inv; w1 *= inv; w2 *= inv;
            const int bb = (int)(row >> 13), tt = (int)(row & (SEQ - 1)), c8 = (jc & 7) * 8;
            const u32x4 o0 = *(const u32x4*)(OG + qkv_off(bb, 0, j, tt) + c8), o1 = *(const u32x4*)(OG + qkv_off(bb, 1, j, tt) + c8), o2 = *(const u32x4*)(OG + qkv_off(bb, 2, j, tt) + c8);
            const u32x4 za = *(const u32x4*)(ZA + row * 512 + jc * 8);
            u32x4 o;
#pragma unroll
            for (int q = 0; q < 4; ++q) {
                const float lo = (w0 * bflo(o0[q]) + w1 * bflo(o1[q]) + w2 * bflo(o2[q])) * bflo(za[q]);
                const float hi = (w0 * bfhi(o0[q]) + w1 * bfhi(o1[q]) + w2 * bfhi(o2[q])) * bfhi(za[q]);
                o[q] = pk2(lo, hi);
            }
            *(u32x4*)(A2 + row * 1024 + jc * 8) = o;
        }
    }
    GSYNC();

    {
        pg8::Gemm g{(const bf16_t*)(ws + WS_ZC), WCO, M, 1024, 1024, (const bf16_t*)(ws + WS_A2), WAO, 16, 8}; pg8::PairOrder S; S.init(M, 1024, G, bid);
        Epi34 E{GC8, ws + WS_GA, (bf16_t*)(ws + WS_MG)};
        pg8::gemm_phase<Epi34, pg8::PairOrder, true, true>(lds, g, S, E);
    }
    GSYNC();

    for (int rep = 0; rep < REP_P5; ++rep) {
        pg8::Gemm g{(const bf16_t*)(ws + WS_MG), WO, M, 1024, 1024, (const bf16_t*)(ws + WS_MG), WO, 16, 16}; pg8::StaticOrder S; S.init(M, 1024, G, bid);
        Epi5 E{p.x, MOD, p.out, p.final_g, SSQ, pcnt, lds + 131072 + 2048};
        pg8::gemm_phase<Epi5, pg8::StaticOrder, true, true>(lds, g, S, E);
    }
}

extern "C" void kernel_launch(void* const* d_in, const int* in_sizes, int n_in, void* d_out, int out_size, void* d_ws, size_t ws_size, hipStream_t stream) {
    static int grid = 0;
    if (grid == 0) {
        if (n_in != 15 || out_size != M * DM || ws_size < WS_END) { fprintf(stderr, "kernel_launch: unexpected sizes (n_in %d, out %d, ws %zu)\n", n_in, out_size, ws_size); grid = -1; return; }
        int dev = 0, cus = 0, per_cu = 0;
        (void)hipGetDevice(&dev); (void)hipDeviceGetAttribute(&cus, hipDeviceAttributeMultiprocessorCount, dev);
        (void)hipFuncSetAttribute((const void*)fwd_megakernel, hipFuncAttributeMaxDynamicSharedMemorySize, LDS_BYTES);
        if (hipOccupancyMaxActiveBlocksPerMultiprocessor(&per_cu, (const void*)fwd_megakernel, 512, LDS_BYTES) != hipSuccess || per_cu < 1) per_cu = 1;
        (void)hipGetLastError();
        grid = cus * per_cu;
    }
    if (grid < 0) return;
    Params p{};
    p.x = (const float*)d_in[0]; p.c = (const float*)d_in[1]; p.pos = (const int*)d_in[2]; p.norm_g = (const float*)d_in[3]; p.w_ada = (const float*)d_in[4]; p.b_ada = (const float*)d_in[5];
    p.w_in = (const float*)d_in[6]; p.conv_w = (const float*)d_in[7]; p.conv_b = (const float*)d_in[8]; p.ln_g = (const float*)d_in[9]; p.ln_b = (const float*)d_in[10];
    p.w_co = (const float*)d_in[11]; p.w_ao = (const float*)d_in[12]; p.w_o = (const float*)d_in[13]; p.final_g = (const float*)d_in[14];
    p.out = (float*)d_out; p.ws = (unsigned char*)d_ws;
    p.f0 = 1.0f; p.f1 = 1.939227432e-01f; p.f2 = 3.760603070e-02f; p.f3 = 7.292664610e-03f; p.f4 = 1.414213562e-03f; p.f5 = 2.742481884e-04f; p.f6 = 5.318295734e-05f; p.f7 = 1.031338525e-05f;
    if (hipMemsetAsync(d_ws, 0, 1 * MiB, stream) != hipSuccess) { fprintf(stderr, "kernel_launch: memset of the control words failed\n"); return; }
    void* args[] = {&p};
    const hipError_t e = hipLaunchCooperativeKernel((const void*)fwd_megakernel, dim3(grid), dim3(512), args, LDS_BYTES, stream);
    if (e != hipSuccess) fprintf(stderr, "cooperative launch failed: %s (grid %d)\n", hipGetErrorString(e), grid);
}
```

```cpp
#include <hip/hip_runtime.h>
#include <hip/hip_cooperative_groups.h>
#include <cstdio>
#include <cstdint>
namespace cg = cooperative_groups;
#define LAS __attribute__((address_space(3)))
namespace pg8 {
#define PG8_LAS __attribute__((address_space(3)))
typedef unsigned short bf16_t;
typedef short bf16x8 __attribute__((ext_vector_type(8)));
typedef float f32x4 __attribute__((ext_vector_type(4)));
typedef unsigned u32x4 __attribute__((ext_vector_type(4)));
constexpr int BM = 256, BK = 64, HALF = 128, HTB = HALF * BK * 2  , STAGE_BYTES = 8 * HTB, NXCD = 8, WGM = 8;

__host__ __device__ __forceinline__ int lds_byte(int r, int c) { const int st = (r >> 4) * 2 + (c >> 5), rr = r & 15, cc = c & 31, ob = rr * 64 + cc * 2; return st * 1024 + (ob ^ (((ob >> 9) & 1) << 5)); }
__host__ __device__ __forceinline__ void stage_rc(int b, int& R, int& C) { const int st = b / 1024, sb = b % 1024, swz = sb ^ (((sb >> 9) & 1) << 5); R = (st >> 1) * 16 + swz / 64; C = (st & 1) * 32 + (swz % 64) / 2; }
__host__ __device__ __forceinline__ int perm32(int rho) { const int n = rho >> 4, i = rho & 15; return 8 * (i >> 2) + 4 * n + (i & 3); }

struct Unit { int pm, pn, kind; };
struct Gemm { const bf16_t* A; const bf16_t* Bt; int M, N, K; const bf16_t* A1; const bf16_t* Bt1; int nt0, nt1; };

struct StaticOrder {
    int nM, nN, nwg, G, c;
    __host__ __device__ void init(int M, int N, int G_, int c_) { nM = M / BM; nN = N / BM; nwg = nM * nN; G = G_; c = c_; }
    __host__ __device__ bool next(int i, Unit& u) const {
        const long L = (long)i * G + c; if (L >= nwg) return false;
        int wgid = (int)L; { const int q = nwg / NXCD, r = nwg % NXCD, xcd = wgid % NXCD, off = wgid / NXCD; wgid = (xcd < r ? xcd * (q + 1) : r * (q + 1) + (xcd - r) * q) + off; }
        const int nig = WGM * nN, gid = wgid / nig, fm = gid * WGM, gsz = (nM - fm) < WGM ? (nM - fm) : WGM;
        u.pm = fm + ((wgid % nig) % gsz); u.pn = (wgid % nig) / gsz; u.kind = 0; return true;
    }
    __device__ __forceinline__ void a_ready(const Unit&) const {}
    __device__ __forceinline__ void done(const Unit&) const {}
};

__device__ __forceinline__ unsigned cvt_pk_bf16(float lo, float hi) { unsigned r; asm volatile("v_cvt_pk_bf16_f32 %0, %1, %2" : "=v"(r) : "v"(lo), "v"(hi)); return r; }
typedef float f32x2 __attribute__((ext_vector_type(2)));
struct PairOrder {
    StaticOrder base;
    __host__ __device__ void init(int M, int N, int G_, int c_) { base.init(M, N, G_, c_); }
    __host__ __device__ bool next(int i, Unit& u) const { if (!base.next(i >> 1, u)) return false; u.kind = i & 1; return true; }
    __device__ __forceinline__ void a_ready(const Unit&) const {}
    __device__ __forceinline__ void done(const Unit&) const {}
};
template <class Epi, class Sched, bool ALIGN_EPI = false, bool SP2 = false>
__device__ __forceinline__ void gemm_phase(PG8_LAS unsigned char* lds, const Gemm g, const Sched& S, const Epi& E) {
    int tid_ = threadIdx.x; asm volatile("" : "+v"(tid_));
    const int tid = tid_, wid = __builtin_amdgcn_readfirstlane(tid >> 6), lane = tid & 63, wr = wid >> 2, wc = wid & 3, fr = lane & 15, fq = lane >> 4;
    const int K = g.K;
    unsigned voffA[2], voffB[2];
#pragma unroll
    for (int i = 0; i < 2; ++i) { int R, C; stage_rc(tid * 16 + i * 8192, R, C); const int Rb = Epi::PERM ? ((R & ~31) + perm32(R & 31)) : R;
        voffA[i] = (unsigned)(R * K + C) * 2u; voffB[i] = (unsigned)(Rb * K + C) * 2u; }
    const size_t kstep = (size_t)(BK * 2);
    const size_t hstep = (size_t)HALF * K * 2;
    const size_t tstep = 2 * hstep;
    const unsigned ldsw = (unsigned)wid * 1024u;
    const int aoff = lds_byte(wr * 64 + fr, fq * 8), boff = lds_byte(wc * 32 + fr, fq * 8);
#define PG8_SA(b, h) (((b) * 2 + (h)) * HTB)
#define PG8_SB(b, h) ((4 + (b) * 2 + (h)) * HTB)
#define PG8_STAGE(bufoff, gbase, voff) do { _Pragma("unroll") for (int _i = 0; _i < 2; ++_i) \
        __builtin_amdgcn_global_load_lds((const unsigned*)((const char*)(gbase) + (voff)[_i]), (PG8_LAS unsigned*)(lds + (bufoff) + ldsw + _i * 8192), 16, 0, 0); } while (0)
#define PG8_LDA(dst, b, h) do { _Pragma("unroll") for (int m = 0; m < 4; ++m) _Pragma("unroll") for (int k = 0; k < 2; ++k) dst[m][k] = *(const PG8_LAS bf16x8*)(lds + PG8_SA(b, h) + aoff + m * 2048 + k * 1024); } while (0)
#define PG8_LDB(dst, b, h) do { _Pragma("unroll") for (int n = 0; n < 2; ++n) _Pragma("unroll") for (int k = 0; k < 2; ++k) dst[n][k] = *(const PG8_LAS bf16x8*)(lds + PG8_SB(b, h) + boff + n * 2048 + k * 1024); } while (0)
#define PG8_MMA(ai, bj, At, Bt) do { __builtin_amdgcn_s_setprio(1); _Pragma("unroll") for (int m = 0; m < 4; ++m) _Pragma("unroll") for (int n = 0; n < 2; ++n) _Pragma("unroll") for (int k = 0; k < 2; ++k) \
        acc[ai][bj][m][n] = __builtin_amdgcn_mfma_f32_16x16x32_bf16(Bt[n][k], At[m][k], acc[ai][bj][m][n], 0, 0, 0); __builtin_amdgcn_s_setprio(0); } while (0)
#define PG8_WAIT_V(n) asm volatile("s_waitcnt vmcnt(" #n ")" ::: "memory")
#define PG8_WAIT_L(n) asm volatile("s_waitcnt lgkmcnt(" #n ")" ::: "memory")
#define PG8_BAR __builtin_amdgcn_s_barrier()
#define PG8_SCHED __builtin_amdgcn_sched_barrier(0)
    Unit cur, nxt; int ui = 0;
    if (!S.next(0, cur)) return;
    f32x4 acc[2][2][4][2];
#pragma unroll
    for (int a = 0; a < 2; ++a)
#pragma unroll
        for (int b = 0; b < 2; ++b)
#pragma unroll
            for (int m = 0; m < 4; ++m)
#pragma unroll
                for (int n = 0; n < 2; ++n) acc[a][b][m][n] = (f32x4){0.f, 0.f, 0.f, 0.f};
    bf16x8 At[4][2], B0[2][2], B1[2][2];
    const char* cA = (const char*)(cur.kind ? g.A1 : g.A) + (size_t)cur.pm * tstep; const char* cB = (const char*)(cur.kind ? g.Bt1 : g.Bt) + (size_t)cur.pn * tstep;
    S.a_ready(cur);
    if constexpr (SP2) {
        PG8_STAGE(PG8_SB(0, 0), cB, voffB); PG8_STAGE(PG8_SB(0, 1), cB + hstep, voffB); PG8_STAGE(PG8_SA(0, 0), cA, voffA); PG8_STAGE(PG8_SA(0, 1), cA + hstep, voffA);
        if (wr == 1) PG8_BAR;
        PG8_WAIT_V(2); PG8_BAR;
        PG8_STAGE(PG8_SB(1, 0), cB + kstep, voffB); PG8_STAGE(PG8_SA(1, 0), cA + kstep, voffA); PG8_STAGE(PG8_SB(1, 1), cB + hstep + kstep, voffB);
        PG8_WAIT_V(6); PG8_BAR;
    } else {
        PG8_STAGE(PG8_SB(0, 0), cB, voffB); PG8_STAGE(PG8_SA(0, 0), cA, voffA); PG8_STAGE(PG8_SB(0, 1), cB + hstep, voffB); PG8_STAGE(PG8_SA(0, 1), cA + hstep, voffA);
        if (wr == 1) PG8_BAR;
        PG8_WAIT_V(4); PG8_BAR;
        PG8_STAGE(PG8_SB(1, 0), cB + kstep, voffB); PG8_STAGE(PG8_SA(1, 0), cA + kstep, voffA); PG8_STAGE(PG8_SB(1, 1), cB + hstep + kstep, voffB);
        PG8_WAIT_V(6); PG8_BAR;
    }
    for (;;) {
        const bool has_next = S.next(ui + 1, nxt);
        const char* nA = has_next ? (const char*)(nxt.kind ? g.A1 : g.A) + (size_t)nxt.pm * tstep : cA; const char* nB = has_next ? (const char*)(nxt.kind ? g.Bt1 : g.Bt) + (size_t)nxt.pn * tstep : cB;
        const int nt = cur.kind ? g.nt1 : g.nt0;
        for (int t = 0; t < nt; t += 2) {
            const bool last = (t == nt - 2);
            const char* a1 = cA + (size_t)(t + 1) * kstep;
            const char* a2 = last ? nA : cA + (size_t)(t + 2) * kstep; const char* b2 = last ? nB : cB + (size_t)(t + 2) * kstep;
            const char* a3 = a2 + kstep; const char* b3 = b2 + kstep;
            if (last && has_next) S.a_ready(nxt);
            if constexpr (SP2) {
            PG8_LDB(B0, 0, 0); PG8_LDB(B1, 0, 1); PG8_SCHED; PG8_LDA(At, 0, 0); PG8_STAGE(PG8_SA(1, 1), a1 + hstep, voffA);
            PG8_WAIT_V(8); PG8_WAIT_L(0); PG8_BAR; PG8_MMA(0, 0, At, B0); PG8_MMA(0, 1, At, B1); PG8_BAR; PG8_SCHED;
            PG8_LDA(At, 0, 1); PG8_STAGE(PG8_SB(0, 0), b2, voffB); PG8_STAGE(PG8_SB(0, 1), b2 + hstep, voffB); PG8_STAGE(PG8_SA(0, 0), a2, voffA);
            PG8_WAIT_V(8); PG8_WAIT_L(0); PG8_BAR; PG8_MMA(1, 0, At, B0); PG8_MMA(1, 1, At, B1); PG8_BAR; PG8_SCHED;
            PG8_LDB(B0, 1, 0); PG8_LDB(B1, 1, 1); PG8_SCHED; PG8_LDA(At, 1, 0); PG8_STAGE(PG8_SA(0, 1), a2 + hstep, voffA);
            PG8_WAIT_V(8); PG8_WAIT_L(0); PG8_BAR; PG8_MMA(0, 0, At, B0); PG8_MMA(0, 1, At, B1); PG8_BAR; PG8_SCHED;
            PG8_LDA(At, 1, 1); PG8_STAGE(PG8_SB(1, 0), b3, voffB); PG8_STAGE(PG8_SB(1, 1), b3 + hstep, voffB); PG8_STAGE(PG8_SA(1, 0), a3, voffA);
            PG8_WAIT_V(8); PG8_WAIT_L(0); PG8_BAR; PG8_MMA(1, 0, At, B0); PG8_MMA(1, 1, At, B1); PG8_BAR; PG8_SCHED;
            } else {
            PG8_LDB(B0, 0, 0); PG8_SCHED; PG8_LDA(At, 0, 0); PG8_STAGE(PG8_SA(1, 1), a1 + hstep, voffA);
            PG8_WAIT_L(8); PG8_BAR; PG8_WAIT_L(0); PG8_MMA(0, 0, At, B0); PG8_BAR; PG8_SCHED;
            PG8_LDB(B1, 0, 1); PG8_STAGE(PG8_SB(0, 0), b2, voffB);
            PG8_BAR; PG8_WAIT_L(0); PG8_MMA(0, 1, At, B1); PG8_BAR;
            PG8_LDA(At, 0, 1); PG8_STAGE(PG8_SA(0, 0), a2, voffA);
            PG8_BAR; PG8_WAIT_L(0); PG8_MMA(1, 0, At, B0); PG8_BAR; PG8_SCHED;
            PG8_STAGE(PG8_SB(0, 1), b2 + hstep, voffB);
            PG8_WAIT_V(6); PG8_BAR; PG8_MMA(1, 1, At, B1); PG8_BAR;
            PG8_LDB(B0, 1, 0); PG8_SCHED; PG8_LDA(At, 1, 0); PG8_STAGE(PG8_SA(0, 1), a2 + hstep, voffA);
            PG8_WAIT_L(8); PG8_BAR; PG8_WAIT_L(0); PG8_MMA(0, 0, At, B0); PG8_BAR; PG8_SCHED;
            PG8_LDB(B1, 1, 1); PG8_STAGE(PG8_SB(1, 0), b3, voffB);
            PG8_BAR; PG8_WAIT_L(0); PG8_MMA(0, 1, At, B1); PG8_BAR;
            PG8_LDA(At, 1, 1); PG8_STAGE(PG8_SA(1, 0), a3, voffA);
            PG8_BAR; PG8_WAIT_L(0); PG8_MMA(1, 0, At, B0); PG8_BAR; PG8_SCHED;
            PG8_STAGE(PG8_SB(1, 1), b3 + hstep, voffB);
            PG8_WAIT_V(6); PG8_BAR; PG8_MMA(1, 1, At, B1); PG8_BAR;
            }
        }
        if constexpr (ALIGN_EPI) { if (wr == 0) PG8_BAR; }
        bool keep = false;
        if constexpr (Epi::PAIRED) keep = (cur.kind == 0);
        if constexpr (!Epi::AFTER_DRAIN) { if constexpr (Epi::PAIRED) { if (keep) E.mid(acc, cur, wr, wc, fr, fq); else E(acc, cur, wr, wc, fr, fq); } else E(acc, cur, wr, wc, fr, fq); S.done(cur); }
        if (!has_next) break;
        if (!keep) {
#pragma unroll
        for (int a = 0; a < 2; ++a)
#pragma unroll
            for (int b = 0; b < 2; ++b)
#pragma unroll
                for (int m = 0; m < 4; ++m)
#pragma unroll
                    for (int n = 0; n < 2; ++n) acc[a][b][m][n] = (f32x4){0.f, 0.f, 0.f, 0.f};
        }
        cur = nxt; cA = nA; cB = nB; ++ui;
        if constexpr (ALIGN_EPI) { if (wr == 1) PG8_BAR; }
    }
    PG8_WAIT_V(0);
    if constexpr (!ALIGN_EPI) { if (wr == 0) PG8_BAR; }
    PG8_BAR;
    if constexpr (Epi::AFTER_DRAIN) { E.fused(acc, cur, wr, wc, fr, fq, lds, wid, lane); S.done(cur); }
#undef PG8_SA
#undef PG8_SB
#undef PG8_STAGE
#undef PG8_LDA
#undef PG8_LDB
#undef PG8_MMA
#undef PG8_WAIT_V
#undef PG8_WAIT_L
#undef PG8_BAR
#undef PG8_SCHED
}
}
#define XB_TMO      128
#define XB_XCNT(j)  (256  + 64 * (j))
#define XB_XSUB(j)  (1280 + 64 * (j))
#define XB_XGEN(j)  (2304 + 64 * (j))
#define XB_TOP      3328
#define XB_TOPGEN   3392
#define XCD_BAR_WORDS 3456
#define XB_SPIN_CAP (1u << 18)

__device__ __forceinline__ unsigned xb_ld(unsigned* p)              { return __hip_atomic_load(p, __ATOMIC_RELAXED, __HIP_MEMORY_SCOPE_AGENT); }
__device__ __forceinline__ unsigned xb_add(unsigned* p, unsigned v) { return __hip_atomic_fetch_add(p, v, __ATOMIC_RELAXED, __HIP_MEMORY_SCOPE_AGENT); }
__device__ __forceinline__ unsigned xb_xcc_id() { return (unsigned)__builtin_amdgcn_s_getreg((3 << 11) | 20) & 0xFu; }
#define XB_SPIN(cond, bar) do { unsigned _sp = 0; while (cond) { __builtin_amdgcn_s_sleep(1); \
    if ((++_sp & 255u) == 0u) { if (xb_ld(&(bar)[XB_TMO])) break; if (_sp > XB_SPIN_CAP) { atomicAdd(&(bar)[XB_TMO], 1u); break; } } } } while (0)

struct XcdBarrier {
    unsigned* bar; unsigned x;
    volatile LAS unsigned* st;
};

__device__ __forceinline__ XcdBarrier xcd_barrier_post(unsigned* bar, volatile LAS unsigned* st) {
    XcdBarrier b; b.bar = bar; b.x = xb_xcc_id(); b.st = st;
    if (threadIdx.x == 0) (void)xb_add(&bar[XB_XCNT(b.x)], 1u);
    return b;
}
__device__ __forceinline__ void xcd_barrier_complete(unsigned* bar, unsigned x, unsigned& nloc, unsigned& nx) {
    const unsigned G = gridDim.x * gridDim.y * gridDim.z;
    unsigned sum, cnt, mine, sp = 0u;
    for (;;) {
        sum = 0u; cnt = 0u; mine = 0u;
#pragma unroll
        for (unsigned j = 0; j < 16; ++j) { const unsigned c = xb_ld(&bar[XB_XCNT(j)]); sum += c; cnt += (c > 0u) ? 1u : 0u; mine = (j == x) ? c : mine; }
        if (sum == G) break;
        __builtin_amdgcn_s_sleep(1);
        if ((++sp & 255u) == 0u) { if (xb_ld(&bar[XB_TMO])) break; if (sp > XB_SPIN_CAP) { atomicAdd(&bar[XB_TMO], 1u); break; } }
    }
    nloc = mine > 0u ? mine : 1u; nx = cnt > 0u ? cnt : 1u;
}

__device__ __forceinline__ void xcd_barrier(const XcdBarrier& b) {
    asm volatile("s_waitcnt vmcnt(0)" ::: "memory");
    __syncthreads();
    if (threadIdx.x == 0) {
        unsigned* bar = b.bar;
        __builtin_amdgcn_s_waitcnt(0);
        unsigned nloc = b.st[0], nx = b.st[1];
        if (nloc == 0u) { xcd_barrier_complete(bar, b.x, nloc, nx); b.st[0] = nloc; b.st[1] = nx; }
        const unsigned old = xb_add(&bar[XB_XSUB(b.x)], 1u);
        const unsigned gen = old / nloc;
        if (old + 1u == (gen + 1u) * nloc) {
            __builtin_amdgcn_fence(__ATOMIC_RELEASE, "agent");
            asm volatile("s_waitcnt vmcnt(0)" ::: "memory");
            const unsigned og = xb_add(&bar[XB_TOP], 1u);
            const unsigned tg = og / nx;
            if (og + 1u == (tg + 1u) * nx) xb_add(&bar[XB_TOPGEN], 1u);
            else XB_SPIN(xb_ld(&bar[XB_TOPGEN]) == tg, bar);
            __builtin_amdgcn_fence(__ATOMIC_ACQUIRE, "agent");
            xb_add(&bar[XB_XGEN(b.x)], 1u);
            asm volatile("s_waitcnt vmcnt(0)" ::: "memory");
        } else {
            XB_SPIN(xb_ld(&bar[XB_XGEN(b.x)]) == gen, bar);
            __builtin_amdgcn_fence(__ATOMIC_ACQUIRE, "agent");
            asm volatile("s_waitcnt vmcnt(0)" ::: "memory");
        }
    }
    __syncthreads();
}

typedef unsigned short bf16_t;
typedef short bf16x8 __attribute__((ext_vector_type(8)));
typedef short s16x4 __attribute__((ext_vector_type(4)));
typedef float f32x4 __attribute__((ext_vector_type(4)));
typedef unsigned u32x4 __attribute__((ext_vector_type(4)));
typedef unsigned u32x2 __attribute__((ext_vector_type(2)));
typedef float f32x2 __attribute__((ext_vector_type(2)));

constexpr int NB = 4, SEQ = 8192, DM = 1024, M = NB * SEQ, NIN = 10240, QP = 1536;
constexpr size_t MiB = 1u << 20;
constexpr size_t WS_BAR = 512 * 1024  , WS_MOD = 0, WS_CS = 1 * MiB, WS_SSQ = 3 * MiB, WS_LSE = 5 * MiB, WS_W1T = 8 * MiB, WS_WCO = 28 * MiB, WS_WAO = 30 * MiB, WS_WO = 32 * MiB,
                 WS_U = 36 * MiB, WS_ZC = 100 * MiB, WS_Q = 164 * MiB, WS_K = 260 * MiB, WS_V = 356 * MiB, WS_GA = 452 * MiB, WS_END = 484 * MiB;
constexpr size_t WS_MG = WS_U, WS_A2 = WS_V;
constexpr size_t DO_H = 0, DO_ZA = 64 * MiB, DO_GC = 96 * MiB;
constexpr int LDS_BYTES = 147456;
constexpr int REP_P0 = 1, REP_P1 = 1, REP_P3 = 1, REP_P4 = 1, REP_P5 = 1, REP_CONV = 1, REP_ATT = 1;
constexpr float QSCALE = 0.125f * 1.4426950408889634f;
constexpr float EPS = 1e-6f;

struct Params {
    const float *x, *c; const int* pos; const float *norm_g, *w_ada, *b_ada, *w_in, *conv_w, *conv_b, *ln_g, *ln_b, *w_co, *w_ao, *w_o, *final_g;
    float* out; unsigned char* ws;
    float f0, f1, f2, f3, f4, f5, f6, f7;
};

__device__ __forceinline__ unsigned pk2(float lo, float hi) { return pg8::cvt_pk_bf16(lo, hi); }
__device__ __forceinline__ float bflo(unsigned w) { return __uint_as_float(w << 16); }
__device__ __forceinline__ float bfhi(unsigned w) { return __uint_as_float(w & 0xffff0000u); }
__device__ __forceinline__ float sigm(float x) { return __builtin_amdgcn_rcpf(1.f + __expf(-x)); }
__device__ __forceinline__ float wave_sum(float v) {
#pragma unroll
    for (int o = 1; o < 64; o <<= 1) v += __shfl_xor(v, o);
    return v;
}
__device__ __forceinline__ u32x4 pack8(const f32x4 a, const f32x4 b) { u32x4 w; w.x = pk2(a[0], a[1]); w.y = pk2(a[2], a[3]); w.z = pk2(b[0], b[1]); w.w = pk2(b[2], b[3]); return w; }
__device__ __forceinline__ f32x4 sigm4(const f32x4 v) { return (f32x4){sigm(v[0]), sigm(v[1]), sigm(v[2]), sigm(v[3])}; }
__device__ __forceinline__ unsigned un8x4(const f32x4 s) {
    const unsigned a = (unsigned)(s[0] * 255.f + 0.5f), b = (unsigned)(s[1] * 255.f + 0.5f), c = (unsigned)(s[2] * 255.f + 0.5f), d = (unsigned)(s[3] * 255.f + 0.5f);
    return a | (b << 8) | (c << 16) | (d << 24);
}
__device__ __forceinline__ f32x4 deq8(unsigned w) { return (f32x4){(float)(w & 255u), (float)((w >> 8) & 255u), (float)((w >> 16) & 255u), (float)(w >> 24)} * (1.0f / 255.0f); }
__device__ __forceinline__ f32x4 byte4(unsigned w) { return (f32x4){(float)(w & 255u), (float)((w >> 8) & 255u), (float)((w >> 16) & 255u), (float)(w >> 24)}; }
__device__ __forceinline__ f32x4 clamp1(const f32x4 v) { return (f32x4){fmaxf(v[0], 1.f), fmaxf(v[1], 1.f), fmaxf(v[2], 1.f), fmaxf(v[3], 1.f)}; }
__device__ __forceinline__ f32x4 deq8c(unsigned w) { return clamp1(byte4(w)) * (1.0f / 255.0f); }
__device__ __forceinline__ f32x4 ratio8(unsigned num, unsigned den) { const f32x4 d = clamp1(byte4(den)); return byte4(num) * (f32x4){__builtin_amdgcn_rcpf(d[0]), __builtin_amdgcn_rcpf(d[1]), __builtin_amdgcn_rcpf(d[2]), __builtin_amdgcn_rcpf(d[3])}; }
__device__ __forceinline__ f32x4 bf4lo(unsigned w0, unsigned w1) { return (f32x4){bflo(w0), bfhi(w0), bflo(w1), bfhi(w1)}; }

__device__ __forceinline__ size_t qkv_off(int b, int g, int j, int t) { const int sh = 2 * g; return ((size_t)(((b * 3 + g) * 8 + j) * SEQ + ((t & ((1 << sh) - 1)) << (13 - sh)) + (t >> sh))) * 64; }

struct Epi1 {
    static constexpr bool PERM = true, AFTER_DRAIN = false, PAIRED = false;
    unsigned char *ws, *dout;
    __device__ __forceinline__ void operator()(const f32x4 (&acc)[2][2][4][2], const pg8::Unit& u, int wr, int wc, int fr, int fq) const {
        const int pn = u.pn, row0 = u.pm * 256 + wr * 64 + fr, cl = wc * 32 + 8 * fq;
        bf16_t* const U = (bf16_t*)(ws + WS_U); bf16_t* const ZC = (bf16_t*)(ws + WS_ZC); bf16_t* const Q = (bf16_t*)(ws + WS_Q); bf16_t* const K = (bf16_t*)(ws + WS_K); bf16_t* const V = (bf16_t*)(ws + WS_V);
        bf16_t* const ZA = (bf16_t*)(dout + DO_ZA); unsigned char* const GC8 = dout + DO_GC; unsigned char* const GA8 = ws + WS_GA; const float* const CS = (const float*)(ws + WS_CS);
        if (pn < 8) {
#pragma unroll
            for (int ai = 0; ai < 2; ++ai)
#pragma unroll
                for (int m = 0; m < 4; ++m) {
                    const size_t row = (size_t)(row0 + ai * 128 + m * 16);
                    const f32x4 a0 = acc[ai][0][m][0] * sigm4(acc[ai][1][m][0]), a1 = acc[ai][0][m][1] * sigm4(acc[ai][1][m][1]);
                    *(u32x4*)(U + row * 1024 + pn * 128 + cl) = pack8(a0, a1);
                }
        } else if (pn < 12 || pn == 30 || pn == 31) {
            bf16_t* base = pn < 12 ? ZC : ZA; const int pitch = pn < 12 ? 1024 : 512, col0 = (pn < 12 ? (pn - 8) : (pn - 30)) * 256 + cl;
#pragma unroll
            for (int ai = 0; ai < 2; ++ai)
#pragma unroll
                for (int m = 0; m < 4; ++m) {
                    const size_t row = (size_t)(row0 + ai * 128 + m * 16);
#pragma unroll
                    for (int bj = 0; bj < 2; ++bj) {
                        const f32x4 v0 = acc[ai][bj][m][0], v1 = acc[ai][bj][m][1];
                        *(u32x4*)(base + row * pitch + col0 + bj * 128) = pack8(v0 * sigm4(v0), v1 * sigm4(v1));
                    }
                }
        } else if (pn < 24) {
            const bool isq = pn < 18; bf16_t* base = isq ? Q : K; const int pl = pn - (isq ? 12 : 18), g = pl >> 1, dim0 = (wc & 1) * 32 + 8 * fq; const float sc = isq ? QSCALE : 1.0f;
            const bool rot = ((wc & 1) == 0) && (fq < 2);
#pragma unroll
            for (int ai = 0; ai < 2; ++ai)
#pragma unroll
                for (int m = 0; m < 4; ++m) {
                    const size_t row = (size_t)(row0 + ai * 128 + m * 16);
                    f32x4 cv = (f32x4){1.f, 1.f, 1.f, 1.f}, sv = (f32x4){0.f, 0.f, 0.f, 0.f};
                    if (rot) { cv = *(const f32x4*)(CS + row * 16 + 4 * fq); sv = *(const f32x4*)(CS + row * 16 + 8 + 4 * fq); }
#pragma unroll
                    for (int bj = 0; bj < 2; ++bj) {
                        const f32x4 v0 = acc[ai][bj][m][0], v1 = acc[ai][bj][m][1];
                        const f32x4 n0 = (v0 * cv - v1 * sv) * sc, n1 = (v1 * cv + v0 * sv) * sc;
                        *(u32x4*)(base + qkv_off((int)(row >> 13), g, (4 * pl + 2 * bj + (wc >> 1)) & 7, (int)(row & (SEQ - 1))) + dim0) = pack8(n0, n1);
                    }
                }
        } else if (pn < 30) {
            const int pl = pn - 24, g = pl >> 1, dim0 = (wc & 1) * 32 + 8 * fq;
#pragma unroll
            for (int ai = 0; ai < 2; ++ai)
#pragma unroll
                for (int m = 0; m < 4; ++m) {
                    const size_t row = (size_t)(row0 + ai * 128 + m * 16);
#pragma unroll
                    for (int bj = 0; bj < 2; ++bj) *(u32x4*)(V + qkv_off((int)(row >> 13), g, (4 * pl + 2 * bj + (wc >> 1)) & 7, (int)(row & (SEQ - 1))) + dim0) = pack8(acc[ai][bj][m][0], acc[ai][bj][m][1]);
                }
        } else {
            unsigned char* base = pn < 36 ? GC8 : GA8; const int col0 = (pn - (pn < 36 ? 32 : 36)) * 256 + cl;
#pragma unroll
            for (int ai = 0; ai < 2; ++ai)
#pragma unroll
                for (int m = 0; m < 4; ++m) {
                    const size_t row = (size_t)(row0 + ai * 128 + m * 16);
#pragma unroll
                    for (int bj = 0; bj < 2; ++bj) { u32x2 w; w.x = un8x4(sigm4(acc[ai][bj][m][0])); w.y = un8x4(sigm4(acc[ai][bj][m][1])); *(u32x2*)(base + row * 1024 + col0 + bj * 128) = w; }
                }
        }
    }
};
struct Epi34 {
    static constexpr bool PERM = true, AFTER_DRAIN = false, PAIRED = true;
    const unsigned char* GC8; const unsigned char* GA8; bf16_t* MG;
    __device__ __forceinline__ void mid(f32x4 (&acc)[2][2][4][2], const pg8::Unit& u, int wr, int wc, int fr, int fq) const {
        const int row0 = u.pm * 256 + wr * 64 + fr, col0 = u.pn * 256 + wc * 32 + 8 * fq;
#pragma unroll
        for (int ai = 0; ai < 2; ++ai)
#pragma unroll
            for (int m = 0; m < 4; ++m) {
                const size_t row = (size_t)(row0 + ai * 128 + m * 16);
#pragma unroll
                for (int bj = 0; bj < 2; ++bj) {
                    const u32x2 gc = *(const u32x2*)(GC8 + row * 1024 + col0 + bj * 128), ga = *(const u32x2*)(GA8 + row * 1024 + col0 + bj * 128);
                    acc[ai][bj][m][0] *= ratio8(gc.x, ga.x); acc[ai][bj][m][1] *= ratio8(gc.y, ga.y);
                }
            }
    }
    __device__ __forceinline__ void operator()(const f32x4 (&acc)[2][2][4][2], const pg8::Unit& u, int wr, int wc, int fr, int fq) const {
        const int row0 = u.pm * 256 + wr * 64 + fr, col0 = u.pn * 256 + wc * 32 + 8 * fq;
#pragma unroll
        for (int ai = 0; ai < 2; ++ai)
#pragma unroll
            for (int m = 0; m < 4; ++m) {
                const size_t row = (size_t)(row0 + ai * 128 + m * 16);
#pragma unroll
                for (int bj = 0; bj < 2; ++bj) {
                    const u32x2 ga = *(const u32x2*)(GA8 + row * 1024 + col0 + bj * 128);
                    *(u32x4*)(MG + row * 1024 + col0 + bj * 128) = pack8(acc[ai][bj][m][0] * deq8c(ga.x), acc[ai][bj][m][1] * deq8c(ga.y));
                }
            }
    }
};
struct Epi5 {
    static constexpr bool PERM = true, AFTER_DRAIN = false, PAIRED = false;
    const float* x; const float* MOD; float* out; const float* fg; float* xbuf; unsigned* cnt; LAS unsigned char* xl;
    __device__ __forceinline__ void operator()(const f32x4 (&acc_)[2][2][4][2], const pg8::Unit& u, int wr, int wc, int fr, int fq) const {
        f32x4 (&acc)[2][2][4][2] = const_cast<f32x4 (&)[2][2][4][2]>(acc_);
        const int row0 = u.pm * 256 + wr * 64 + fr, col0 = u.pn * 256 + wc * 32 + 8 * fq, b = u.pm >> 5, wid = wr * 4 + wc, tid = wid * 64 + fq * 16 + fr;
        LAS float* P = (LAS float*)xl; LAS float* S = (LAS float*)(xl + 4096);
        {
            f32x4 gt[2][2];
#pragma unroll
            for (int bj = 0; bj < 2; ++bj) { gt[bj][0] = *(const f32x4*)(MOD + b * 3072 + 2048 + col0 + bj * 128); gt[bj][1] = *(const f32x4*)(MOD + b * 3072 + 2048 + col0 + bj * 128 + 4); }
#pragma unroll
            for (int ai = 0; ai < 2; ++ai)
#pragma unroll
                for (int m = 0; m < 4; ++m) {
                    const size_t row = (size_t)(row0 + ai * 128 + m * 16);
                    float ss = 0.f;
#pragma unroll
                    for (int bj = 0; bj < 2; ++bj) {
                        const f32x4 xa = *(const f32x4*)(x + row * 1024 + col0 + bj * 128), xb = *(const f32x4*)(x + row * 1024 + col0 + bj * 128 + 4);
                        const f32x4 o0 = xa + gt[bj][0] * acc[ai][bj][m][0], o1 = xb + gt[bj][1] * acc[ai][bj][m][1];
                        acc[ai][bj][m][0] = o0; acc[ai][bj][m][1] = o1;
                        ss += (o0[0] * o0[0] + o0[1] * o0[1]) + (o0[2] * o0[2] + o0[3] * o0[3]) + (o1[0] * o1[0] + o1[1] * o1[1]) + (o1[2] * o1[2] + o1[3] * o1[3]);
                    }
                    ss += __shfl_xor(ss, 16); ss += __shfl_xor(ss, 32);
                    if (fq == 0) P[(ai * 128 + wr * 64 + m * 16 + fr) * 4 + wc] = ss;
                }
        }
        asm volatile("s_waitcnt lgkmcnt(0)" ::: "memory"); __builtin_amdgcn_s_barrier(); asm volatile("" ::: "memory");
        if (tid < 256) {
            const float t = (P[tid * 4 + 0] + P[tid * 4 + 1]) + (P[tid * 4 + 2] + P[tid * 4 + 3]);
            __hip_atomic_store(xbuf + ((size_t)(u.pm * 256 + tid) * 4 + u.pn), t, __ATOMIC_RELAXED, __HIP_MEMORY_SCOPE_AGENT);
        }
        asm volatile("s_waitcnt vmcnt(0)" ::: "memory");
        if (wid < 4 && fq == 0 && fr == 0) __hip_atomic_fetch_add(cnt + 64 * u.pm, 1u, __ATOMIC_RELAXED, __HIP_MEMORY_SCOPE_AGENT);
        if (wid == 0) {
            unsigned sp = 0;
            while ((unsigned)__builtin_amdgcn_readfirstlane(__hip_atomic_load(cnt + 64 * u.pm, __ATOMIC_RELAXED, __HIP_MEMORY_SCOPE_AGENT)) < 16u) { __builtin_amdgcn_s_sleep(2); if (++sp > (1u << 22)) break; }
            __builtin_amdgcn_fence(__ATOMIC_ACQUIRE, "agent");
        }
        asm volatile("s_waitcnt vmcnt(0) lgkmcnt(0)" ::: "memory"); __builtin_amdgcn_s_barrier(); asm volatile("" ::: "memory");
        if (tid < 256) {
            const float* sl = xbuf + (size_t)(u.pm * 256 + tid) * 4;
            const float t = (__hip_atomic_load(sl + 0, __ATOMIC_RELAXED, __HIP_MEMORY_SCOPE_AGENT) + __hip_atomic_load(sl + 1, __ATOMIC_RELAXED, __HIP_MEMORY_SCOPE_AGENT))
                          + (__hip_atomic_load(sl + 2, __ATOMIC_RELAXED, __HIP_MEMORY_SCOPE_AGENT) + __hip_atomic_load(sl + 3, __ATOMIC_RELAXED, __HIP_MEMORY_SCOPE_AGENT));
            S[tid] = 1.0f / sqrtf(t * (1.f / 1024.f) + EPS);
        }
        asm volatile("s_waitcnt vmcnt(0) lgkmcnt(0)" ::: "memory"); __builtin_amdgcn_s_barrier(); asm volatile("" ::: "memory");
        f32x4 fv[2][2];
#pragma unroll
        for (int bj = 0; bj < 2; ++bj) { fv[bj][0] = *(const f32x4*)(fg + col0 + bj * 128); fv[bj][1] = *(const f32x4*)(fg + col0 + bj * 128 + 4); }
#pragma unroll
        for (int ai = 0; ai < 2; ++ai)
#pragma unroll
            for (int m = 0; m < 4; ++m) {
                const int rl = ai * 128 + wr * 64 + m * 16 + fr; const float sr = S[rl]; const size_t row = (size_t)(u.pm * 256 + rl);
#pragma unroll
                for (int bj = 0; bj < 2; ++bj) {
                    *(f32x4*)(out + row * 1024 + col0 + bj * 128) = acc[ai][bj][m][0] * sr * fv[bj][0];
                    *(f32x4*)(out + row * 1024 + col0 + bj * 128 + 4) = acc[ai][bj][m][1] * sr * fv[bj][1];
                }
            }
    }
};

__device__ __forceinline__ int src_col(int n) {
    const int tile = n >> 8, loc = n & 255;
    if (tile < 8) return (loc < 128) ? tile * 128 + loc : 1024 + tile * 128 + (loc - 128);
    if (tile >= 12 && tile < 24) { const int p = loc & 63; if (p < 16) return (n & ~63) + (p & 3) + ((p >> 2) & 1) * 8 + ((p >> 3) & 1) * 4; }
    return n;
}
template <bool PERMUTE>
__device__ __forceinline__ void transpose_item(const float* W, int K, int N, bf16_t* WT, LAS float* scr, int item, int lane) {
    const int nblk = N / 32, kb = item / nblk, nb = item % nblk, k0 = 64 * kb, n0 = 32 * nb;
    const int sn = PERMUTE ? src_col(n0 + (lane & 31)) : n0 + (lane & 31);
#pragma unroll 8
    for (int i = 0; i < 32; ++i) { const int kk = 2 * i + (lane >> 5); scr[kk * 33 + (lane & 31)] = W[(size_t)(k0 + kk) * N + sn]; }
    asm volatile("s_waitcnt lgkmcnt(0)" ::: "memory");
    const int c = lane & 7;
#pragma unroll
    for (int j = 0; j < 4; ++j) { const int n = (lane >> 3) + 8 * j; const LAS float* s = scr + (8 * c) * 33 + n;
        u32x4 o; o.x = pk2(s[0 * 33], s[1 * 33]); o.y = pk2(s[2 * 33], s[3 * 33]); o.z = pk2(s[4 * 33], s[5 * 33]); o.w = pk2(s[6 * 33], s[7 * 33]);
        *(u32x4*)(WT + (size_t)(n0 + n) * K + k0 + 8 * c) = o; }
    asm volatile("s_waitcnt lgkmcnt(0)" ::: "memory");
}

__device__ __forceinline__ void conv_oct(const f32x2 (&u)[38], const f32x2 (&w)[31], const f32x2 bias, LAS f32x2* acc) {
#pragma unroll
    for (int tt = 0; tt < 8; ++tt) {
        f32x2 a = bias;
#pragma unroll
        for (int k = 0; k < 31; ++k) a += w[k] * u[tt + k];
        acc[tt * 512] = a;
    }
}
__device__ __forceinline__ void conv_load8(unsigned (&nw)[8], const unsigned* up) {
#pragma unroll
    for (int i = 0; i < 8; ++i) nw[i] = up[(long)i * 512];
}
__device__ __forceinline__ void conv_slide(f32x2 (&u)[38], const unsigned (&nw)[8]) {
#pragma unroll
    for (int i = 0; i < 30; ++i) u[i] = u[i + 8];
#pragma unroll
    for (int i = 0; i < 8; ++i) u[30 + i] = (f32x2){bflo(nw[i]), bfhi(nw[i])};
}
__device__ __forceinline__ void conv_items(const Params& p, LAS unsigned char* lds, int bid, int G, int tid) {
    const bf16_t* U = (const bf16_t*)(p.ws + WS_U); bf16_t* ZC = (bf16_t*)(p.ws + WS_ZC);
    const int c = 2 * tid;
    f32x2 w[31];
#pragma unroll
    for (int k = 0; k < 31; ++k) w[k] = *(const f32x2*)(p.conv_w + k * 1024 + c);
    const f32x2 bias = *(const f32x2*)(p.conv_b + c);
    const f32x2 g2 = *(const f32x2*)(p.ln_g + c), b2 = *(const f32x2*)(p.ln_b + c);
    LAS f32x2* red = (LAS f32x2*)lds;
    LAS f32x2* stats = (LAS f32x2*)(lds + 131072);
    for (int it = bid; it < 1024; it += G) {
        const int row0 = it * 32, s0 = row0 & (SEQ - 1);
        const unsigned* up = (const unsigned*)(U + ((long)row0 - 30) * 1024 + c);
        f32x2 u[38]; unsigned nw[8];
        {
            unsigned raw[38];
#pragma unroll
            for (int s = 0; s < 30; ++s) raw[s] = 0u;
            if (s0 > 0) {
#pragma unroll
                for (int s = 0; s < 30; ++s) raw[s] = up[(long)s * 512];
            }
#pragma unroll
            for (int s = 30; s < 38; ++s) raw[s] = up[(long)s * 512];
            conv_load8(nw, up + 38L * 512);
#pragma unroll
            for (int s = 0; s < 38; ++s) u[s] = (f32x2){bflo(raw[s]), bfhi(raw[s])};
        }
        conv_oct(u, w, bias, red + tid);
        conv_slide(u, nw); conv_load8(nw, up + 46L * 512); conv_oct(u, w, bias, red + 8 * 512 + tid);
        conv_slide(u, nw); conv_load8(nw, up + 54L * 512); conv_oct(u, w, bias, red + 16 * 512 + tid);
        conv_slide(u, nw); conv_oct(u, w, bias, red + 24 * 512 + tid);
        unsigned* zp = (unsigned*)(ZC + (size_t)row0 * 1024 + c);
        unsigned zz[32];
#pragma unroll
        for (int t = 0; t < 32; ++t) zz[t] = zp[(size_t)t * 512];
        __syncthreads();
        {
            const int t = tid >> 4, part = tid & 15; float s1 = 0.f, s2 = 0.f;
#pragma unroll 8
            for (int i = 0; i < 32; ++i) { const f32x2 v = red[t * 512 + part + 16 * i]; s1 += v.x + v.y; s2 += v.x * v.x + v.y * v.y; }
#pragma unroll
            for (int o = 1; o < 16; o <<= 1) { s1 += __shfl_xor(s1, o); s2 += __shfl_xor(s2, o); }
            if (part == 0) { const float mean = s1 * (1.f / 1024.f); const float var = fmaxf(s2 * (1.f / 1024.f) - mean * mean, 0.f); stats[t] = (f32x2){mean, 1.0f / sqrtf(var + EPS)}; }
        }
        __syncthreads();
#pragma unroll
        for (int t = 0; t < 32; ++t) {
            const f32x2 st = stats[t], av = red[t * 512 + tid];
            float y0 = (av.x - st.x) * st.y * g2.x + b2.x, y1 = (av.y - st.x) * st.y * g2.y + b2.y;
            y0 *= sigm(y0); y1 *= sigm(y1);
            zp[(size_t)t * 512] = pk2(y0 * bflo(zz[t]), y1 * bfhi(zz[t]));
        }
        __syncthreads();
    }
}

typedef short v4i16_t __attribute__((ext_vector_type(4)));
__device__ __forceinline__ s16x4 vtr(const LAS unsigned char* p) { return __builtin_bit_cast(s16x4, __builtin_amdgcn_ds_read_tr16_b64_v4i16((LAS v4i16_t*)p)); }
constexpr int KV_ROWB = 160, LDS_VOFF = 256 * KV_ROWB;
struct AttnPre { u32x4 kv[8]; bf16x8 q0, q1; };
__device__ __forceinline__ void attn_decode(int idx, int& b, int& g, int& j, int& r, int& n, int& sh, size_t& sub) {
    const int q64 = idx & 63; int rest = idx >> 6; j = rest & 7; rest >>= 3; g = rest % 3; b = rest / 3;
    sh = 2 * g; r = q64 >> (6 - sh); n = q64 & ((64 >> sh) - 1);
    sub = ((size_t)(((b * 3 + g) * 8 + j) * SEQ) + ((size_t)r << (13 - sh))) * 64;
}
__device__ __forceinline__ void attn_prefetch(const Params& p, int idx, int tid, int lane, int w, AttnPre& R) {
    const bf16_t* Q = (const bf16_t*)(p.ws + WS_Q); const bf16_t* K = (const bf16_t*)(p.ws + WS_K); const bf16_t* V = (const bf16_t*)(p.ws + WS_V);
    int b, g, j, r, n, sh; size_t sub; attn_decode(idx, b, g, j, r, n, sh, sub);
    const int nprev = n > 0 ? n - 1 : n;
    const size_t rp = sub + (size_t)nprev * 8192 + tid * 8, rc = sub + (size_t)n * 8192 + tid * 8;
    R.kv[0] = *(const u32x4*)(K + rp); R.kv[1] = *(const u32x4*)(K + rp + 4096); R.kv[2] = *(const u32x4*)(K + rc); R.kv[3] = *(const u32x4*)(K + rc + 4096);
    R.kv[4] = *(const u32x4*)(V + rp); R.kv[5] = *(const u32x4*)(V + rp + 4096); R.kv[6] = *(const u32x4*)(V + rc); R.kv[7] = *(const u32x4*)(V + rc + 4096);
    const bf16_t* qptr = Q + sub + (size_t)(n * 128 + 16 * w + (lane & 15)) * 64 + 8 * (lane >> 4);
    R.q0 = *(const bf16x8*)(qptr); R.q1 = *(const bf16x8*)(qptr + 32);
}
__device__ __forceinline__ void attn_stage(LAS unsigned char* lds, int tid, const AttnPre& R) {
    LAS unsigned char* dp = lds + (tid >> 3) * KV_ROWB + (tid & 7) * 16; LAS unsigned char* dc = dp + 128 * KV_ROWB;
    *(LAS u32x4*)(dp) = R.kv[0]; *(LAS u32x4*)(dp + 64 * KV_ROWB) = R.kv[1]; *(LAS u32x4*)(dc) = R.kv[2]; *(LAS u32x4*)(dc + 64 * KV_ROWB) = R.kv[3];
    *(LAS u32x4*)(dp + LDS_VOFF) = R.kv[4]; *(LAS u32x4*)(dp + LDS_VOFF + 64 * KV_ROWB) = R.kv[5]; *(LAS u32x4*)(dc + LDS_VOFF) = R.kv[6]; *(LAS u32x4*)(dc + LDS_VOFF + 64 * KV_ROWB) = R.kv[7];
}
__device__ __forceinline__ void attn_compute(const Params& p, LAS unsigned char* lds, int idx, int lane, int w, const bf16x8 qf0, const bf16x8 qf1) {
    bf16_t* Q = (bf16_t*)(p.ws + WS_Q); float* LSE = (float*)(p.ws + WS_LSE);
    int b, g, j, r, n, sh; size_t sub; attn_decode(idx, b, g, j, r, n, sh, sub);
    const int d = 1 << sh;
    const int fr = lane & 15, fq = lane >> 4;
    const size_t qrow = (size_t)b * SEQ + (size_t)(n * 128 + 16 * w + fr) * d + r;
    bf16_t* qptr = Q + sub + (size_t)(n * 128 + 16 * w + fr) * 64;
    f32x4 s[9];
#pragma unroll
    for (int tp = 0; tp < 9; ++tp) {
        const LAS unsigned char* kb = lds + (16 * (w + tp) + fr) * KV_ROWB + fq * 16;
        const bf16x8 ka = *(const LAS bf16x8*)kb, kc = *(const LAS bf16x8*)(kb + 64);
        f32x4 z = (f32x4){0.f, 0.f, 0.f, 0.f};
        z = __builtin_amdgcn_mfma_f32_16x16x32_bf16(ka, qf0, z, 0, 0, 0);
        s[tp] = __builtin_amdgcn_mfma_f32_16x16x32_bf16(kc, qf1, z, 0, 0, 0);
    }
    const float NEG = -1e30f;
#pragma unroll
    for (int jj = 0; jj < 4; ++jj) { const int key = 4 * fq + jj; if (key < fr) s[0][jj] = NEG; if (key > fr) s[8][jj] = NEG; }
    if (n == 0) {
#pragma unroll
        for (int tp = 0; tp < 8; ++tp) if (w + tp < 8) s[tp] = (f32x4){NEG, NEG, NEG, NEG};
    }
    float mx = NEG;
#pragma unroll
    for (int tp = 0; tp < 9; ++tp) mx = fmaxf(fmaxf(mx, fmaxf(s[tp][0], s[tp][1])), fmaxf(s[tp][2], s[tp][3]));
    mx = fmaxf(mx, __shfl_xor(mx, 16)); mx = fmaxf(mx, __shfl_xor(mx, 32));
    float l = 0.f;
#pragma unroll
    for (int tp = 0; tp < 9; ++tp)
#pragma unroll
        for (int jj = 0; jj < 4; ++jj) { const float e = __builtin_amdgcn_exp2f(s[tp][jj] - mx); s[tp][jj] = e; l += e; }
    u32x4 pw[5];
#pragma unroll
    for (int kp = 0; kp < 4; ++kp) pw[kp] = pack8(s[2 * kp], s[2 * kp + 1]);
    pw[4] = pack8(s[8], (f32x4){0.f, 0.f, 0.f, 0.f});
    f32x4 ot[4];
#pragma unroll
    for (int dt = 0; dt < 4; ++dt) ot[dt] = (f32x4){0.f, 0.f, 0.f, 0.f};
    const LAS unsigned char* vbase = lds + LDS_VOFF + (16 * w + 4 * fq + (fr >> 2)) * KV_ROWB + (fr & 3) * 8;
#pragma unroll
    for (int kp = 0; kp < 5; ++kp)
#pragma unroll
        for (int dt = 0; dt < 4; ++dt) {
            const s16x4 lo = vtr(vbase + (2 * kp) * 16 * KV_ROWB + dt * 32);
            s16x4 hi = (s16x4){0, 0, 0, 0};
            if (kp < 4) hi = vtr(vbase + (2 * kp + 1) * 16 * KV_ROWB + dt * 32);
            const bf16x8 a = (bf16x8){lo[0], lo[1], lo[2], lo[3], hi[0], hi[1], hi[2], hi[3]};
            ot[dt] = __builtin_amdgcn_mfma_f32_16x16x32_bf16(a, __builtin_bit_cast(bf16x8, pw[kp]), ot[dt], 0, 0, 0);
        }
    l += __shfl_xor(l, 16); l += __shfl_xor(l, 32);
    const float inv = 1.0f / l;
#pragma unroll
    for (int dt = 0; dt < 4; ++dt) { u32x2 o; o.x = pk2(ot[dt][0] * inv, ot[dt][1] * inv); o.y = pk2(ot[dt][2] * inv, ot[dt][3] * inv); *(u32x2*)(qptr + 16 * dt + 4 * fq) = o; }
    if (fq == 0) LSE[((size_t)g * M + qrow) * 8 + j] = mx + __log2f(l);
}

__global__ void __launch_bounds__(512, 2) fwd_megakernel(Params p) {
    extern __shared__ __attribute__((aligned(16))) unsigned char lds_raw[];
    LAS unsigned char* lds = (LAS unsigned char*)lds_raw;
    cg::grid_group grid = cg::this_grid();
    int tid, lane, wave, gw;
#define RELANE() do { int t_ = threadIdx.x; asm volatile("" : "+v"(t_)); tid = t_; lane = tid & 63; wave = __builtin_amdgcn_readfirstlane(tid >> 6); gw = bid * 8 + wave; } while (0)
    const int G = gridDim.x, bid = blockIdx.x, NGW = G * 8;
    RELANE();
    unsigned char* ws = p.ws; unsigned char* dout = (unsigned char*)p.out;
    float* MOD = (float*)(ws + WS_MOD); float* CS = (float*)(ws + WS_CS); float* SSQ = (float*)(ws + WS_SSQ);
    bf16_t* W1T = (bf16_t*)(ws + WS_W1T); bf16_t* WCO = (bf16_t*)(ws + WS_WCO); bf16_t* WAO = (bf16_t*)(ws + WS_WAO); bf16_t* WO = (bf16_t*)(ws + WS_WO);
    bf16_t* H = (bf16_t*)(dout + DO_H); bf16_t* ZA = (bf16_t*)(dout + DO_ZA); unsigned char* GC8 = dout + DO_GC;
    unsigned* const barw = (unsigned*)(ws + WS_BAR);
    unsigned* const pcnt = (unsigned*)(ws + WS_BAR + 65536);
    volatile LAS unsigned* const misc = (volatile LAS unsigned*)(lds + 131072 + 1024);
    if (tid == 0) { misc[0] = 0u; misc[1] = 0u; }
    __syncthreads();
    XcdBarrier xbar = xcd_barrier_post(barw, misc);
    if (G == 0x7fffffff) grid.sync();
#define GSYNC() do { xcd_barrier(xbar); RELANE(); } while (0)

    for (int it = bid; it < 96 * 8; it += G) {
        const int cgp = it % 96, kc = it / 96, n0 = cgp * 32, col = tid & 31, ks = tid >> 5;
        float a0 = 0.f, a1 = 0.f, a2 = 0.f, a3 = 0.f;
        const int kb = kc * 128 + ks * 8;
        const float* wp = p.w_ada + (size_t)kb * 3072 + n0 + col; const float* cc = p.c + kb;
#pragma unroll
        for (int k = 0; k < 8; ++k) { const float wv = wp[(size_t)k * 3072]; a0 += cc[k] * wv; a1 += cc[1024 + k] * wv; a2 += cc[2048 + k] * wv; a3 += cc[3072 + k] * wv; }
        LAS float* red = (LAS float*)lds;
        red[(ks * 4 + 0) * 32 + col] = a0; red[(ks * 4 + 1) * 32 + col] = a1; red[(ks * 4 + 2) * 32 + col] = a2; red[(ks * 4 + 3) * 32 + col] = a3;
        __syncthreads();
        if (tid < 128) { const int bb = tid >> 5; float sum = kc == 0 ? p.b_ada[n0 + col] : 0.f;
#pragma unroll
            for (int k2 = 0; k2 < 16; ++k2) sum += red[(k2 * 4 + bb) * 32 + col];
            atomicAdd(MOD + bb * 3072 + n0 + col, sum); }
        __syncthreads();
    }
    GSYNC();

    for (int rep0 = 0; rep0 < REP_P0; ++rep0) {
    {
        LAS float* scr = (LAS float*)(lds + wave * 16384);
        constexpr int I1 = 16 * 320, I2 = 16 * 32, I3 = 8 * 32, I4 = 16 * 32;
        for (int it = gw; it < I1 + I2 + I3 + I4; it += NGW) {
            int r = it;
            if (r < I1) { transpose_item<true>(p.w_in, 1024, NIN, W1T, scr, r, lane); continue; } r -= I1;
            if (r < I2) { transpose_item<false>(p.w_co, 1024, 1024, WCO, scr, r, lane); continue; } r -= I2;
            if (r < I3) { transpose_item<false>(p.w_ao, 1024  , 1024, WAO, scr, r, lane); continue; } r -= I3;
            transpose_item<false>(p.w_o, 1024, 1024, WO, scr, r, lane);
        }
    }
    for (int e = bid * 512 + tid; e < M * 8; e += G * 512) {
        const int row = e >> 3, i = e & 7;
        const float fi = i == 0 ? p.f0 : i == 1 ? p.f1 : i == 2 ? p.f2 : i == 3 ? p.f3 : i == 4 ? p.f4 : i == 5 ? p.f5 : i == 6 ? p.f6 : p.f7;
        const float ang = (float)p.pos[row] * fi;
        const double rev = (double)ang * 0.15915494309189535; const float frac = (float)(rev - __builtin_rint(rev));
        CS[row * 16 + i] = __builtin_amdgcn_cosf(frac); CS[row * 16 + 8 + i] = __builtin_amdgcn_sinf(frac);
    }
    for (int row = gw; row < M; row += NGW) {
        const f32x4* xr = (const f32x4*)(p.x + (size_t)row * 1024) + lane; f32x4 v[4]; float ss = 0.f;
#pragma unroll
        for (int jx = 0; jx < 4; ++jx) { v[jx] = xr[64 * jx]; ss += (v[jx][0] * v[jx][0] + v[jx][1] * v[jx][1]) + (v[jx][2] * v[jx][2] + v[jx][3] * v[jx][3]); }
        const float rstd = 1.0f / sqrtf(wave_sum(ss) * (1.f / 1024.f) + EPS);
        const float* mb = MOD + (row >> 13) * 3072;
#pragma unroll
        for (int jx = 0; jx < 4; ++jx) { const int col = 4 * lane + 256 * jx;
            const f32x4 gg = *(const f32x4*)(p.norm_g + col), scl = *(const f32x4*)(mb + 1024 + col), sft = *(const f32x4*)(mb + col);
            const f32x4 y = v[jx] * rstd * gg * (scl + 1.0f) + sft;
            u32x2 o; o.x = pk2(y[0], y[1]); o.y = pk2(y[2], y[3]); *(u32x2*)(H + (size_t)row * 1024 + col) = o; }
    }
    }
    GSYNC();

    for (int rep = 0; rep < REP_P1; ++rep) {
        pg8::Gemm g{H, W1T, M, NIN, 1024, H, W1T, 16, 16}; pg8::StaticOrder S; S.init(M, NIN, G, bid);
        Epi1 E{ws, dout};
        pg8::gemm_phase<Epi1, pg8::StaticOrder, true, true>(lds, g, S, E);
    }
    GSYNC();

    conv_items(p, lds, bid, G, tid);
    if (bid < 6144) {
        AttnPre R; attn_prefetch(p, bid, tid, lane, wave, R);
        for (int idx = bid; idx < 6144; idx += G) {
            __syncthreads();
            attn_stage(lds, tid, R); const bf16x8 qf0 = R.q0, qf1 = R.q1;
            __syncthreads();
            if (idx + G < 6144) attn_prefetch(p, idx + G, tid, lane, wave, R);
            for (int rep = 0; rep < REP_ATT; ++rep) attn_compute(p, lds, idx, lane, wave, qf0, qf1);
        }
    }
    GSYNC();

    for (int rep = 0; rep < REP_P3; ++rep) {
        const bf16_t* OG = (const bf16_t*)(ws + WS_Q); const float* LSE = (const float*)(ws + WS_LSE); bf16_t* A2 = (bf16_t*)(ws + WS_A2);
        for (int e = bid * 512 + tid; e < M * 64; e += G * 512) {
            const size_t row = (size_t)(e >> 6); const int jc = e & 63, j = jc >> 3;
            const float l0 = LSE[row * 8 + j], l1 = LSE[((size_t)M + row) * 8 + j], l2 = LSE[((size_t)2 * M + row) * 8 + j];
            const float mxl = fmaxf(l0, fmaxf(l1, l2));
            float w0 = __builtin_amdgcn_exp2f(l0 - mxl), w1 = __builtin_amdgcn_exp2f(l1 - mxl), w2 = __builtin_amdgcn_exp2f(l2 - mxl);
            const float inv = 1.0f / (w0 + w1 + w2); w0 *= inv; w1 *= inv; w2 *= inv;
            const int bb = (int)(row >> 13), tt = (int)(row & (SEQ - 1)), c8 = (jc & 7) * 8;
            const u32x4 o0 = *(const u32x4*)(OG + qkv_off(bb, 0, j, tt) + c8), o1 = *(const u32x4*)(OG + qkv_off(bb, 1, j, tt) + c8), o2 = *(const u32x4*)(OG + qkv_off(bb, 2, j, tt) + c8);
            const u32x4 za = *(const u32x4*)(ZA + row * 512 + jc * 8);
            u32x4 o;
#pragma unroll
            for (int q = 0; q < 4; ++q) {
                const float lo = (w0 * bflo(o0[q]) + w1 * bflo(o1[q]) + w2 * bflo(o2[q])) * bflo(za[q]);
                const float hi = (w0 * bfhi(o0[q]) + w1 * bfhi(o1[q]) + w2 * bfhi(o2[q])) * bfhi(za[q]);
                o[q] = pk2(lo, hi);
            }
            *(u32x4*)(A2 + row * 1024 + jc * 8) = o;
        }
    }
    GSYNC();

    for (int rep = 0; rep < REP_P4; ++rep) {
        pg8::Gemm g{(const bf16_t*)(ws + WS_ZC), WCO, M, 1024, 1024, (const bf16_t*)(ws + WS_A2), WAO, 16, 8}; pg8::PairOrder S; S.init(M, 1024, G, bid);
        Epi34 E{GC8, ws + WS_GA, (bf16_t*)(ws + WS_MG)};
        pg8::gemm_phase<Epi34, pg8::PairOrder, true, true>(lds, g, S, E);
    }
    GSYNC();

    for (int rep = 0; rep < REP_P5; ++rep) {
        pg8::Gemm g{(const bf16_t*)(ws + WS_MG), WO, M, 1024, 1024, (const bf16_t*)(ws + WS_MG), WO, 16, 16}; pg8::StaticOrder S; S.init(M, 1024, G, bid);
        Epi5 E{p.x, MOD, p.out, p.final_g, SSQ, pcnt + rep * 128 * 64, lds + 131072 + 2048};
        pg8::gemm_phase<Epi5, pg8::StaticOrder, true, true>(lds, g, S, E);
    }
}

extern "C" void kernel_launch(void* const* d_in, const int* in_sizes, int n_in, void* d_out, int out_size, void* d_ws, size_t ws_size, hipStream_t stream) {
    static int grid = 0;
    if (grid == 0) {
        if (n_in != 15 || out_size != M * DM || ws_size < WS_END) { fprintf(stderr, "kernel_launch: unexpected sizes (n_in %d, out %d, ws %zu)\n", n_in, out_size, ws_size); grid = -1; return; }
        int dev = 0, cus = 0, per_cu = 0;
        (void)hipGetDevice(&dev); (void)hipDeviceGetAttribute(&cus, hipDeviceAttributeMultiprocessorCount, dev);
        (void)hipFuncSetAttribute((const void*)fwd_megakernel, hipFuncAttributeMaxDynamicSharedMemorySize, LDS_BYTES);
        if (hipOccupancyMaxActiveBlocksPerMultiprocessor(&per_cu, (const void*)fwd_megakernel, 512, LDS_BYTES) != hipSuccess || per_cu < 1) per_cu = 1;
        (void)hipGetLastError();
        grid = cus * per_cu;
    }
    if (grid < 0) return;
    Params p{};
    p.x = (const float*)d_in[0]; p.c = (const float*)d_in[1]; p.pos = (const int*)d_in[2]; p.norm_g = (const float*)d_in[3]; p.w_ada = (const float*)d_in[4]; p.b_ada = (const float*)d_in[5];
    p.w_in = (const float*)d_in[6]; p.conv_w = (const float*)d_in[7]; p.conv_b = (const float*)d_in[8]; p.ln_g = (const float*)d_in[9]; p.ln_b = (const float*)d_in[10];
    p.w_co = (const float*)d_in[11]; p.w_ao = (const float*)d_in[12]; p.w_o = (const float*)d_in[13]; p.final_g = (const float*)d_in[14];
    p.out = (float*)d_out; p.ws = (unsigned char*)d_ws;
    p.f0 = 1.0f; p.f1 = 1.939227432e-01f; p.f2 = 3.760603070e-02f; p.f3 = 7.292664610e-03f; p.f4 = 1.414213562e-03f; p.f5 = 2.742481884e-04f; p.f6 = 5.318295734e-05f; p.f7 = 1.031338525e-05f;
    if (hipMemsetAsync(d_ws, 0, 1 * MiB, stream) != hipSuccess) { fprintf(stderr, "kernel_launch: memset of the control words failed\n"); return; }
    void* args[] = {&p};
    const hipError_t e = hipLaunchCooperativeKernel((const void*)fwd_megakernel, dim3(grid), dim3(512), args, LDS_BYTES, stream);
    if (e != hipSuccess) fprintf(stderr, "cooperative launch failed: %s (grid %d)\n", hipGetErrorString(e), grid);
}
```

```cpp
#include <hip/hip_runtime.h>
#include <hip/hip_cooperative_groups.h>
#include <cstdio>
#include <cstdint>
namespace cg = cooperative_groups;
#define LAS __attribute__((address_space(3)))
namespace pg8 {
#define PG8_LAS __attribute__((address_space(3)))
typedef unsigned short bf16_t;
typedef short bf16x8 __attribute__((ext_vector_type(8)));
typedef float f32x4 __attribute__((ext_vector_type(4)));
typedef unsigned u32x4 __attribute__((ext_vector_type(4)));
constexpr int BM = 256, BK = 64, HALF = 128, HTB = HALF * BK * 2  , STAGE_BYTES = 8 * HTB, NXCD = 8, WGM = 8;

__host__ __device__ __forceinline__ int lds_byte(int r, int c) { const int st = (r >> 4) * 2 + (c >> 5), rr = r & 15, cc = c & 31, ob = rr * 64 + cc * 2; return st * 1024 + (ob ^ (((ob >> 9) & 1) << 5)); }
__host__ __device__ __forceinline__ void stage_rc(int b, int& R, int& C) { const int st = b / 1024, sb = b % 1024, swz = sb ^ (((sb >> 9) & 1) << 5); R = (st >> 1) * 16 + swz / 64; C = (st & 1) * 32 + (swz % 64) / 2; }
__host__ __device__ __forceinline__ int perm32(int rho) { const int n = rho >> 4, i = rho & 15; return 8 * (i >> 2) + 4 * n + (i & 3); }

struct Unit { int pm, pn, kind; };
struct Gemm { const bf16_t* A; const bf16_t* Bt; int M, N, K; const bf16_t* A1; const bf16_t* Bt1; int nt0, nt1; };

struct StaticOrder {
    int nM, nN, nwg, G, c, wgm;
    __host__ __device__ void init(int M, int N, int G_, int c_, int wgm_ = WGM) { nM = M / BM; nN = N / BM; nwg = nM * nN; G = G_; c = c_; wgm = wgm_; }
    __host__ __device__ bool next(int i, Unit& u) const {
        const long L = (long)i * G + c; if (L >= nwg) return false;
        int wgid = (int)L; { const int q = nwg / NXCD, r = nwg % NXCD, xcd = wgid % NXCD, off = wgid / NXCD; wgid = (xcd < r ? xcd * (q + 1) : r * (q + 1) + (xcd - r) * q) + off; }
        const int nig = wgm * nN, gid = wgid / nig, fm = gid * wgm, gsz = (nM - fm) < wgm ? (nM - fm) : wgm;
        u.pm = fm + ((wgid % nig) % gsz); u.pn = (wgid % nig) / gsz; u.kind = 0; return true;
    }
    __device__ __forceinline__ void a_ready(const Unit&) const {}
    __device__ __forceinline__ void done(const Unit&) const {}
};

__device__ __forceinline__ unsigned cvt_pk_bf16(float lo, float hi) { unsigned r; asm volatile("v_cvt_pk_bf16_f32 %0, %1, %2" : "=v"(r) : "v"(lo), "v"(hi)); return r; }
typedef float f32x2 __attribute__((ext_vector_type(2)));
struct XcdColOrder {
    StaticOrder base; int nM, nNx, lb, xcd, lc; bool ok;
    __host__ __device__ void init(int M, int N, int G_, int c_, int wgm_ = WGM) { base.init(M, N, G_, c_, wgm_); nM = M / BM; const int nN = N / BM; ok = (G_ % NXCD == 0) && (nN % NXCD == 0); nNx = nN / NXCD; lb = G_ / NXCD; xcd = c_ % NXCD; lc = c_ / NXCD; }
    __host__ __device__ bool next(int i, Unit& u) const {
        if (!ok) return base.next(i, u);
        const int t = i * lb + lc; if (t >= nM * nNx) return false;
        u.pm = t / nNx; u.pn = xcd + NXCD * (t % nNx); u.kind = 0; return true;
    }
    __device__ __forceinline__ void a_ready(const Unit&) const {}
    __device__ __forceinline__ void done(const Unit&) const {}
};
struct PairOrder {
    StaticOrder base;
    __host__ __device__ void init(int M, int N, int G_, int c_, int wgm_ = WGM) { base.init(M, N, G_, c_, wgm_); }
    __host__ __device__ bool next(int i, Unit& u) const { if (!base.next(i >> 1, u)) return false; u.kind = i & 1; return true; }
    __device__ __forceinline__ void a_ready(const Unit&) const {}
    __device__ __forceinline__ void done(const Unit&) const {}
};
template <class Epi, class Sched, bool ALIGN_EPI = false, bool SP2 = false>
__device__ __forceinline__ void gemm_phase(PG8_LAS unsigned char* lds, const Gemm g, const Sched& S, const Epi& E) {
    int tid_ = threadIdx.x; asm volatile("" : "+v"(tid_));
    const int tid = tid_, wid = __builtin_amdgcn_readfirstlane(tid >> 6), lane = tid & 63, wr = wid >> 2, wc = wid & 3, fr = lane & 15, fq = lane >> 4;
    const int K = g.K;
    unsigned voffA[2], voffB[2];
#pragma unroll
    for (int i = 0; i < 2; ++i) { int R, C; stage_rc(tid * 16 + i * 8192, R, C); const int Rb = Epi::PERM ? ((R & ~31) + perm32(R & 31)) : R;
        voffA[i] = (unsigned)(R * K + C) * 2u; voffB[i] = (unsigned)(Rb * K + C) * 2u; }
    const size_t kstep = (size_t)(BK * 2);
    const size_t hstep = (size_t)HALF * K * 2;
    const size_t tstep = 2 * hstep;
    const unsigned ldsw = (unsigned)wid * 1024u;
    const int aoff = lds_byte(wr * 64 + fr, fq * 8), boff = lds_byte(wc * 32 + fr, fq * 8);
#define PG8_SA(b, h) (((b) * 2 + (h)) * HTB)
#define PG8_SB(b, h) ((4 + (b) * 2 + (h)) * HTB)
#define PG8_STAGE(bufoff, gbase, voff) do { _Pragma("unroll") for (int _i = 0; _i < 2; ++_i) \
        __builtin_amdgcn_global_load_lds((const unsigned*)((const char*)(gbase) + (voff)[_i]), (PG8_LAS unsigned*)(lds + (bufoff) + ldsw + _i * 8192), 16, 0, 0); } while (0)
#define PG8_LDA(dst, b, h) do { _Pragma("unroll") for (int m = 0; m < 4; ++m) _Pragma("unroll") for (int k = 0; k < 2; ++k) dst[m][k] = *(const PG8_LAS bf16x8*)(lds + PG8_SA(b, h) + aoff + m * 2048 + k * 1024); } while (0)
#define PG8_LDB(dst, b, h) do { _Pragma("unroll") for (int n = 0; n < 2; ++n) _Pragma("unroll") for (int k = 0; k < 2; ++k) dst[n][k] = *(const PG8_LAS bf16x8*)(lds + PG8_SB(b, h) + boff + n * 2048 + k * 1024); } while (0)
#define PG8_MMA(ai, bj, At, Bt) do { __builtin_amdgcn_s_setprio(1); _Pragma("unroll") for (int m = 0; m < 4; ++m) _Pragma("unroll") for (int n = 0; n < 2; ++n) _Pragma("unroll") for (int k = 0; k < 2; ++k) \
        acc[ai][bj][m][n] = __builtin_amdgcn_mfma_f32_16x16x32_bf16(Bt[n][k], At[m][k], acc[ai][bj][m][n], 0, 0, 0); __builtin_amdgcn_s_setprio(0); } while (0)
#define PG8_WAIT_V(n) asm volatile("s_waitcnt vmcnt(" #n ")" ::: "memory")
#define PG8_WAIT_L(n) asm volatile("s_waitcnt lgkmcnt(" #n ")" ::: "memory")
#define PG8_BAR __builtin_amdgcn_s_barrier()
#define PG8_SCHED __builtin_amdgcn_sched_barrier(0)
    Unit cur, nxt; int ui = 0;
    if (!S.next(0, cur)) return;
    f32x4 acc[2][2][4][2];
#pragma unroll
    for (int a = 0; a < 2; ++a)
#pragma unroll
        for (int b = 0; b < 2; ++b)
#pragma unroll
            for (int m = 0; m < 4; ++m)
#pragma unroll
                for (int n = 0; n < 2; ++n) acc[a][b][m][n] = (f32x4){0.f, 0.f, 0.f, 0.f};
    bf16x8 At[4][2], B0[2][2], B1[2][2];
    const char* cA = (const char*)(cur.kind ? g.A1 : g.A) + (size_t)cur.pm * tstep; const char* cB = (const char*)(cur.kind ? g.Bt1 : g.Bt) + (size_t)cur.pn * tstep;
    S.a_ready(cur);
    if constexpr (SP2) {
        PG8_STAGE(PG8_SB(0, 0), cB, voffB); PG8_STAGE(PG8_SB(0, 1), cB + hstep, voffB); PG8_STAGE(PG8_SA(0, 0), cA, voffA); PG8_STAGE(PG8_SA(0, 1), cA + hstep, voffA);
        if (wr == 1) PG8_BAR;
        PG8_WAIT_V(2); PG8_BAR;
        PG8_STAGE(PG8_SB(1, 0), cB + kstep, voffB); PG8_STAGE(PG8_SA(1, 0), cA + kstep, voffA); PG8_STAGE(PG8_SB(1, 1), cB + hstep + kstep, voffB);
        PG8_WAIT_V(6); PG8_BAR;
    } else {
        PG8_STAGE(PG8_SB(0, 0), cB, voffB); PG8_STAGE(PG8_SA(0, 0), cA, voffA); PG8_STAGE(PG8_SB(0, 1), cB + hstep, voffB); PG8_STAGE(PG8_SA(0, 1), cA + hstep, voffA);
        if (wr == 1) PG8_BAR;
        PG8_WAIT_V(4); PG8_BAR;
        PG8_STAGE(PG8_SB(1, 0), cB + kstep, voffB); PG8_STAGE(PG8_SA(1, 0), cA + kstep, voffA); PG8_STAGE(PG8_SB(1, 1), cB + hstep + kstep, voffB);
        PG8_WAIT_V(6); PG8_BAR;
    }
    for (;;) {
        const bool has_next = S.next(ui + 1, nxt);
        const char* nA = has_next ? (const char*)(nxt.kind ? g.A1 : g.A) + (size_t)nxt.pm * tstep : cA; const char* nB = has_next ? (const char*)(nxt.kind ? g.Bt1 : g.Bt) + (size_t)nxt.pn * tstep : cB;
        const int nt = cur.kind ? g.nt1 : g.nt0;
        for (int t = 0; t < nt; t += 2) {
            const bool last = (t == nt - 2);
            const char* a1 = cA + (size_t)(t + 1) * kstep;
            const char* a2 = last ? nA : cA + (size_t)(t + 2) * kstep; const char* b2 = last ? nB : cB + (size_t)(t + 2) * kstep;
            const char* a3 = a2 + kstep; const char* b3 = b2 + kstep;
            if (last && has_next) S.a_ready(nxt);
            if constexpr (SP2) {
            PG8_LDB(B0, 0, 0); PG8_LDB(B1, 0, 1); PG8_SCHED; PG8_LDA(At, 0, 0); PG8_STAGE(PG8_SA(1, 1), a1 + hstep, voffA);
            PG8_WAIT_V(8); PG8_WAIT_L(0); PG8_BAR; PG8_MMA(0, 0, At, B0); PG8_MMA(0, 1, At, B1); PG8_BAR; PG8_SCHED;
            PG8_LDA(At, 0, 1); PG8_STAGE(PG8_SB(0, 0), b2, voffB); PG8_STAGE(PG8_SB(0, 1), b2 + hstep, voffB); PG8_STAGE(PG8_SA(0, 0), a2, voffA);
            PG8_WAIT_V(8); PG8_WAIT_L(0); PG8_BAR; PG8_MMA(1, 0, At, B0); PG8_MMA(1, 1, At, B1); PG8_BAR; PG8_SCHED;
            PG8_LDB(B0, 1, 0); PG8_LDB(B1, 1, 1); PG8_SCHED; PG8_LDA(At, 1, 0); PG8_STAGE(PG8_SA(0, 1), a2 + hstep, voffA);
            PG8_WAIT_V(8); PG8_WAIT_L(0); PG8_BAR; PG8_MMA(0, 0, At, B0); PG8_MMA(0, 1, At, B1); PG8_BAR; PG8_SCHED;
            PG8_LDA(At, 1, 1); PG8_STAGE(PG8_SB(1, 0), b3, voffB); PG8_STAGE(PG8_SB(1, 1), b3 + hstep, voffB); PG8_STAGE(PG8_SA(1, 0), a3, voffA);
            PG8_WAIT_V(8); PG8_WAIT_L(0); PG8_BAR; PG8_MMA(1, 0, At, B0); PG8_MMA(1, 1, At, B1); PG8_BAR; PG8_SCHED;
            } else {
            PG8_LDB(B0, 0, 0); PG8_SCHED; PG8_LDA(At, 0, 0); PG8_STAGE(PG8_SA(1, 1), a1 + hstep, voffA);
            PG8_WAIT_L(8); PG8_BAR; PG8_WAIT_L(0); PG8_MMA(0, 0, At, B0); PG8_BAR; PG8_SCHED;
            PG8_LDB(B1, 0, 1); PG8_STAGE(PG8_SB(0, 0), b2, voffB);
            PG8_BAR; PG8_WAIT_L(0); PG8_MMA(0, 1, At, B1); PG8_BAR;
            PG8_LDA(At, 0, 1); PG8_STAGE(PG8_SA(0, 0), a2, voffA);
            PG8_BAR; PG8_WAIT_L(0); PG8_MMA(1, 0, At, B0); PG8_BAR; PG8_SCHED;
            PG8_STAGE(PG8_SB(0, 1), b2 + hstep, voffB);
            PG8_WAIT_V(6); PG8_BAR; PG8_MMA(1, 1, At, B1); PG8_BAR;
            PG8_LDB(B0, 1, 0); PG8_SCHED; PG8_LDA(At, 1, 0); PG8_STAGE(PG8_SA(0, 1), a2 + hstep, voffA);
            PG8_WAIT_L(8); PG8_BAR; PG8_WAIT_L(0); PG8_MMA(0, 0, At, B0); PG8_BAR; PG8_SCHED;
            PG8_LDB(B1, 1, 1); PG8_STAGE(PG8_SB(1, 0), b3, voffB);
            PG8_BAR; PG8_WAIT_L(0); PG8_MMA(0, 1, At, B1); PG8_BAR;
            PG8_LDA(At, 1, 1); PG8_STAGE(PG8_SA(1, 0), a3, voffA);
            PG8_BAR; PG8_WAIT_L(0); PG8_MMA(1, 0, At, B0); PG8_BAR; PG8_SCHED;
            PG8_STAGE(PG8_SB(1, 1), b3 + hstep, voffB);
            PG8_WAIT_V(6); PG8_BAR; PG8_MMA(1, 1, At, B1); PG8_BAR;
            }
        }
        if constexpr (ALIGN_EPI) { if (wr == 0) PG8_BAR; }
        bool keep = false;
        if constexpr (Epi::PAIRED) keep = (cur.kind == 0);
        if constexpr (!Epi::AFTER_DRAIN) { if constexpr (Epi::PAIRED) { if (keep) E.mid(acc, cur, wr, wc, fr, fq); else E(acc, cur, wr, wc, fr, fq); } else E(acc, cur, wr, wc, fr, fq); S.done(cur); }
        if (!has_next) break;
        if (!keep) {
#pragma unroll
        for (int a = 0; a < 2; ++a)
#pragma unroll
            for (int b = 0; b < 2; ++b)
#pragma unroll
                for (int m = 0; m < 4; ++m)
#pragma unroll
                    for (int n = 0; n < 2; ++n) acc[a][b][m][n] = (f32x4){0.f, 0.f, 0.f, 0.f};
        }
        cur = nxt; cA = nA; cB = nB; ++ui;
        if constexpr (ALIGN_EPI) { if (wr == 1) PG8_BAR; }
    }
    PG8_WAIT_V(0);
    if constexpr (!ALIGN_EPI) { if (wr == 0) PG8_BAR; }
    PG8_BAR;
    if constexpr (Epi::AFTER_DRAIN) { E.fused(acc, cur, wr, wc, fr, fq, lds, wid, lane); S.done(cur); }
#undef PG8_SA
#undef PG8_SB
#undef PG8_STAGE
#undef PG8_LDA
#undef PG8_LDB
#undef PG8_MMA
#undef PG8_WAIT_V
#undef PG8_WAIT_L
#undef PG8_BAR
#undef PG8_SCHED
}
}
#define XB_TMO      128
#define XB_XCNT(j)  (256  + 64 * (j))
#define XB_XSUB(j)  (1280 + 64 * (j))
#define XB_XGEN(j)  (2304 + 64 * (j))
#define XB_TOP      3328
#define XB_TOPGEN   3392
#define XCD_BAR_WORDS 3456
#define XB_SPIN_CAP (1u << 18)

__device__ __forceinline__ unsigned xb_ld(unsigned* p)              { return __hip_atomic_load(p, __ATOMIC_RELAXED, __HIP_MEMORY_SCOPE_AGENT); }
__device__ __forceinline__ unsigned xb_add(unsigned* p, unsigned v) { return __hip_atomic_fetch_add(p, v, __ATOMIC_RELAXED, __HIP_MEMORY_SCOPE_AGENT); }
__device__ __forceinline__ unsigned xb_xcc_id() { return (unsigned)__builtin_amdgcn_s_getreg((3 << 11) | 20) & 0xFu; }
#define XB_SPIN(cond, bar) do { unsigned _sp = 0; while (cond) { __builtin_amdgcn_s_sleep(1); \
    if ((++_sp & 255u) == 0u) { if (xb_ld(&(bar)[XB_TMO])) break; if (_sp > XB_SPIN_CAP) { atomicAdd(&(bar)[XB_TMO], 1u); break; } } } } while (0)

struct XcdBarrier {
    unsigned* bar; unsigned x;
    volatile LAS unsigned* st;
};

__device__ __forceinline__ XcdBarrier xcd_barrier_post(unsigned* bar, volatile LAS unsigned* st) {
    XcdBarrier b; b.bar = bar; b.x = xb_xcc_id(); b.st = st;
    if (threadIdx.x == 0) (void)xb_add(&bar[XB_XCNT(b.x)], 1u);
    return b;
}
__device__ __forceinline__ void xcd_barrier_complete(unsigned* bar, unsigned x, unsigned& nloc, unsigned& nx) {
    const unsigned G = gridDim.x * gridDim.y * gridDim.z;
    unsigned sum, cnt, mine, sp = 0u;
    for (;;) {
        sum = 0u; cnt = 0u; mine = 0u;
#pragma unroll
        for (unsigned j = 0; j < 16; ++j) { const unsigned c = xb_ld(&bar[XB_XCNT(j)]); sum += c; cnt += (c > 0u) ? 1u : 0u; mine = (j == x) ? c : mine; }
        if (sum == G) break;
        __builtin_amdgcn_s_sleep(1);
        if ((++sp & 255u) == 0u) { if (xb_ld(&bar[XB_TMO])) break; if (sp > XB_SPIN_CAP) { atomicAdd(&bar[XB_TMO], 1u); break; } }
    }
    nloc = mine > 0u ? mine : 1u; nx = cnt > 0u ? cnt : 1u;
}

__device__ __forceinline__ void xcd_barrier(const XcdBarrier& b) {
    asm volatile("s_waitcnt vmcnt(0)" ::: "memory");
    __syncthreads();
    if (threadIdx.x == 0) {
        unsigned* bar = b.bar;
        __builtin_amdgcn_s_waitcnt(0);
        unsigned nloc = b.st[0], nx = b.st[1];
        if (nloc == 0u) { xcd_barrier_complete(bar, b.x, nloc, nx); b.st[0] = nloc; b.st[1] = nx; }
        const unsigned old = xb_add(&bar[XB_XSUB(b.x)], 1u);
        const unsigned gen = old / nloc;
        if (old + 1u == (gen + 1u) * nloc) {
            __builtin_amdgcn_fence(__ATOMIC_RELEASE, "agent");
            asm volatile("s_waitcnt vmcnt(0)" ::: "memory");
            const unsigned og = xb_add(&bar[XB_TOP], 1u);
            const unsigned tg = og / nx;
            if (og + 1u == (tg + 1u) * nx) xb_add(&bar[XB_TOPGEN], 1u);
            else XB_SPIN(xb_ld(&bar[XB_TOPGEN]) == tg, bar);
            __builtin_amdgcn_fence(__ATOMIC_ACQUIRE, "agent");
            xb_add(&bar[XB_XGEN(b.x)], 1u);
            asm volatile("s_waitcnt vmcnt(0)" ::: "memory");
        } else {
            XB_SPIN(xb_ld(&bar[XB_XGEN(b.x)]) == gen, bar);
            __builtin_amdgcn_fence(__ATOMIC_ACQUIRE, "agent");
            asm volatile("s_waitcnt vmcnt(0)" ::: "memory");
        }
    }
    __syncthreads();
}

typedef unsigned short bf16_t;
typedef short bf16x8 __attribute__((ext_vector_type(8)));
typedef short s16x4 __attribute__((ext_vector_type(4)));
typedef float f32x4 __attribute__((ext_vector_type(4)));
typedef unsigned u32x4 __attribute__((ext_vector_type(4)));
typedef unsigned u32x2 __attribute__((ext_vector_type(2)));
typedef float f32x2 __attribute__((ext_vector_type(2)));

constexpr int NB = 4, SEQ = 8192, DM = 1024, M = NB * SEQ, NIN = 10240, QP = 1536;
constexpr size_t MiB = 1u << 20;
constexpr size_t WS_BAR = 512 * 1024  , WS_MOD = 0, WS_CS = 1 * MiB, WS_SSQ = 3 * MiB, WS_LSE = 5 * MiB, WS_W1T = 8 * MiB, WS_WCO = 28 * MiB, WS_WAO = 30 * MiB, WS_WO = 32 * MiB,
                 WS_U = 36 * MiB, WS_ZC = 100 * MiB, WS_Q = 164 * MiB, WS_K = 260 * MiB, WS_V = 356 * MiB, WS_GA = 452 * MiB, WS_END = 484 * MiB;
constexpr size_t WS_MG = WS_U;
constexpr size_t DO_H = 0, DO_A2 = 0  , DO_ZA = 64 * MiB, DO_GC = 96 * MiB;
constexpr int LDS_BYTES = 147456;
constexpr int WGM_P1 = 4, WGM_P4 = 8, WGM_P5 = 8;
constexpr int PROBE_LO = -1, PROBE_HI = -1;
constexpr int REP_P0 = 1, REP_P1 = 1, REP_P3 = 1, REP_P4 = 1, REP_P5 = 1, REP_CONV = 1, REP_ATT = 1;
constexpr float QSCALE = 0.125f * 1.4426950408889634f;
constexpr float EPS = 1e-6f;

struct Params {
    const float *x, *c; const int* pos; const float *norm_g, *w_ada, *b_ada, *w_in, *conv_w, *conv_b, *ln_g, *ln_b, *w_co, *w_ao, *w_o, *final_g;
    float* out; unsigned char* ws;
    float f0, f1, f2, f3, f4, f5, f6, f7;
};

__device__ __forceinline__ unsigned pk2(float lo, float hi) { return pg8::cvt_pk_bf16(lo, hi); }
__device__ __forceinline__ float bflo(unsigned w) { return __uint_as_float(w << 16); }
__device__ __forceinline__ float bfhi(unsigned w) { return __uint_as_float(w & 0xffff0000u); }
__device__ __forceinline__ float sigm(float x) { return __builtin_amdgcn_rcpf(1.f + __expf(-x)); }
__device__ __forceinline__ float wave_sum(float v) {
#pragma unroll
    for (int o = 1; o < 64; o <<= 1) v += __shfl_xor(v, o);
    return v;
}
__device__ __forceinline__ u32x4 pack8(const f32x4 a, const f32x4 b) { u32x4 w; w.x = pk2(a[0], a[1]); w.y = pk2(a[2], a[3]); w.z = pk2(b[0], b[1]); w.w = pk2(b[2], b[3]); return w; }
__device__ __forceinline__ f32x4 sigm4(const f32x4 v) { return (f32x4){sigm(v[0]), sigm(v[1]), sigm(v[2]), sigm(v[3])}; }
__device__ __forceinline__ unsigned un8x4(const f32x4 s) {
    const unsigned a = (unsigned)(s[0] * 255.f + 0.5f), b = (unsigned)(s[1] * 255.f + 0.5f), c = (unsigned)(s[2] * 255.f + 0.5f), d = (unsigned)(s[3] * 255.f + 0.5f);
    return a | (b << 8) | (c << 16) | (d << 24);
}
__device__ __forceinline__ f32x4 deq8(unsigned w) { return (f32x4){(float)(w & 255u), (float)((w >> 8) & 255u), (float)((w >> 16) & 255u), (float)(w >> 24)} * (1.0f / 255.0f); }
__device__ __forceinline__ f32x4 byte4(unsigned w) { return (f32x4){(float)(w & 255u), (float)((w >> 8) & 255u), (float)((w >> 16) & 255u), (float)(w >> 24)}; }
__device__ __forceinline__ f32x4 clamp1(const f32x4 v) { return (f32x4){fmaxf(v[0], 1.f), fmaxf(v[1], 1.f), fmaxf(v[2], 1.f), fmaxf(v[3], 1.f)}; }
__device__ __forceinline__ f32x4 deq8c(unsigned w) { return clamp1(byte4(w)) * (1.0f / 255.0f); }
__device__ __forceinline__ f32x4 ratio8(unsigned num, unsigned den) { const f32x4 d = clamp1(byte4(den)); return byte4(num) * (f32x4){__builtin_amdgcn_rcpf(d[0]), __builtin_amdgcn_rcpf(d[1]), __builtin_amdgcn_rcpf(d[2]), __builtin_amdgcn_rcpf(d[3])}; }
__device__ __forceinline__ f32x4 bf4lo(unsigned w0, unsigned w1) { return (f32x4){bflo(w0), bfhi(w0), bflo(w1), bfhi(w1)}; }

__device__ __forceinline__ size_t qkv_off(int b, int g, int j, int t) { const int sh = 2 * g; return ((size_t)(((b * 3 + g) * 8 + j) * SEQ + ((t & ((1 << sh) - 1)) << (13 - sh)) + (t >> sh))) * 64; }

struct Epi1 {
    static constexpr bool PERM = true, AFTER_DRAIN = false, PAIRED = false;
    unsigned char *ws, *dout;
    __device__ __forceinline__ void operator()(const f32x4 (&acc)[2][2][4][2], const pg8::Unit& u, int wr, int wc, int fr, int fq) const {
        const int pn = u.pn, row0 = u.pm * 256 + wr * 64 + fr, cl = wc * 32 + 8 * fq;
        bf16_t* const U = (bf16_t*)(ws + WS_U); bf16_t* const ZC = (bf16_t*)(ws + WS_ZC); bf16_t* const Q = (bf16_t*)(ws + WS_Q); bf16_t* const K = (bf16_t*)(ws + WS_K); bf16_t* const V = (bf16_t*)(ws + WS_V);
        bf16_t* const ZA = (bf16_t*)(dout + DO_ZA); unsigned char* const GC8 = dout + DO_GC; unsigned char* const GA8 = ws + WS_GA; const float* const CS = (const float*)(ws + WS_CS);
        if (pn < 8) {
#pragma unroll
            for (int ai = 0; ai < 2; ++ai)
#pragma unroll
                for (int m = 0; m < 4; ++m) {
                    const size_t row = (size_t)(row0 + ai * 128 + m * 16);
                    const f32x4 a0 = acc[ai][0][m][0] * sigm4(acc[ai][1][m][0]), a1 = acc[ai][0][m][1] * sigm4(acc[ai][1][m][1]);
                    __builtin_nontemporal_store(pack8(a0, a1), (u32x4*)(U + row * 1024 + pn * 128 + cl));
                }
        } else if (pn < 12 || pn == 30 || pn == 31) {
            bf16_t* base = pn < 12 ? ZC : ZA; const int pitch = pn < 12 ? 1024 : 512, col0 = (pn < 12 ? (pn - 8) : (pn - 30)) * 256 + cl;
#pragma unroll
            for (int ai = 0; ai < 2; ++ai)
#pragma unroll
                for (int m = 0; m < 4; ++m) {
                    const size_t row = (size_t)(row0 + ai * 128 + m * 16);
#pragma unroll
                    for (int bj = 0; bj < 2; ++bj) {
                        const f32x4 v0 = acc[ai][bj][m][0], v1 = acc[ai][bj][m][1];
                        __builtin_nontemporal_store(pack8(v0 * sigm4(v0), v1 * sigm4(v1)), (u32x4*)(base + row * pitch + col0 + bj * 128));
                    }
                }
        } else if (pn < 24) {
            const bool isq = pn < 18; bf16_t* base = isq ? Q : K; const int pl = pn - (isq ? 12 : 18), g = pl >> 1, dim0 = (wc & 1) * 32 + 8 * fq; const float sc = isq ? QSCALE : 1.0f;
            const bool rot = ((wc & 1) == 0) && (fq < 2);
#pragma unroll
            for (int ai = 0; ai < 2; ++ai)
#pragma unroll
                for (int m = 0; m < 4; ++m) {
                    const size_t row = (size_t)(row0 + ai * 128 + m * 16);
                    f32x4 cv = (f32x4){1.f, 1.f, 1.f, 1.f}, sv = (f32x4){0.f, 0.f, 0.f, 0.f};
                    if (rot) { cv = *(const f32x4*)(CS + row * 16 + 4 * fq); sv = *(const f32x4*)(CS + row * 16 + 8 + 4 * fq); }
#pragma unroll
                    for (int bj = 0; bj < 2; ++bj) {
                        const f32x4 v0 = acc[ai][bj][m][0], v1 = acc[ai][bj][m][1];
                        const f32x4 n0 = (v0 * cv - v1 * sv) * sc, n1 = (v1 * cv + v0 * sv) * sc;
                        __builtin_nontemporal_store(pack8(n0, n1), (u32x4*)(base + qkv_off((int)(row >> 13), g, (4 * pl + 2 * bj + (wc >> 1)) & 7, (int)(row & (SEQ - 1))) + dim0));
                    }
                }
        } else if (pn < 30) {
            const int pl = pn - 24, g = pl >> 1, dim0 = (wc & 1) * 32 + 8 * fq;
#pragma unroll
            for (int ai = 0; ai < 2; ++ai)
#pragma unroll
                for (int m = 0; m < 4; ++m) {
                    const size_t row = (size_t)(row0 + ai * 128 + m * 16);
#pragma unroll
                    for (int bj = 0; bj < 2; ++bj) __builtin_nontemporal_store(pack8(acc[ai][bj][m][0], acc[ai][bj][m][1]), (u32x4*)(V + qkv_off((int)(row >> 13), g, (4 * pl + 2 * bj + (wc >> 1)) & 7, (int)(row & (SEQ - 1))) + dim0));
                }
        } else {
            unsigned char* base = pn < 36 ? GC8 : GA8; const int col0 = (pn - (pn < 36 ? 32 : 36)) * 256 + wc * 64 + fq * 16;
#pragma unroll
            for (int ai = 0; ai < 2; ++ai)
#pragma unroll
                for (int m = 0; m < 4; ++m) {
                    const size_t row = (size_t)(row0 + ai * 128 + m * 16);
                    u32x4 o; o.x = un8x4(sigm4(acc[ai][0][m][0])); o.y = un8x4(sigm4(acc[ai][0][m][1])); o.z = un8x4(sigm4(acc[ai][1][m][0])); o.w = un8x4(sigm4(acc[ai][1][m][1]));
                    __builtin_nontemporal_store(o, (u32x4*)(base + row * 1024 + col0));
                }
        }
    }
};
struct Epi34 {
    static constexpr bool PERM = true, AFTER_DRAIN = false, PAIRED = true;
    const unsigned char* GC8; const unsigned char* GA8; bf16_t* MG;
    __device__ __forceinline__ void mid(f32x4 (&acc)[2][2][4][2], const pg8::Unit& u, int wr, int wc, int fr, int fq) const {
        const int row0 = u.pm * 256 + wr * 64 + fr, gcol = u.pn * 256 + wc * 64 + fq * 16;
#pragma unroll
        for (int ai = 0; ai < 2; ++ai)
#pragma unroll
            for (int m = 0; m < 4; ++m) {
                const size_t row = (size_t)(row0 + ai * 128 + m * 16);
                const u32x4 gc = *(const u32x4*)(GC8 + row * 1024 + gcol), ga = *(const u32x4*)(GA8 + row * 1024 + gcol);
                acc[ai][0][m][0] *= ratio8(gc.x, ga.x); acc[ai][0][m][1] *= ratio8(gc.y, ga.y);
                acc[ai][1][m][0] *= ratio8(gc.z, ga.z); acc[ai][1][m][1] *= ratio8(gc.w, ga.w);
            }
    }
    __device__ __forceinline__ void operator()(const f32x4 (&acc)[2][2][4][2], const pg8::Unit& u, int wr, int wc, int fr, int fq) const {
        const int row0 = u.pm * 256 + wr * 64 + fr, col0 = u.pn * 256 + wc * 32 + 8 * fq, gcol = u.pn * 256 + wc * 64 + fq * 16;
#pragma unroll
        for (int ai = 0; ai < 2; ++ai)
#pragma unroll
            for (int m = 0; m < 4; ++m) {
                const size_t row = (size_t)(row0 + ai * 128 + m * 16);
                const u32x4 ga = *(const u32x4*)(GA8 + row * 1024 + gcol);
                *(u32x4*)(MG + row * 1024 + col0) = pack8(acc[ai][0][m][0] * deq8c(ga.x), acc[ai][0][m][1] * deq8c(ga.y));
                *(u32x4*)(MG + row * 1024 + col0 + 128) = pack8(acc[ai][1][m][0] * deq8c(ga.z), acc[ai][1][m][1] * deq8c(ga.w));
            }
    }
};
struct Epi5 {
    static constexpr bool PERM = true, AFTER_DRAIN = false, PAIRED = false;
    const float* x; const float* MOD; float* out; const float* fg; float* xbuf; unsigned* cnt; LAS unsigned char* xl;
    __device__ __forceinline__ void operator()(const f32x4 (&acc_)[2][2][4][2], const pg8::Unit& u, int wr, int wc, int fr, int fq) const {
        f32x4 (&acc)[2][2][4][2] = const_cast<f32x4 (&)[2][2][4][2]>(acc_);
        const int row0 = u.pm * 256 + wr * 64 + fr, col0 = u.pn * 256 + wc * 32 + 8 * fq, b = u.pm >> 5, wid = wr * 4 + wc, tid = wid * 64 + fq * 16 + fr;
        LAS float* P = (LAS float*)xl; LAS float* S = (LAS float*)(xl + 4096);
        {
            f32x4 gt[2][2];
#pragma unroll
            for (int bj = 0; bj < 2; ++bj) { gt[bj][0] = *(const f32x4*)(MOD + b * 3072 + 2048 + col0 + bj * 128); gt[bj][1] = *(const f32x4*)(MOD + b * 3072 + 2048 + col0 + bj * 128 + 4); }
#pragma unroll
            for (int ai = 0; ai < 2; ++ai)
#pragma unroll
                for (int m = 0; m < 4; ++m) {
                    const size_t row = (size_t)(row0 + ai * 128 + m * 16);
                    float ss = 0.f;
#pragma unroll
                    for (int bj = 0; bj < 2; ++bj) {
                        const f32x4 xa = *(const f32x4*)(x + row * 1024 + col0 + bj * 128), xb = *(const f32x4*)(x + row * 1024 + col0 + bj * 128 + 4);
                        const f32x4 o0 = xa + gt[bj][0] * acc[ai][bj][m][0], o1 = xb + gt[bj][1] * acc[ai][bj][m][1];
                        acc[ai][bj][m][0] = o0; acc[ai][bj][m][1] = o1;
                        ss += (o0[0] * o0[0] + o0[1] * o0[1]) + (o0[2] * o0[2] + o0[3] * o0[3]) + (o1[0] * o1[0] + o1[1] * o1[1]) + (o1[2] * o1[2] + o1[3] * o1[3]);
                    }
                    ss += __shfl_xor(ss, 16); ss += __shfl_xor(ss, 32);
                    if (fq == 0) P[(ai * 128 + wr * 64 + m * 16 + fr) * 4 + wc] = ss;
                }
        }
        asm volatile("s_waitcnt lgkmcnt(0)" ::: "memory"); __builtin_amdgcn_s_barrier(); asm volatile("" ::: "memory");
        if (tid < 256) {
            const float t = (P[tid * 4 + 0] + P[tid * 4 + 1]) + (P[tid * 4 + 2] + P[tid * 4 + 3]);
            __hip_atomic_store(xbuf + ((size_t)(u.pm * 256 + tid) * 4 + u.pn), t, __ATOMIC_RELAXED, __HIP_MEMORY_SCOPE_AGENT);
        }
        asm volatile("s_waitcnt vmcnt(0)" ::: "memory");
        if (wid < 4 && fq == 0 && fr == 0) __hip_atomic_fetch_add(cnt + 64 * u.pm, 1u, __ATOMIC_RELAXED, __HIP_MEMORY_SCOPE_AGENT);
        if (wid == 0) {
            unsigned sp = 0;
            while ((unsigned)__builtin_amdgcn_readfirstlane(__hip_atomic_load(cnt + 64 * u.pm, __ATOMIC_RELAXED, __HIP_MEMORY_SCOPE_AGENT)) < 16u) { __builtin_amdgcn_s_sleep(2); if (++sp > (1u << 22)) break; }
            __builtin_amdgcn_fence(__ATOMIC_ACQUIRE, "agent");
        }
        asm volatile("s_waitcnt vmcnt(0) lgkmcnt(0)" ::: "memory"); __builtin_amdgcn_s_barrier(); asm volatile("" ::: "memory");
        if (tid < 256) {
            const float* sl = xbuf + (size_t)(u.pm * 256 + tid) * 4;
            const float t = (__hip_atomic_load(sl + 0, __ATOMIC_RELAXED, __HIP_MEMORY_SCOPE_AGENT) + __hip_atomic_load(sl + 1, __ATOMIC_RELAXED, __HIP_MEMORY_SCOPE_AGENT))
                          + (__hip_atomic_load(sl + 2, __ATOMIC_RELAXED, __HIP_MEMORY_SCOPE_AGENT) + __hip_atomic_load(sl + 3, __ATOMIC_RELAXED, __HIP_MEMORY_SCOPE_AGENT));
            S[tid] = 1.0f / sqrtf(t * (1.f / 1024.f) + EPS);
        }
        asm volatile("s_waitcnt vmcnt(0) lgkmcnt(0)" ::: "memory"); __builtin_amdgcn_s_barrier(); asm volatile("" ::: "memory");
        f32x4 fv[2][2];
#pragma unroll
        for (int bj = 0; bj < 2; ++bj) { fv[bj][0] = *(const f32x4*)(fg + col0 + bj * 128); fv[bj][1] = *(const f32x4*)(fg + col0 + bj * 128 + 4); }
#pragma unroll
        for (int ai = 0; ai < 2; ++ai)
#pragma unroll
            for (int m = 0; m < 4; ++m) {
                const int rl = ai * 128 + wr * 64 + m * 16 + fr; const float sr = S[rl]; const size_t row = (size_t)(u.pm * 256 + rl);
#pragma unroll
                for (int bj = 0; bj < 2; ++bj) {
                    *(f32x4*)(out + row * 1024 + col0 + bj * 128) = acc[ai][bj][m][0] * sr * fv[bj][0];
                    *(f32x4*)(out + row * 1024 + col0 + bj * 128 + 4) = acc[ai][bj][m][1] * sr * fv[bj][1];
                }
            }
    }
};

__device__ __forceinline__ int src_col(int n) {
    const int tile = n >> 8, loc = n & 255;
    if (tile < 8) return (loc < 128) ? tile * 128 + loc : 1024 + tile * 128 + (loc - 128);
    if (tile >= 12 && tile < 24) { const int p = loc & 63; if (p < 16) return (n & ~63) + (p & 3) + ((p >> 2) & 1) * 8 + ((p >> 3) & 1) * 4; }
    if (tile >= 24 && tile < 30) { const int p = loc & 63, dt = p >> 4; return (n & ~63) + 32 * (dt >> 1) + 8 * ((p >> 2) & 3) + 4 * (dt & 1) + (p & 3); }
    return n;
}
template <bool PERMUTE>
__device__ __forceinline__ void transpose_item(const float* W, int K, int N, bf16_t* WT, LAS float* scr, int item, int lane) {
    const int nblk = N / 32, kb = item / nblk, nb = item % nblk, k0 = 64 * kb, n0 = 32 * nb;
    const int q4 = 4 * (lane & 7), kr = lane >> 3;
    const int sn = PERMUTE ? src_col(n0 + q4) : n0 + q4;
    f32x4 tv[8];
#pragma unroll
    for (int i = 0; i < 8; ++i) tv[i] = *(const f32x4*)(W + (size_t)(k0 + 8 * i + kr) * N + sn);
#pragma unroll
    for (int i = 0; i < 8; ++i) { LAS float* d = scr + (8 * i + kr) * 33 + q4; d[0] = tv[i][0]; d[1] = tv[i][1]; d[2] = tv[i][2]; d[3] = tv[i][3]; }
    asm volatile("s_waitcnt lgkmcnt(0)" ::: "memory");
    const int c = lane & 7;
#pragma unroll
    for (int j = 0; j < 4; ++j) { const int n = (lane >> 3) + 8 * j; const LAS float* s = scr + (8 * c) * 33 + n;
        u32x4 o; o.x = pk2(s[0 * 33], s[1 * 33]); o.y = pk2(s[2 * 33], s[3 * 33]); o.z = pk2(s[4 * 33], s[5 * 33]); o.w = pk2(s[6 * 33], s[7 * 33]);
        *(u32x4*)(WT + (size_t)(n0 + n) * K + k0 + 8 * c) = o; }
    asm volatile("s_waitcnt lgkmcnt(0)" ::: "memory");
}

__device__ __forceinline__ void conv_oct(const f32x2 (&u)[38], const f32x2 (&w)[31], const f32x2 bias, LAS f32x2* acc) {
#pragma unroll
    for (int tt = 0; tt < 8; ++tt) {
        f32x2 a = bias;
#pragma unroll
        for (int k = 0; k < 31; ++k) a += w[k] * u[tt + k];
        acc[tt * 512] = a;
    }
}
__device__ __forceinline__ void conv_load8(unsigned (&nw)[8], const unsigned* up) {
#pragma unroll
    for (int i = 0; i < 8; ++i) nw[i] = up[(long)i * 512];
}
__device__ __forceinline__ void conv_slide(f32x2 (&u)[38], const unsigned (&nw)[8]) {
#pragma unroll
    for (int i = 0; i < 30; ++i) u[i] = u[i + 8];
#pragma unroll
    for (int i = 0; i < 8; ++i) u[30 + i] = (f32x2){bflo(nw[i]), bfhi(nw[i])};
}
__device__ __forceinline__ void conv_items(const Params& p, LAS unsigned char* lds, int bid, int G, int tid) {
    const bf16_t* U = (const bf16_t*)(p.ws + WS_U); bf16_t* ZC = (bf16_t*)(p.ws + WS_ZC);
    const int c = 2 * tid;
    f32x2 w[31];
#pragma unroll
    for (int k = 0; k < 31; ++k) w[k] = *(const f32x2*)(p.conv_w + k * 1024 + c);
    const f32x2 bias = *(const f32x2*)(p.conv_b + c);
    const f32x2 g2 = *(const f32x2*)(p.ln_g + c), b2 = *(const f32x2*)(p.ln_b + c);
    LAS f32x2* red = (LAS f32x2*)lds;
    LAS f32x2* stats = (LAS f32x2*)(lds + 131072);
    for (int it = bid; it < 1024; it += G) {
        const int row0 = it * 32, s0 = row0 & (SEQ - 1);
        const unsigned* up = (const unsigned*)(U + ((long)row0 - 30) * 1024 + c);
        f32x2 u[38]; unsigned nw[8];
        {
            unsigned raw[38];
#pragma unroll
            for (int s = 0; s < 30; ++s) raw[s] = 0u;
            if (s0 > 0) {
#pragma unroll
                for (int s = 0; s < 30; ++s) raw[s] = up[(long)s * 512];
            }
#pragma unroll
            for (int s = 30; s < 38; ++s) raw[s] = up[(long)s * 512];
            conv_load8(nw, up + 38L * 512);
#pragma unroll
            for (int s = 0; s < 38; ++s) u[s] = (f32x2){bflo(raw[s]), bfhi(raw[s])};
        }
        conv_oct(u, w, bias, red + tid);
        conv_slide(u, nw); conv_load8(nw, up + 46L * 512); conv_oct(u, w, bias, red + 8 * 512 + tid);
        conv_slide(u, nw); conv_load8(nw, up + 54L * 512); conv_oct(u, w, bias, red + 16 * 512 + tid);
        conv_slide(u, nw); conv_oct(u, w, bias, red + 24 * 512 + tid);
        unsigned* zp = (unsigned*)(ZC + (size_t)row0 * 1024 + c);
        unsigned zz[32];
#pragma unroll
        for (int t = 0; t < 32; ++t) zz[t] = zp[(size_t)t * 512];
        __syncthreads();
        {
            const int t = tid >> 4, part = tid & 15; float s1 = 0.f, s2 = 0.f;
#pragma unroll 8
            for (int i = 0; i < 32; ++i) { const f32x2 v = red[t * 512 + part + 16 * i]; s1 += v.x + v.y; s2 += v.x * v.x + v.y * v.y; }
#pragma unroll
            for (int o = 1; o < 16; o <<= 1) { s1 += __shfl_xor(s1, o); s2 += __shfl_xor(s2, o); }
            if (part == 0) { const float mean = s1 * (1.f / 1024.f); const float var = fmaxf(s2 * (1.f / 1024.f) - mean * mean, 0.f); stats[t] = (f32x2){mean, 1.0f / sqrtf(var + EPS)}; }
        }
        __syncthreads();
#pragma unroll
        for (int t = 0; t < 32; ++t) {
            const f32x2 st = stats[t], av = red[t * 512 + tid];
            float y0 = (av.x - st.x) * st.y * g2.x + b2.x, y1 = (av.y - st.x) * st.y * g2.y + b2.y;
            y0 *= sigm(y0); y1 *= sigm(y1);
            zp[(size_t)t * 512] = pk2(y0 * bflo(zz[t]), y1 * bfhi(zz[t]));
        }
        __syncthreads();
    }
}

typedef short v4i16_t __attribute__((ext_vector_type(4)));
__device__ __forceinline__ float max3f(float a, float b, float c) { float r; asm("v_max3_f32 %0, %1, %2, %3" : "=v"(r) : "v"(a), "v"(b), "v"(c)); return r; }
__device__ __forceinline__ s16x4 vtr(const LAS unsigned char* p) { return __builtin_bit_cast(s16x4, __builtin_amdgcn_ds_read_tr16_b64_v4i16((LAS v4i16_t*)p)); }
constexpr int KV_ROWB = 160, LDS_VOFF = 256 * KV_ROWB;
struct AttnPre { u32x4 kv[8]; bf16x8 q0, q1; };
template <bool MERGE>
__device__ __forceinline__ void attn_decode(int idx, int& b, int& g, int& j, int& r, int& n, int& sh, size_t& sub) {
    const int q64 = idx & 63; int rest = idx >> 6; j = rest & 7; rest >>= 3;
    if (MERGE) { g = 0; b = rest; } else { g = 1 + (rest & 1); b = rest >> 1; }
    sh = 2 * g; r = q64 >> (6 - sh); n = q64 & ((64 >> sh) - 1);
    sub = ((size_t)(((b * 3 + g) * 8 + j) * SEQ) + ((size_t)r << (13 - sh))) * 64;
}
template <bool MERGE>
__device__ __forceinline__ void attn_prefetch(const Params& p, int idx, bool first, int tid, int lane, int w, AttnPre& R) {
    const bf16_t* Q = (const bf16_t*)(p.ws + WS_Q); const bf16_t* K = (const bf16_t*)(p.ws + WS_K); const bf16_t* V = (const bf16_t*)(p.ws + WS_V);
    int b, g, j, r, n, sh; size_t sub; attn_decode<MERGE>(idx, b, g, j, r, n, sh, sub);
    const size_t rc = sub + (size_t)n * 8192 + tid * 8;
    R.kv[2] = *(const u32x4*)(K + rc); R.kv[3] = *(const u32x4*)(K + rc + 4096); R.kv[6] = *(const u32x4*)(V + rc); R.kv[7] = *(const u32x4*)(V + rc + 4096);
    if (first) {
        const size_t rp = sub + (size_t)(n > 0 ? n - 1 : n) * 8192 + tid * 8;
        R.kv[0] = *(const u32x4*)(K + rp); R.kv[1] = *(const u32x4*)(K + rp + 4096); R.kv[4] = *(const u32x4*)(V + rp); R.kv[5] = *(const u32x4*)(V + rp + 4096);
    }
    const bf16_t* qptr = Q + sub + (size_t)(n * 128 + 16 * w + (lane & 15)) * 64 + 8 * (lane >> 4);
    R.q0 = *(const bf16x8*)(qptr); R.q1 = *(const bf16x8*)(qptr + 32);
}
__device__ __forceinline__ void attn_stage(LAS unsigned char* lds, int tid, const AttnPre& R, bool first, int cs) {
    LAS unsigned char* dc = lds + (cs * 128 + (tid >> 3)) * KV_ROWB + (tid & 7) * 16; LAS unsigned char* dp = lds + ((cs ^ 1) * 128 + (tid >> 3)) * KV_ROWB + (tid & 7) * 16;
    *(LAS u32x4*)(dc) = R.kv[2]; *(LAS u32x4*)(dc + 64 * KV_ROWB) = R.kv[3]; *(LAS u32x4*)(dc + LDS_VOFF) = R.kv[6]; *(LAS u32x4*)(dc + LDS_VOFF + 64 * KV_ROWB) = R.kv[7];
    if (first) { *(LAS u32x4*)(dp) = R.kv[0]; *(LAS u32x4*)(dp + 64 * KV_ROWB) = R.kv[1]; *(LAS u32x4*)(dp + LDS_VOFF) = R.kv[4]; *(LAS u32x4*)(dp + LDS_VOFF + 64 * KV_ROWB) = R.kv[5]; }
}
template <bool MERGE>
__device__ __forceinline__ void attn_compute(const Params& p, LAS unsigned char* lds, int idx, int cs, int lane, int w, const bf16x8 qf0, const bf16x8 qf1) {
    bf16_t* Q = (bf16_t*)(p.ws + WS_Q); float* LSE = (float*)(p.ws + WS_LSE);
    int b, g, j, r, n, sh; size_t sub; attn_decode<MERGE>(idx, b, g, j, r, n, sh, sub);
    const int d = 1 << sh;
    const int fr = lane & 15, fq = lane >> 4;
    const size_t qrow = (size_t)b * SEQ + (size_t)(n * 128 + 16 * w + fr) * d + r;
    bf16_t* qptr = Q + sub + (size_t)(n * 128 + 16 * w + fr) * 64;
    u32x2 o1[4], o2[4], zz[4]; float l1 = 0.f, l2 = 0.f;
    if (MERGE) {
        const int t = n * 128 + 16 * w + fr;
        const bf16_t* p1 = Q + qkv_off(b, 1, j, t) + 8 * fq; const bf16_t* p2 = Q + qkv_off(b, 2, j, t) + 8 * fq;
        const bf16_t* pz = (const bf16_t*)((const unsigned char*)p.out + DO_ZA) + qrow * 512 + j * 64 + 8 * fq;
#pragma unroll
        for (int k = 0; k < 2; ++k) { const u32x4 vz = *(const u32x4*)(pz + 32 * k); zz[2 * k] = (u32x2){vz.x, vz.y}; zz[2 * k + 1] = (u32x2){vz.z, vz.w}; }
#pragma unroll
        for (int k = 0; k < 2; ++k) {
            const u32x4 v1 = *(const u32x4*)(p1 + 32 * k), v2 = *(const u32x4*)(p2 + 32 * k);
            o1[2 * k] = (u32x2){v1.x, v1.y}; o1[2 * k + 1] = (u32x2){v1.z, v1.w}; o2[2 * k] = (u32x2){v2.x, v2.y}; o2[2 * k + 1] = (u32x2){v2.z, v2.w};
        }
        l1 = LSE[((size_t)M + qrow) * 8 + j]; l2 = LSE[((size_t)2 * M + qrow) * 8 + j];
    }
    f32x4 s[9];
#pragma unroll
    for (int tp = 0; tp < 9; ++tp) {
        const int tau = w + tp;
        const LAS unsigned char* kb = lds + (((tau < 8 ? (cs ^ 1) : cs) * 128 + 16 * (tau & 7)) + fr) * KV_ROWB + fq * 16;
        const bf16x8 ka = *(const LAS bf16x8*)kb, kc = *(const LAS bf16x8*)(kb + 64);
        f32x4 z = (f32x4){0.f, 0.f, 0.f, 0.f};
        z = __builtin_amdgcn_mfma_f32_16x16x32_bf16(ka, qf0, z, 0, 0, 0);
        s[tp] = __builtin_amdgcn_mfma_f32_16x16x32_bf16(kc, qf1, z, 0, 0, 0);
    }
    const float NEG = -1e30f;
#pragma unroll
    for (int jj = 0; jj < 4; ++jj) { const int key = 4 * fq + jj; if (key < fr) s[0][jj] = NEG; if (key > fr) s[8][jj] = NEG; }
    if (n == 0) {
#pragma unroll
        for (int tp = 0; tp < 8; ++tp) if (w + tp < 8) s[tp] = (f32x4){NEG, NEG, NEG, NEG};
    }
    float mx = NEG;
#pragma unroll
    for (int tp = 0; tp < 9; ++tp) mx = fmaxf(fmaxf(mx, fmaxf(s[tp][0], s[tp][1])), fmaxf(s[tp][2], s[tp][3]));
    mx = fmaxf(mx, __shfl_xor(mx, 16)); mx = fmaxf(mx, __shfl_xor(mx, 32));
    float l = 0.f;
#pragma unroll
    for (int tp = 0; tp < 9; ++tp)
#pragma unroll
        for (int jj = 0; jj < 4; ++jj) { const float e = __builtin_amdgcn_exp2f(s[tp][jj] - mx); s[tp][jj] = e; l += e; }
    u32x4 pw[5];
#pragma unroll
    for (int kp = 0; kp < 4; ++kp) pw[kp] = pack8(s[2 * kp], s[2 * kp + 1]);
    pw[4] = pack8(s[8], (f32x4){0.f, 0.f, 0.f, 0.f});
    f32x4 ot[4];
#pragma unroll
    for (int dt = 0; dt < 4; ++dt) ot[dt] = (f32x4){0.f, 0.f, 0.f, 0.f};
    const LAS unsigned char* vlane = lds + LDS_VOFF + (4 * fq + (fr >> 2)) * KV_ROWB + (fr & 3) * 8;
#pragma unroll
    for (int kp = 0; kp < 5; ++kp)
#pragma unroll
        for (int dt = 0; dt < 4; ++dt) {
            const int ta = w + 2 * kp, tb = ta + 1;
            const s16x4 lo = vtr(vlane + ((ta < 8 ? (cs ^ 1) : cs) * 128 + 16 * (ta & 7)) * KV_ROWB + dt * 32);
            s16x4 hi = (s16x4){0, 0, 0, 0};
            if (kp < 4) hi = vtr(vlane + ((tb < 8 ? (cs ^ 1) : cs) * 128 + 16 * (tb & 7)) * KV_ROWB + dt * 32);
            const bf16x8 a = (bf16x8){lo[0], lo[1], lo[2], lo[3], hi[0], hi[1], hi[2], hi[3]};
            ot[dt] = __builtin_amdgcn_mfma_f32_16x16x32_bf16(a, __builtin_bit_cast(bf16x8, pw[kp]), ot[dt], 0, 0, 0);
        }
    l += __shfl_xor(l, 16); l += __shfl_xor(l, 32);
    const float inv = 1.0f / l;
    if (MERGE) {
        const float l0 = mx + __log2f(l), mxl = fmaxf(l0, fmaxf(l1, l2));
        float w0 = __builtin_amdgcn_exp2f(l0 - mxl), w1 = __builtin_amdgcn_exp2f(l1 - mxl), w2 = __builtin_amdgcn_exp2f(l2 - mxl);
        const float wi = 1.0f / (w0 + w1 + w2); w0 *= wi * inv; w1 *= wi; w2 *= wi;
        bf16_t* a2 = (bf16_t*)((unsigned char*)p.out + DO_A2) + qrow * 1024 + j * 64 + 8 * fq;
        unsigned pr[4][2];
#pragma unroll
        for (int dt = 0; dt < 4; ++dt) {
            const float r0 = (w0 * ot[dt][0] + w1 * bflo(o1[dt].x) + w2 * bflo(o2[dt].x)) * bflo(zz[dt].x), r1 = (w0 * ot[dt][1] + w1 * bfhi(o1[dt].x) + w2 * bfhi(o2[dt].x)) * bfhi(zz[dt].x);
            const float r2 = (w0 * ot[dt][2] + w1 * bflo(o1[dt].y) + w2 * bflo(o2[dt].y)) * bflo(zz[dt].y), r3 = (w0 * ot[dt][3] + w1 * bfhi(o1[dt].y) + w2 * bfhi(o2[dt].y)) * bfhi(zz[dt].y);
            pr[dt][0] = pk2(r0, r1); pr[dt][1] = pk2(r2, r3);
        }
#pragma unroll
        for (int k = 0; k < 2; ++k) *(u32x4*)(a2 + 32 * k) = (u32x4){pr[2 * k][0], pr[2 * k][1], pr[2 * k + 1][0], pr[2 * k + 1][1]};
    } else {
#pragma unroll
        for (int k = 0; k < 2; ++k) {
            u32x4 o; o.x = pk2(ot[2 * k][0] * inv, ot[2 * k][1] * inv); o.y = pk2(ot[2 * k][2] * inv, ot[2 * k][3] * inv); o.z = pk2(ot[2 * k + 1][0] * inv, ot[2 * k + 1][1] * inv); o.w = pk2(ot[2 * k + 1][2] * inv, ot[2 * k + 1][3] * inv);
            *(u32x4*)(qptr + 32 * k + 8 * fq) = o;
        }
        if (fq == 0) LSE[((size_t)g * M + qrow) * 8 + j] = mx + __log2f(l);
    }
}
template <bool MERGE, int CH>
__device__ __forceinline__ void attn_phase(const Params& p, LAS unsigned char* lds, int bid, int G, int nitems, int tid, int lane, int wave) {
    const int nchains = nitems / CH;
    for (int chain = bid; chain < nchains; chain += G) {
        const int idx0 = chain * CH;
        AttnPre R; attn_prefetch<MERGE>(p, idx0, true, tid, lane, wave, R);
        __syncthreads();
        attn_stage(lds, tid, R, true, 0);
        bf16x8 qf0 = R.q0, qf1 = R.q1;
        __syncthreads();
        int cs = 0;
        for (int k = 0; k + 1 < CH; ++k) {
            attn_prefetch<MERGE>(p, idx0 + k + 1, false, tid, lane, wave, R);
            attn_compute<MERGE>(p, lds, idx0 + k, cs, lane, wave, qf0, qf1);
            cs ^= 1;
            __syncthreads();
            attn_stage(lds, tid, R, false, cs); qf0 = R.q0; qf1 = R.q1;
            __syncthreads();
        }
        attn_compute<MERGE>(p, lds, idx0 + CH - 1, cs, lane, wave, qf0, qf1);
    }
}

__global__ void __launch_bounds__(512, 2) fwd_megakernel(Params p) {
    extern __shared__ __attribute__((aligned(16))) unsigned char lds_raw[];
    LAS unsigned char* lds = (LAS unsigned char*)lds_raw;
    cg::grid_group grid = cg::this_grid();
    int tid, lane, wave, gw;
#define RELANE() do { int t_ = threadIdx.x; asm volatile("" : "+v"(t_)); tid = t_; lane = tid & 63; wave = __builtin_amdgcn_readfirstlane(tid >> 6); gw = bid * 8 + wave; } while (0)
    const int G = gridDim.x, bid = blockIdx.x, NGW = G * 8;
    RELANE();
    unsigned char* ws = p.ws; unsigned char* dout = (unsigned char*)p.out;
    float* MOD = (float*)(ws + WS_MOD); float* CS = (float*)(ws + WS_CS); float* SSQ = (float*)(ws + WS_SSQ);
    bf16_t* W1T = (bf16_t*)(ws + WS_W1T); bf16_t* WCO = (bf16_t*)(ws + WS_WCO); bf16_t* WAO = (bf16_t*)(ws + WS_WAO); bf16_t* WO = (bf16_t*)(ws + WS_WO);
    bf16_t* H = (bf16_t*)(dout + DO_H); bf16_t* ZA = (bf16_t*)(dout + DO_ZA); unsigned char* GC8 = dout + DO_GC;
    unsigned* const barw = (unsigned*)(ws + WS_BAR);
    unsigned* const pcnt = (unsigned*)(ws + WS_BAR + 65536);
    volatile LAS unsigned* const misc = (volatile LAS unsigned*)(lds + 131072 + 1024);
    if (tid == 0) { misc[0] = 0u; misc[1] = 0u; }
    __syncthreads();
    XcdBarrier xbar = xcd_barrier_post(barw, misc);
    if (G == 0x7fffffff) grid.sync();
    unsigned long long* const tsb = (unsigned long long*)(ws + 700 * 1024); int nstamp = 0;
#define STAMP() do { if (PROBE_LO >= 0) { if (bid == 0 && tid == 0) tsb[nstamp] = __builtin_amdgcn_s_memrealtime(); ++nstamp; } } while (0)
#define GSYNC() do { xcd_barrier(xbar); RELANE(); STAMP(); } while (0)
    STAMP();

    for (int it = bid; it < 96 * 8; it += G) {
        const int cgp = it % 96, kc = it / 96, n0 = cgp * 32, col = tid & 31, ks = tid >> 5;
        float a0 = 0.f, a1 = 0.f, a2 = 0.f, a3 = 0.f;
        const int kb = kc * 128 + ks * 8;
        const float* wp = p.w_ada + (size_t)kb * 3072 + n0 + col; const float* cc = p.c + kb;
#pragma unroll
        for (int k = 0; k < 8; ++k) { const float wv = wp[(size_t)k * 3072]; a0 += cc[k] * wv; a1 += cc[1024 + k] * wv; a2 += cc[2048 + k] * wv; a3 += cc[3072 + k] * wv; }
        LAS float* red = (LAS float*)lds;
        red[(ks * 4 + 0) * 32 + col] = a0; red[(ks * 4 + 1) * 32 + col] = a1; red[(ks * 4 + 2) * 32 + col] = a2; red[(ks * 4 + 3) * 32 + col] = a3;
        __syncthreads();
        if (tid < 128) { const int bb = tid >> 5; float sum = kc == 0 ? p.b_ada[n0 + col] : 0.f;
#pragma unroll
            for (int k2 = 0; k2 < 16; ++k2) sum += red[(k2 * 4 + bb) * 32 + col];
            atomicAdd(MOD + bb * 3072 + n0 + col, sum); }
        __syncthreads();
    }
    GSYNC();

    for (int rep0 = 0; rep0 < REP_P0; ++rep0) {
    {
        LAS float* scr = (LAS float*)(lds + wave * 16384);
        constexpr int I1 = 16 * 320, I2 = 16 * 32, I3 = 8 * 32, I4 = 16 * 32;
        for (int it = gw; it < I1 + I2 + I3 + I4; it += NGW) {
            int r = it;
            if (r < I1) { transpose_item<true>(p.w_in, 1024, NIN, W1T, scr, r, lane); continue; } r -= I1;
            if (r < I2) { transpose_item<false>(p.w_co, 1024, 1024, WCO, scr, r, lane); continue; } r -= I2;
            if (r < I3) { transpose_item<false>(p.w_ao, 1024  , 1024, WAO, scr, r, lane); continue; } r -= I3;
            transpose_item<false>(p.w_o, 1024, 1024, WO, scr, r, lane);
        }
    }
    for (int e = bid * 512 + tid; e < M * 8; e += G * 512) {
        const int row = e >> 3, i = e & 7;
        const float fi = i == 0 ? p.f0 : i == 1 ? p.f1 : i == 2 ? p.f2 : i == 3 ? p.f3 : i == 4 ? p.f4 : i == 5 ? p.f5 : i == 6 ? p.f6 : p.f7;
        const float ang = (float)p.pos[row] * fi;
        const double rev = (double)ang * 0.15915494309189535; const float frac = (float)(rev - __builtin_rint(rev));
        CS[row * 16 + i] = __builtin_amdgcn_cosf(frac); CS[row * 16 + 8 + i] = __builtin_amdgcn_sinf(frac);
    }
    for (int row = gw; row < M; row += 2 * NGW) {
        const int rowb = row + NGW;
        const bool hasb = rowb < M;
        const f32x4* xa = (const f32x4*)(p.x + (size_t)row * 1024) + lane; const f32x4* xb = (const f32x4*)(p.x + (size_t)(hasb ? rowb : row) * 1024) + lane;
        f32x4 va[4], vb[4]; float sa = 0.f, sb = 0.f;
#pragma unroll
        for (int jx = 0; jx < 4; ++jx) { va[jx] = __builtin_nontemporal_load(xa + 64 * jx); vb[jx] = __builtin_nontemporal_load(xb + 64 * jx); }
#pragma unroll
        for (int jx = 0; jx < 4; ++jx) { sa += (va[jx][0] * va[jx][0] + va[jx][1] * va[jx][1]) + (va[jx][2] * va[jx][2] + va[jx][3] * va[jx][3]); sb += (vb[jx][0] * vb[jx][0] + vb[jx][1] * vb[jx][1]) + (vb[jx][2] * vb[jx][2] + vb[jx][3] * vb[jx][3]); }
#pragma unroll
        for (int o = 1; o < 64; o <<= 1) { sa += __shfl_xor(sa, o); sb += __shfl_xor(sb, o); }
        const float ra = 1.0f / sqrtf(sa * (1.f / 1024.f) + EPS), rb = 1.0f / sqrtf(sb * (1.f / 1024.f) + EPS);
        const float* ma = MOD + (row >> 13) * 3072; const float* mb = MOD + ((hasb ? rowb : row) >> 13) * 3072;
#pragma unroll
        for (int jx = 0; jx < 4; ++jx) { const int col = 4 * lane + 256 * jx;
            const f32x4 gg = *(const f32x4*)(p.norm_g + col);
            { const f32x4 scl = *(const f32x4*)(ma + 1024 + col), sft = *(const f32x4*)(ma + col); const f32x4 y = va[jx] * ra * gg * (scl + 1.0f) + sft;
              u32x2 o; o.x = pk2(y[0], y[1]); o.y = pk2(y[2], y[3]); *(u32x2*)(H + (size_t)row * 1024 + col) = o; }
            if (hasb) { const f32x4 scl = *(const f32x4*)(mb + 1024 + col), sft = *(const f32x4*)(mb + col); const f32x4 y = vb[jx] * rb * gg * (scl + 1.0f) + sft;
              u32x2 o; o.x = pk2(y[0], y[1]); o.y = pk2(y[2], y[3]); *(u32x2*)(H + (size_t)rowb * 1024 + col) = o; }
        }
    }
    }
    GSYNC();

    for (int rep = 0; rep < REP_P1; ++rep) {
        pg8::Gemm g{H, W1T, M, NIN, 1024, H, W1T, 16, 16}; pg8::StaticOrder S; S.init(M, NIN, G, bid, WGM_P1);
        Epi1 E{ws, dout};
        pg8::gemm_phase<Epi1, pg8::StaticOrder, true, true>(lds, g, S, E);
    }
    GSYNC();

    conv_items(p, lds, bid, G, tid);
    attn_phase<false, 16>(p, lds, bid, G, 4096, tid, lane, wave);
    GSYNC();

    attn_phase<true, 8>(p, lds, bid, G, 2048, tid, lane, wave);
    GSYNC();

    for (int rep = 0; rep < REP_P4; ++rep) {
        pg8::Gemm g{(const bf16_t*)(ws + WS_ZC), WCO, M, 1024, 1024, (const bf16_t*)(dout + DO_A2), WAO, 16, 8}; pg8::PairOrder S; S.init(M, 1024, G, bid, WGM_P4);
        Epi34 E{GC8, ws + WS_GA, (bf16_t*)(ws + WS_MG)};
        pg8::gemm_phase<Epi34, pg8::PairOrder, true, true>(lds, g, S, E);
    }
    GSYNC();

    for (int rep = 0; rep < REP_P5; ++rep) {
        pg8::Gemm g{(const bf16_t*)(ws + WS_MG), WO, M, 1024, 1024, (const bf16_t*)(ws + WS_MG), WO, 16, 16}; pg8::StaticOrder S; S.init(M, 1024, G, bid, WGM_P5);
        Epi5 E{p.x, MOD, p.out, p.final_g, SSQ, pcnt + rep * 128 * 64, lds + 131072 + 2048};
        pg8::gemm_phase<Epi5, pg8::StaticOrder, true, true>(lds, g, S, E);
    }
    STAMP();
    if (PROBE_LO >= 0 && bid == 0 && threadIdx.x == 0) {
        asm volatile("s_waitcnt vmcnt(0)" ::: "memory");
        const unsigned long long dt = tsb[PROBE_HI] - tsb[PROBE_LO], t0 = __builtin_amdgcn_s_memrealtime();
        while (__builtin_amdgcn_s_memrealtime() - t0 < dt) __builtin_amdgcn_s_sleep(8);
    }
}

extern "C" void kernel_launch(void* const* d_in, const int* in_sizes, int n_in, void* d_out, int out_size, void* d_ws, size_t ws_size, hipStream_t stream) {
    static int grid = 0;
    if (grid == 0) {
        if (n_in != 15 || out_size != M * DM || ws_size < WS_END) { fprintf(stderr, "kernel_launch: unexpected sizes (n_in %d, out %d, ws %zu)\n", n_in, out_size, ws_size); grid = -1; return; }
        int dev = 0, cus = 0, per_cu = 0;
        (void)hipGetDevice(&dev); (void)hipDeviceGetAttribute(&cus, hipDeviceAttributeMultiprocessorCount, dev);
        (void)hipFuncSetAttribute((const void*)fwd_megakernel, hipFuncAttributeMaxDynamicSharedMemorySize, LDS_BYTES);
        if (hipOccupancyMaxActiveBlocksPerMultiprocessor(&per_cu, (const void*)fwd_megakernel, 512, LDS_BYTES) != hipSuccess || per_cu < 1) per_cu = 1;
        (void)hipGetLastError();
        grid = cus * per_cu;
    }
    if (grid < 0) return;
    Params p{};
    p.x = (const float*)d_in[0]; p.c = (const float*)d_in[1]; p.pos = (const int*)d_in[2]; p.norm_g = (const float*)d_in[3]; p.w_ada = (const float*)d_in[4]; p.b_ada = (const float*)d_in[5];
    p.w_in = (const float*)d_in[6]; p.conv_w = (const float*)d_in[7]; p.conv_b = (const float*)d_in[8]; p.ln_g = (const float*)d_in[9]; p.ln_b = (const float*)d_in[10];
    p.w_co = (const float*)d_in[11]; p.w_ao = (const float*)d_in[12]; p.w_o = (const float*)d_in[13]; p.final_g = (const float*)d_in[14];
    p.out = (float*)d_out; p.ws = (unsigned char*)d_ws;
    p.f0 = 1.0f; p.f1 = 1.939227432e-01f; p.f2 = 3.760603070e-02f; p.f3 = 7.292664610e-03f; p.f4 = 1.414213562e-03f; p.f5 = 2.742481884e-04f; p.f6 = 5.318295734e-05f; p.f7 = 1.031338525e-05f;
    if (hipMemsetAsync(d_ws, 0, 1 * MiB, stream) != hipSuccess) { fprintf(stderr, "kernel_launch: memset of the control words failed\n"); return; }
    void* args[] = {&p};
    const hipError_t e = hipLaunchCooperativeKernel((const void*)fwd_megakernel, dim3(grid), dim3(512), args, LDS_BYTES, stream);
    if (e != hipSuccess) fprintf(stderr, "cooperative launch failed: %s (grid %d)\n", hipGetErrorString(e), grid);
}
```

```cpp
#include <hip/hip_runtime.h>
#include <hip/hip_cooperative_groups.h>
#include <cstdio>
#include <cstdint>
namespace cg = cooperative_groups;
#define LAS __attribute__((address_space(3)))
namespace pg8 {
#define PG8_LAS __attribute__((address_space(3)))
typedef unsigned short bf16_t;
typedef short bf16x8 __attribute__((ext_vector_type(8)));
typedef float f32x4 __attribute__((ext_vector_type(4)));
typedef unsigned u32x4 __attribute__((ext_vector_type(4)));
constexpr int BM = 256, BK = 64, HALF = 128, HTB = HALF * BK * 2  , STAGE_BYTES = 8 * HTB, NXCD = 8, WGM = 8;

__host__ __device__ __forceinline__ int lds_byte(int r, int c) { const int st = (r >> 4) * 2 + (c >> 5), rr = r & 15, cc = c & 31, ob = rr * 64 + cc * 2; return st * 1024 + (ob ^ (((ob >> 9) & 1) << 5)); }
__host__ __device__ __forceinline__ void stage_rc(int b, int& R, int& C) { const int st = b / 1024, sb = b % 1024, swz = sb ^ (((sb >> 9) & 1) << 5); R = (st >> 1) * 16 + swz / 64; C = (st & 1) * 32 + (swz % 64) / 2; }
__host__ __device__ __forceinline__ int perm32(int rho) { const int n = rho >> 4, i = rho & 15; return 8 * (i >> 2) + 4 * n + (i & 3); }

struct Unit { int pm, pn, kind; };
struct Gemm { const bf16_t* A; const bf16_t* Bt; int M, N, K; const bf16_t* A1; const bf16_t* Bt1; int nt0, nt1; };

struct StaticOrder {
    int nM, nN, nwg, G, c, wgm;
    __host__ __device__ void init(int M, int N, int G_, int c_, int wgm_ = WGM) { nM = M / BM; nN = N / BM; nwg = nM * nN; G = G_; c = c_; wgm = wgm_; }
    __host__ __device__ bool next(int i, Unit& u) const {
        const long L = (long)i * G + c; if (L >= nwg) return false;
        int wgid = (int)L; { const int q = nwg / NXCD, r = nwg % NXCD, xcd = wgid % NXCD, off = wgid / NXCD; wgid = (xcd < r ? xcd * (q + 1) : r * (q + 1) + (xcd - r) * q) + off; }
        const int nig = wgm * nN, gid = wgid / nig, fm = gid * wgm, gsz = (nM - fm) < wgm ? (nM - fm) : wgm;
        u.pm = fm + ((wgid % nig) % gsz); u.pn = (wgid % nig) / gsz; u.kind = 0; return true;
    }
    __device__ __forceinline__ void a_ready(const Unit&) const {}
    __device__ __forceinline__ void done(const Unit&) const {}
};

__device__ __forceinline__ unsigned cvt_pk_bf16(float lo, float hi) { unsigned r; asm volatile("v_cvt_pk_bf16_f32 %0, %1, %2" : "=v"(r) : "v"(lo), "v"(hi)); return r; }
typedef float f32x2 __attribute__((ext_vector_type(2)));
struct XcdColOrder {
    StaticOrder base; int nM, nNx, lb, xcd, lc; bool ok;
    __host__ __device__ void init(int M, int N, int G_, int c_, int wgm_ = WGM) { base.init(M, N, G_, c_, wgm_); nM = M / BM; const int nN = N / BM; ok = (G_ % NXCD == 0) && (nN % NXCD == 0); nNx = nN / NXCD; lb = G_ / NXCD; xcd = c_ % NXCD; lc = c_ / NXCD; }
    __host__ __device__ bool next(int i, Unit& u) const {
        if (!ok) return base.next(i, u);
        const int t = i * lb + lc; if (t >= nM * nNx) return false;
        u.pm = t / nNx; u.pn = xcd + NXCD * (t % nNx); u.kind = 0; return true;
    }
    __device__ __forceinline__ void a_ready(const Unit&) const {}
    __device__ __forceinline__ void done(const Unit&) const {}
};
struct PairOrder {
    StaticOrder base;
    __host__ __device__ void init(int M, int N, int G_, int c_, int wgm_ = WGM) { base.init(M, N, G_, c_, wgm_); }
    __host__ __device__ bool next(int i, Unit& u) const { if (!base.next(i >> 1, u)) return false; u.kind = i & 1; return true; }
    __device__ __forceinline__ void a_ready(const Unit&) const {}
    __device__ __forceinline__ void done(const Unit&) const {}
};
template <class Epi, class Sched, bool ALIGN_EPI = false, bool SP2 = false>
__device__ __forceinline__ void gemm_phase(PG8_LAS unsigned char* lds, const Gemm g, const Sched& S, const Epi& E) {
    int tid_ = threadIdx.x; asm volatile("" : "+v"(tid_));
    const int tid = tid_, wid = __builtin_amdgcn_readfirstlane(tid >> 6), lane = tid & 63, wr = wid >> 2, wc = wid & 3, fr = lane & 15, fq = lane >> 4;
    const int K = g.K;
    unsigned voffA[2], voffB[2];
#pragma unroll
    for (int i = 0; i < 2; ++i) { int R, C; stage_rc(tid * 16 + i * 8192, R, C); const int Rb = Epi::PERM ? ((R & ~31) + perm32(R & 31)) : R;
        voffA[i] = (unsigned)(R * K + C) * 2u; voffB[i] = (unsigned)(Rb * K + C) * 2u; }
    const size_t kstep = (size_t)(BK * 2);
    const size_t hstep = (size_t)HALF * K * 2;
    const size_t tstep = 2 * hstep;
    const unsigned ldsw = (unsigned)wid * 1024u;
    const int aoff = lds_byte(wr * 64 + fr, fq * 8), boff = lds_byte(wc * 32 + fr, fq * 8);
#define PG8_SA(b, h) (((b) * 2 + (h)) * HTB)
#define PG8_SB(b, h) ((4 + (b) * 2 + (h)) * HTB)
#define PG8_STAGE(bufoff, gbase, voff) do { _Pragma("unroll") for (int _i = 0; _i < 2; ++_i) \
        __builtin_amdgcn_global_load_lds((const unsigned*)((const char*)(gbase) + (voff)[_i]), (PG8_LAS unsigned*)(lds + (bufoff) + ldsw + _i * 8192), 16, 0, 0); } while (0)
#define PG8_LDA(dst, b, h) do { _Pragma("unroll") for (int m = 0; m < 4; ++m) _Pragma("unroll") for (int k = 0; k < 2; ++k) dst[m][k] = *(const PG8_LAS bf16x8*)(lds + PG8_SA(b, h) + aoff + m * 2048 + k * 1024); } while (0)
#define PG8_LDB(dst, b, h) do { _Pragma("unroll") for (int n = 0; n < 2; ++n) _Pragma("unroll") for (int k = 0; k < 2; ++k) dst[n][k] = *(const PG8_LAS bf16x8*)(lds + PG8_SB(b, h) + boff + n * 2048 + k * 1024); } while (0)
#define PG8_MMA(ai, bj, At, Bt) do { __builtin_amdgcn_s_setprio(1); _Pragma("unroll") for (int m = 0; m < 4; ++m) _Pragma("unroll") for (int n = 0; n < 2; ++n) _Pragma("unroll") for (int k = 0; k < 2; ++k) \
        acc[ai][bj][m][n] = __builtin_amdgcn_mfma_f32_16x16x32_bf16(Bt[n][k], At[m][k], acc[ai][bj][m][n], 0, 0, 0); __builtin_amdgcn_s_setprio(0); } while (0)
#define PG8_WAIT_V(n) asm volatile("s_waitcnt vmcnt(" #n ")" ::: "memory")
#define PG8_WAIT_L(n) asm volatile("s_waitcnt lgkmcnt(" #n ")" ::: "memory")
#define PG8_BAR __builtin_amdgcn_s_barrier()
#define PG8_SCHED __builtin_amdgcn_sched_barrier(0)
    Unit cur, nxt; int ui = 0;
    if (!S.next(0, cur)) return;
    f32x4 acc[2][2][4][2];
#pragma unroll
    for (int a = 0; a < 2; ++a)
#pragma unroll
        for (int b = 0; b < 2; ++b)
#pragma unroll
            for (int m = 0; m < 4; ++m)
#pragma unroll
                for (int n = 0; n < 2; ++n) acc[a][b][m][n] = (f32x4){0.f, 0.f, 0.f, 0.f};
    bf16x8 At[4][2], B0[2][2], B1[2][2];
    const char* cA = (const char*)(cur.kind ? g.A1 : g.A) + (size_t)cur.pm * tstep; const char* cB = (const char*)(cur.kind ? g.Bt1 : g.Bt) + (size_t)cur.pn * tstep;
    S.a_ready(cur);
    if constexpr (SP2) {
        PG8_STAGE(PG8_SB(0, 0), cB, voffB); PG8_STAGE(PG8_SB(0, 1), cB + hstep, voffB); PG8_STAGE(PG8_SA(0, 0), cA, voffA); PG8_STAGE(PG8_SA(0, 1), cA + hstep, voffA);
        if (wr == 1) PG8_BAR;
        PG8_WAIT_V(2); PG8_BAR;
        PG8_STAGE(PG8_SB(1, 0), cB + kstep, voffB); PG8_STAGE(PG8_SA(1, 0), cA + kstep, voffA); PG8_STAGE(PG8_SB(1, 1), cB + hstep + kstep, voffB);
        PG8_WAIT_V(6); PG8_BAR;
    } else {
        PG8_STAGE(PG8_SB(0, 0), cB, voffB); PG8_STAGE(PG8_SA(0, 0), cA, voffA); PG8_STAGE(PG8_SB(0, 1), cB + hstep, voffB); PG8_STAGE(PG8_SA(0, 1), cA + hstep, voffA);
        if (wr == 1) PG8_BAR;
        PG8_WAIT_V(4); PG8_BAR;
        PG8_STAGE(PG8_SB(1, 0), cB + kstep, voffB); PG8_STAGE(PG8_SA(1, 0), cA + kstep, voffA); PG8_STAGE(PG8_SB(1, 1), cB + hstep + kstep, voffB);
        PG8_WAIT_V(6); PG8_BAR;
    }
    for (;;) {
        const bool has_next = S.next(ui + 1, nxt);
        const char* nA = has_next ? (const char*)(nxt.kind ? g.A1 : g.A) + (size_t)nxt.pm * tstep : cA; const char* nB = has_next ? (const char*)(nxt.kind ? g.Bt1 : g.Bt) + (size_t)nxt.pn * tstep : cB;
        const int nt = cur.kind ? g.nt1 : g.nt0;
        for (int t = 0; t < nt; t += 2) {
            const bool last = (t == nt - 2);
            const char* a1 = cA + (size_t)(t + 1) * kstep;
            const char* a2 = last ? nA : cA + (size_t)(t + 2) * kstep; const char* b2 = last ? nB : cB + (size_t)(t + 2) * kstep;
            const char* a3 = a2 + kstep; const char* b3 = b2 + kstep;
            if (last && has_next) S.a_ready(nxt);
            if constexpr (SP2) {
            PG8_LDB(B0, 0, 0); PG8_LDB(B1, 0, 1); PG8_SCHED; PG8_LDA(At, 0, 0); PG8_STAGE(PG8_SA(1, 1), a1 + hstep, voffA);
            PG8_WAIT_V(8); PG8_WAIT_L(0); PG8_BAR; PG8_MMA(0, 0, At, B0); PG8_MMA(0, 1, At, B1); PG8_BAR; PG8_SCHED;
            PG8_LDA(At, 0, 1); PG8_STAGE(PG8_SB(0, 0), b2, voffB); PG8_STAGE(PG8_SB(0, 1), b2 + hstep, voffB); PG8_STAGE(PG8_SA(0, 0), a2, voffA);
            PG8_WAIT_V(8); PG8_WAIT_L(0); PG8_BAR; PG8_MMA(1, 0, At, B0); PG8_MMA(1, 1, At, B1); PG8_BAR; PG8_SCHED;
            PG8_LDB(B0, 1, 0); PG8_LDB(B1, 1, 1); PG8_SCHED; PG8_LDA(At, 1, 0); PG8_STAGE(PG8_SA(0, 1), a2 + hstep, voffA);
            PG8_WAIT_V(8); PG8_WAIT_L(0); PG8_BAR; PG8_MMA(0, 0, At, B0); PG8_MMA(0, 1, At, B1); PG8_BAR; PG8_SCHED;
            PG8_LDA(At, 1, 1); PG8_STAGE(PG8_SB(1, 0), b3, voffB); PG8_STAGE(PG8_SB(1, 1), b3 + hstep, voffB); PG8_STAGE(PG8_SA(1, 0), a3, voffA);
            PG8_WAIT_V(8); PG8_WAIT_L(0); PG8_BAR; PG8_MMA(1, 0, At, B0); PG8_MMA(1, 1, At, B1); PG8_BAR; PG8_SCHED;
            } else {
            PG8_LDB(B0, 0, 0); PG8_SCHED; PG8_LDA(At, 0, 0); PG8_STAGE(PG8_SA(1, 1), a1 + hstep, voffA);
            PG8_WAIT_L(8); PG8_BAR; PG8_WAIT_L(0); PG8_MMA(0, 0, At, B0); PG8_BAR; PG8_SCHED;
            PG8_LDB(B1, 0, 1); PG8_STAGE(PG8_SB(0, 0), b2, voffB);
            PG8_BAR; PG8_WAIT_L(0); PG8_MMA(0, 1, At, B1); PG8_BAR;
            PG8_LDA(At, 0, 1); PG8_STAGE(PG8_SA(0, 0), a2, voffA);
            PG8_BAR; PG8_WAIT_L(0); PG8_MMA(1, 0, At, B0); PG8_BAR; PG8_SCHED;
            PG8_STAGE(PG8_SB(0, 1), b2 + hstep, voffB);
            PG8_WAIT_V(6); PG8_BAR; PG8_MMA(1, 1, At, B1); PG8_BAR;
            PG8_LDB(B0, 1, 0); PG8_SCHED; PG8_LDA(At, 1, 0); PG8_STAGE(PG8_SA(0, 1), a2 + hstep, voffA);
            PG8_WAIT_L(8); PG8_BAR; PG8_WAIT_L(0); PG8_MMA(0, 0, At, B0); PG8_BAR; PG8_SCHED;
            PG8_LDB(B1, 1, 1); PG8_STAGE(PG8_SB(1, 0), b3, voffB);
            PG8_BAR; PG8_WAIT_L(0); PG8_MMA(0, 1, At, B1); PG8_BAR;
            PG8_LDA(At, 1, 1); PG8_STAGE(PG8_SA(1, 0), a3, voffA);
            PG8_BAR; PG8_WAIT_L(0); PG8_MMA(1, 0, At, B0); PG8_BAR; PG8_SCHED;
            PG8_STAGE(PG8_SB(1, 1), b3 + hstep, voffB);
            PG8_WAIT_V(6); PG8_BAR; PG8_MMA(1, 1, At, B1); PG8_BAR;
            }
        }
        if constexpr (ALIGN_EPI) { if (wr == 0) PG8_BAR; }
        bool keep = false;
        if constexpr (Epi::PAIRED) keep = (cur.kind == 0);
        if constexpr (!Epi::AFTER_DRAIN) { if constexpr (Epi::PAIRED) { if (keep) E.mid(acc, cur, wr, wc, fr, fq); else E(acc, cur, wr, wc, fr, fq); } else E(acc, cur, wr, wc, fr, fq); S.done(cur); }
        if (!has_next) break;
        if (!keep) {
#pragma unroll
        for (int a = 0; a < 2; ++a)
#pragma unroll
            for (int b = 0; b < 2; ++b)
#pragma unroll
                for (int m = 0; m < 4; ++m)
#pragma unroll
                    for (int n = 0; n < 2; ++n) acc[a][b][m][n] = (f32x4){0.f, 0.f, 0.f, 0.f};
        }
        cur = nxt; cA = nA; cB = nB; ++ui;
        if constexpr (ALIGN_EPI) { if (wr == 1) PG8_BAR; }
    }
    PG8_WAIT_V(0);
    if constexpr (!ALIGN_EPI) { if (wr == 0) PG8_BAR; }
    PG8_BAR;
    if constexpr (Epi::AFTER_DRAIN) { E.fused(acc, cur, wr, wc, fr, fq, lds, wid, lane); S.done(cur); }
#undef PG8_SA
#undef PG8_SB
#undef PG8_STAGE
#undef PG8_LDA
#undef PG8_LDB
#undef PG8_MMA
#undef PG8_WAIT_V
#undef PG8_WAIT_L
#undef PG8_BAR
#undef PG8_SCHED
}
}
#define XB_TMO      128
#define XB_XCNT(j)  (256  + 64 * (j))
#define XB_XSUB(j)  (1280 + 64 * (j))
#define XB_XGEN(j)  (2304 + 64 * (j))
#define XB_TOP      3328
#define XB_TOPGEN   3392
#define XCD_BAR_WORDS 3456
#define XB_SPIN_CAP (1u << 18)

__device__ __forceinline__ unsigned xb_ld(unsigned* p)              { return __hip_atomic_load(p, __ATOMIC_RELAXED, __HIP_MEMORY_SCOPE_AGENT); }
__device__ __forceinline__ unsigned xb_add(unsigned* p, unsigned v) { return __hip_atomic_fetch_add(p, v, __ATOMIC_RELAXED, __HIP_MEMORY_SCOPE_AGENT); }
__device__ __forceinline__ unsigned xb_xcc_id() { return (unsigned)__builtin_amdgcn_s_getreg((3 << 11) | 20) & 0xFu; }
#define XB_SPIN(cond, bar) do { unsigned _sp = 0; while (cond) { __builtin_amdgcn_s_sleep(1); \
    if ((++_sp & 255u) == 0u) { if (xb_ld(&(bar)[XB_TMO])) break; if (_sp > XB_SPIN_CAP) { atomicAdd(&(bar)[XB_TMO], 1u); break; } } } } while (0)

struct XcdBarrier {
    unsigned* bar; unsigned x;
    volatile LAS unsigned* st;
};

__device__ __forceinline__ XcdBarrier xcd_barrier_post(unsigned* bar, volatile LAS unsigned* st) {
    XcdBarrier b; b.bar = bar; b.x = xb_xcc_id(); b.st = st;
    if (threadIdx.x == 0) (void)xb_add(&bar[XB_XCNT(b.x)], 1u);
    return b;
}
__device__ __forceinline__ void xcd_barrier_complete(unsigned* bar, unsigned x, unsigned& nloc, unsigned& nx) {
    const unsigned G = gridDim.x * gridDim.y * gridDim.z;
    unsigned sum, cnt, mine, sp = 0u;
    for (;;) {
        sum = 0u; cnt = 0u; mine = 0u;
#pragma unroll
        for (unsigned j = 0; j < 16; ++j) { const unsigned c = xb_ld(&bar[XB_XCNT(j)]); sum += c; cnt += (c > 0u) ? 1u : 0u; mine = (j == x) ? c : mine; }
        if (sum == G) break;
        __builtin_amdgcn_s_sleep(1);
        if ((++sp & 255u) == 0u) { if (xb_ld(&bar[XB_TMO])) break; if (sp > XB_SPIN_CAP) { atomicAdd(&bar[XB_TMO], 1u); break; } }
    }
    nloc = mine > 0u ? mine : 1u; nx = cnt > 0u ? cnt : 1u;
}

__device__ __forceinline__ void xcd_barrier(const XcdBarrier& b) {
    asm volatile("s_waitcnt vmcnt(0)" ::: "memory");
    __syncthreads();
    if (threadIdx.x == 0) {
        unsigned* bar = b.bar;
        __builtin_amdgcn_s_waitcnt(0);
        unsigned nloc = b.st[0], nx = b.st[1];
        if (nloc == 0u) { xcd_barrier_complete(bar, b.x, nloc, nx); b.st[0] = nloc; b.st[1] = nx; }
        const unsigned old = xb_add(&bar[XB_XSUB(b.x)], 1u);
        const unsigned gen = old / nloc;
        if (old + 1u == (gen + 1u) * nloc) {
            __builtin_amdgcn_fence(__ATOMIC_RELEASE, "agent");
            asm volatile("s_waitcnt vmcnt(0)" ::: "memory");
            const unsigned og = xb_add(&bar[XB_TOP], 1u);
            const unsigned tg = og / nx;
            if (og + 1u == (tg + 1u) * nx) xb_add(&bar[XB_TOPGEN], 1u);
            else XB_SPIN(xb_ld(&bar[XB_TOPGEN]) == tg, bar);
            __builtin_amdgcn_fence(__ATOMIC_ACQUIRE, "agent");
            xb_add(&bar[XB_XGEN(b.x)], 1u);
            asm volatile("s_waitcnt vmcnt(0)" ::: "memory");
        } else {
            XB_SPIN(xb_ld(&bar[XB_XGEN(b.x)]) == gen, bar);
            __builtin_amdgcn_fence(__ATOMIC_ACQUIRE, "agent");
            asm volatile("s_waitcnt vmcnt(0)" ::: "memory");
        }
    }
    __syncthreads();
}

typedef unsigned short bf16_t;
typedef short bf16x8 __attribute__((ext_vector_type(8)));
typedef short s16x4 __attribute__((ext_vector_type(4)));
typedef float f32x4 __attribute__((ext_vector_type(4)));
typedef unsigned u32x4 __attribute__((ext_vector_type(4)));
typedef unsigned u32x2 __attribute__((ext_vector_type(2)));
typedef float f32x2 __attribute__((ext_vector_type(2)));

constexpr int NB = 4, SEQ = 8192, DM = 1024, M = NB * SEQ, NIN = 10240, QP = 1536;
constexpr size_t MiB = 1u << 20;
constexpr size_t WS_BAR = 512 * 1024  , WS_MOD = 0, WS_CS = 1 * MiB, WS_SSQ = 3 * MiB, WS_LSE = 5 * MiB, WS_W1T = 8 * MiB, WS_WCO = 28 * MiB, WS_WAO = 30 * MiB, WS_WO = 32 * MiB,
                 WS_U = 36 * MiB, WS_ZC = 100 * MiB, WS_Q = 164 * MiB, WS_K = 260 * MiB, WS_V = 356 * MiB, WS_GA = 452 * MiB, WS_END = 484 * MiB;
constexpr size_t WS_MG = WS_U;
constexpr size_t DO_H = 0, DO_A2 = 0  , DO_ZA = 64 * MiB, DO_GC = 96 * MiB;
constexpr int LDS_BYTES = 147456;
constexpr int WGM_P1 = 4, WGM_P4 = 8, WGM_P5 = 8;
constexpr int PROBE_LO = -1, PROBE_HI = -1;
constexpr int REP_P0 = 1, REP_P1 = 1, REP_P3 = 1, REP_P4 = 1, REP_P5 = 1, REP_CONV = 1, REP_ATT = 1;
constexpr float QSCALE = 0.125f * 1.4426950408889634f;
constexpr float EPS = 1e-6f;

struct Params {
    const float *x, *c; const int* pos; const float *norm_g, *w_ada, *b_ada, *w_in, *conv_w, *conv_b, *ln_g, *ln_b, *w_co, *w_ao, *w_o, *final_g;
    float* out; unsigned char* ws;
    float f0, f1, f2, f3, f4, f5, f6, f7;
};

__device__ __forceinline__ unsigned pk2(float lo, float hi) { return pg8::cvt_pk_bf16(lo, hi); }
__device__ __forceinline__ float bflo(unsigned w) { return __uint_as_float(w << 16); }
__device__ __forceinline__ float bfhi(unsigned w) { return __uint_as_float(w & 0xffff0000u); }
__device__ __forceinline__ float sigm(float x) { return __builtin_amdgcn_rcpf(1.f + __expf(-x)); }
__device__ __forceinline__ float wave_sum(float v) {
#pragma unroll
    for (int o = 1; o < 64; o <<= 1) v += __shfl_xor(v, o);
    return v;
}
__device__ __forceinline__ u32x4 pack8(const f32x4 a, const f32x4 b) { u32x4 w; w.x = pk2(a[0], a[1]); w.y = pk2(a[2], a[3]); w.z = pk2(b[0], b[1]); w.w = pk2(b[2], b[3]); return w; }
__device__ __forceinline__ f32x4 sigm4(const f32x4 v) { return (f32x4){sigm(v[0]), sigm(v[1]), sigm(v[2]), sigm(v[3])}; }
__device__ __forceinline__ unsigned un8x4(const f32x4 s) {
    const unsigned a = (unsigned)(s[0] * 255.f + 0.5f), b = (unsigned)(s[1] * 255.f + 0.5f), c = (unsigned)(s[2] * 255.f + 0.5f), d = (unsigned)(s[3] * 255.f + 0.5f);
    return a | (b << 8) | (c << 16) | (d << 24);
}
__device__ __forceinline__ f32x4 deq8(unsigned w) { return (f32x4){(float)(w & 255u), (float)((w >> 8) & 255u), (float)((w >> 16) & 255u), (float)(w >> 24)} * (1.0f / 255.0f); }
__device__ __forceinline__ f32x4 byte4(unsigned w) { return (f32x4){(float)(w & 255u), (float)((w >> 8) & 255u), (float)((w >> 16) & 255u), (float)(w >> 24)}; }
__device__ __forceinline__ f32x4 clamp1(const f32x4 v) { return (f32x4){fmaxf(v[0], 1.f), fmaxf(v[1], 1.f), fmaxf(v[2], 1.f), fmaxf(v[3], 1.f)}; }
__device__ __forceinline__ f32x4 deq8c(unsigned w) { return clamp1(byte4(w)) * (1.0f / 255.0f); }
__device__ __forceinline__ f32x4 ratio8(unsigned num, unsigned den) { const f32x4 d = clamp1(byte4(den)); return byte4(num) * (f32x4){__builtin_amdgcn_rcpf(d[0]), __builtin_amdgcn_rcpf(d[1]), __builtin_amdgcn_rcpf(d[2]), __builtin_amdgcn_rcpf(d[3])}; }
__device__ __forceinline__ f32x4 bf4lo(unsigned w0, unsigned w1) { return (f32x4){bflo(w0), bfhi(w0), bflo(w1), bfhi(w1)}; }

__device__ __forceinline__ size_t qkv_off(int b, int g, int j, int t) { const int sh = 2 * g; return ((size_t)(((b * 3 + g) * 8 + j) * SEQ + ((t & ((1 << sh) - 1)) << (13 - sh)) + (t >> sh))) * 64; }

struct Epi1 {
    static constexpr bool PERM = true, AFTER_DRAIN = false, PAIRED = false;
    unsigned char *ws, *dout;
    __device__ __forceinline__ void operator()(const f32x4 (&acc)[2][2][4][2], const pg8::Unit& u, int wr, int wc, int fr, int fq) const {
        const int pn = u.pn, row0 = u.pm * 256 + wr * 64 + fr, cl = wc * 32 + 8 * fq;
        bf16_t* const U = (bf16_t*)(ws + WS_U); bf16_t* const ZC = (bf16_t*)(ws + WS_ZC); bf16_t* const Q = (bf16_t*)(ws + WS_Q); bf16_t* const K = (bf16_t*)(ws + WS_K); bf16_t* const V = (bf16_t*)(ws + WS_V);
        bf16_t* const ZA = (bf16_t*)(dout + DO_ZA); unsigned char* const GC8 = dout + DO_GC; unsigned char* const GA8 = ws + WS_GA; const float* const CS = (const float*)(ws + WS_CS);
        if (pn < 8) {
#pragma unroll
            for (int ai = 0; ai < 2; ++ai)
#pragma unroll
                for (int m = 0; m < 4; ++m) {
                    const size_t row = (size_t)(row0 + ai * 128 + m * 16);
                    const f32x4 a0 = acc[ai][0][m][0] * sigm4(acc[ai][1][m][0]), a1 = acc[ai][0][m][1] * sigm4(acc[ai][1][m][1]);
                    __builtin_nontemporal_store(pack8(a0, a1), (u32x4*)(U + row * 1024 + pn * 128 + cl));
                }
        } else if (pn < 12 || pn == 30 || pn == 31) {
            bf16_t* base = pn < 12 ? ZC : ZA; const int pitch = pn < 12 ? 1024 : 512, col0 = (pn < 12 ? (pn - 8) : (pn - 30)) * 256 + cl;
#pragma unroll
            for (int ai = 0; ai < 2; ++ai)
#pragma unroll
                for (int m = 0; m < 4; ++m) {
                    const size_t row = (size_t)(row0 + ai * 128 + m * 16);
#pragma unroll
                    for (int bj = 0; bj < 2; ++bj) {
                        const f32x4 v0 = acc[ai][bj][m][0], v1 = acc[ai][bj][m][1];
                        __builtin_nontemporal_store(pack8(v0 * sigm4(v0), v1 * sigm4(v1)), (u32x4*)(base + row * pitch + col0 + bj * 128));
                    }
                }
        } else if (pn < 24) {
            const bool isq = pn < 18; bf16_t* base = isq ? Q : K; const int pl = pn - (isq ? 12 : 18), g = pl >> 1, dim0 = (wc & 1) * 32 + 8 * fq; const float sc = isq ? QSCALE : 1.0f;
            const bool rot = ((wc & 1) == 0) && (fq < 2);
#pragma unroll
            for (int ai = 0; ai < 2; ++ai)
#pragma unroll
                for (int m = 0; m < 4; ++m) {
                    const size_t row = (size_t)(row0 + ai * 128 + m * 16);
                    f32x4 cv = (f32x4){1.f, 1.f, 1.f, 1.f}, sv = (f32x4){0.f, 0.f, 0.f, 0.f};
                    if (rot) { cv = *(const f32x4*)(CS + row * 16 + 8 * fq); sv = *(const f32x4*)(CS + row * 16 + 8 * fq + 4); }
#pragma unroll
                    for (int bj = 0; bj < 2; ++bj) {
                        const f32x4 v0 = acc[ai][bj][m][0], v1 = acc[ai][bj][m][1];
                        const f32x4 n0 = (v0 * cv - v1 * sv) * sc, n1 = (v1 * cv + v0 * sv) * sc;
                        __builtin_nontemporal_store(pack8(n0, n1), (u32x4*)(base + qkv_off((int)(row >> 13), g, (4 * pl + 2 * bj + (wc >> 1)) & 7, (int)(row & (SEQ - 1))) + dim0));
                    }
                }
        } else if (pn < 30) {
            const int pl = pn - 24, g = pl >> 1, dim0 = (wc & 1) * 32 + 8 * fq;
#pragma unroll
            for (int ai = 0; ai < 2; ++ai)
#pragma unroll
                for (int m = 0; m < 4; ++m) {
                    const size_t row = (size_t)(row0 + ai * 128 + m * 16);
#pragma unroll
                    for (int bj = 0; bj < 2; ++bj) __builtin_nontemporal_store(pack8(acc[ai][bj][m][0], acc[ai][bj][m][1]), (u32x4*)(V + qkv_off((int)(row >> 13), g, (4 * pl + 2 * bj + (wc >> 1)) & 7, (int)(row & (SEQ - 1))) + dim0));
                }
        } else {
            unsigned char* base = pn < 36 ? GC8 : GA8; const int col0 = (pn - (pn < 36 ? 32 : 36)) * 256 + wc * 64 + fq * 16;
#pragma unroll
            for (int ai = 0; ai < 2; ++ai)
#pragma unroll
                for (int m = 0; m < 4; ++m) {
                    const size_t row = (size_t)(row0 + ai * 128 + m * 16);
                    u32x4 o; o.x = un8x4(sigm4(acc[ai][0][m][0])); o.y = un8x4(sigm4(acc[ai][0][m][1])); o.z = un8x4(sigm4(acc[ai][1][m][0])); o.w = un8x4(sigm4(acc[ai][1][m][1]));
                    __builtin_nontemporal_store(o, (u32x4*)(base + row * 1024 + col0));
                }
        }
    }
};
struct Epi34 {
    static constexpr bool PERM = true, AFTER_DRAIN = false, PAIRED = true;
    const unsigned char* GC8; const unsigned char* GA8; bf16_t* MG;
    __device__ __forceinline__ void mid(f32x4 (&acc)[2][2][4][2], const pg8::Unit& u, int wr, int wc, int fr, int fq) const {
        const int row0 = u.pm * 256 + wr * 64 + fr, gcol = u.pn * 256 + wc * 64 + fq * 16;
#pragma unroll
        for (int ai = 0; ai < 2; ++ai)
#pragma unroll
            for (int m = 0; m < 4; ++m) {
                const size_t row = (size_t)(row0 + ai * 128 + m * 16);
                const u32x4 gc = *(const u32x4*)(GC8 + row * 1024 + gcol), ga = *(const u32x4*)(GA8 + row * 1024 + gcol);
                acc[ai][0][m][0] *= ratio8(gc.x, ga.x); acc[ai][0][m][1] *= ratio8(gc.y, ga.y);
                acc[ai][1][m][0] *= ratio8(gc.z, ga.z); acc[ai][1][m][1] *= ratio8(gc.w, ga.w);
            }
    }
    __device__ __forceinline__ void operator()(const f32x4 (&acc)[2][2][4][2], const pg8::Unit& u, int wr, int wc, int fr, int fq) const {
        const int row0 = u.pm * 256 + wr * 64 + fr, col0 = u.pn * 256 + wc * 32 + 8 * fq, gcol = u.pn * 256 + wc * 64 + fq * 16;
#pragma unroll
        for (int ai = 0; ai < 2; ++ai)
#pragma unroll
            for (int m = 0; m < 4; ++m) {
                const size_t row = (size_t)(row0 + ai * 128 + m * 16);
                const u32x4 ga = *(const u32x4*)(GA8 + row * 1024 + gcol);
                *(u32x4*)(MG + row * 1024 + col0) = pack8(acc[ai][0][m][0] * deq8c(ga.x), acc[ai][0][m][1] * deq8c(ga.y));
                *(u32x4*)(MG + row * 1024 + col0 + 128) = pack8(acc[ai][1][m][0] * deq8c(ga.z), acc[ai][1][m][1] * deq8c(ga.w));
            }
    }
};
struct Epi5 {
    static constexpr bool PERM = true, AFTER_DRAIN = false, PAIRED = false;
    const float* x; const float* MOD; float* out; const float* fg; float* xbuf; unsigned* cnt; LAS unsigned char* xl;
    __device__ __forceinline__ void operator()(const f32x4 (&acc_)[2][2][4][2], const pg8::Unit& u, int wr, int wc, int fr, int fq) const {
        f32x4 (&acc)[2][2][4][2] = const_cast<f32x4 (&)[2][2][4][2]>(acc_);
        const int row0 = u.pm * 256 + wr * 64 + fr, col0 = u.pn * 256 + wc * 32 + 8 * fq, b = u.pm >> 5, wid = wr * 4 + wc, tid = wid * 64 + fq * 16 + fr;
        LAS float* P = (LAS float*)xl; LAS float* S = (LAS float*)(xl + 4096);
        {
            f32x4 gt[2][2];
#pragma unroll
            for (int bj = 0; bj < 2; ++bj) { gt[bj][0] = *(const f32x4*)(MOD + b * 3072 + 2048 + col0 + bj * 128); gt[bj][1] = *(const f32x4*)(MOD + b * 3072 + 2048 + col0 + bj * 128 + 4); }
#pragma unroll
            for (int ai = 0; ai < 2; ++ai)
#pragma unroll
                for (int m = 0; m < 4; ++m) {
                    const size_t row = (size_t)(row0 + ai * 128 + m * 16);
                    float ss = 0.f;
#pragma unroll
                    for (int bj = 0; bj < 2; ++bj) {
                        const f32x4 xa = *(const f32x4*)(x + row * 1024 + col0 + bj * 128), xb = *(const f32x4*)(x + row * 1024 + col0 + bj * 128 + 4);
                        const f32x4 o0 = xa + gt[bj][0] * acc[ai][bj][m][0], o1 = xb + gt[bj][1] * acc[ai][bj][m][1];
                        acc[ai][bj][m][0] = o0; acc[ai][bj][m][1] = o1;
                        ss += (o0[0] * o0[0] + o0[1] * o0[1]) + (o0[2] * o0[2] + o0[3] * o0[3]) + (o1[0] * o1[0] + o1[1] * o1[1]) + (o1[2] * o1[2] + o1[3] * o1[3]);
                    }
                    ss += __shfl_xor(ss, 16); ss += __shfl_xor(ss, 32);
                    if (fq == 0) P[(ai * 128 + wr * 64 + m * 16 + fr) * 4 + wc] = ss;
                }
        }
        asm volatile("s_waitcnt lgkmcnt(0)" ::: "memory"); __builtin_amdgcn_s_barrier(); asm volatile("" ::: "memory");
        if (tid < 256) {
            const float t = (P[tid * 4 + 0] + P[tid * 4 + 1]) + (P[tid * 4 + 2] + P[tid * 4 + 3]);
            __hip_atomic_store(xbuf + ((size_t)(u.pm * 256 + tid) * 4 + u.pn), t, __ATOMIC_RELAXED, __HIP_MEMORY_SCOPE_AGENT);
        }
        asm volatile("s_waitcnt vmcnt(0)" ::: "memory");
        if (wid < 4 && fq == 0 && fr == 0) __hip_atomic_fetch_add(cnt + 64 * u.pm, 1u, __ATOMIC_RELAXED, __HIP_MEMORY_SCOPE_AGENT);
        if (wid == 0) {
            unsigned sp = 0;
            while ((unsigned)__builtin_amdgcn_readfirstlane(__hip_atomic_load(cnt + 64 * u.pm, __ATOMIC_RELAXED, __HIP_MEMORY_SCOPE_AGENT)) < 16u) { __builtin_amdgcn_s_sleep(2); if (++sp > (1u << 22)) break; }
            __builtin_amdgcn_fence(__ATOMIC_ACQUIRE, "agent");
        }
        asm volatile("s_waitcnt vmcnt(0) lgkmcnt(0)" ::: "memory"); __builtin_amdgcn_s_barrier(); asm volatile("" ::: "memory");
        if (tid < 256) {
            const float* sl = xbuf + (size_t)(u.pm * 256 + tid) * 4;
            const float t = (__hip_atomic_load(sl + 0, __ATOMIC_RELAXED, __HIP_MEMORY_SCOPE_AGENT) + __hip_atomic_load(sl + 1, __ATOMIC_RELAXED, __HIP_MEMORY_SCOPE_AGENT))
                          + (__hip_atomic_load(sl + 2, __ATOMIC_RELAXED, __HIP_MEMORY_SCOPE_AGENT) + __hip_atomic_load(sl + 3, __ATOMIC_RELAXED, __HIP_MEMORY_SCOPE_AGENT));
            S[tid] = 1.0f / sqrtf(t * (1.f / 1024.f) + EPS);
        }
        asm volatile("s_waitcnt vmcnt(0) lgkmcnt(0)" ::: "memory"); __builtin_amdgcn_s_barrier(); asm volatile("" ::: "memory");
        f32x4 fv[2][2];
#pragma unroll
        for (int bj = 0; bj < 2; ++bj) { fv[bj][0] = *(const f32x4*)(fg + col0 + bj * 128); fv[bj][1] = *(const f32x4*)(fg + col0 + bj * 128 + 4); }
#pragma unroll
        for (int ai = 0; ai < 2; ++ai)
#pragma unroll
            for (int m = 0; m < 4; ++m) {
                const int rl = ai * 128 + wr * 64 + m * 16 + fr; const float sr = S[rl]; const size_t row = (size_t)(u.pm * 256 + rl);
#pragma unroll
                for (int bj = 0; bj < 2; ++bj) {
                    *(f32x4*)(out + row * 1024 + col0 + bj * 128) = acc[ai][bj][m][0] * sr * fv[bj][0];
                    *(f32x4*)(out + row * 1024 + col0 + bj * 128 + 4) = acc[ai][bj][m][1] * sr * fv[bj][1];
                }
            }
    }
};

__device__ __forceinline__ int src_col(int n) {
    const int tile = n >> 8, loc = n & 255;
    if (tile < 8) return (loc < 128) ? tile * 128 + loc : 1024 + tile * 128 + (loc - 128);
    if (tile >= 12 && tile < 24) { const int p = loc & 63; if (p < 16) return (n & ~63) + (p & 3) + ((p >> 2) & 1) * 8 + ((p >> 3) & 1) * 4; }
    return n;
}
template <bool PERMUTE>
__device__ __forceinline__ void transpose_item(const float* W, int K, int N, bf16_t* WT, LAS float* scr, int item, int lane) {
    const int nblk = N / 32, kb = item / nblk, nb = item % nblk, k0 = 64 * kb, n0 = 32 * nb;
    const int q4 = 4 * (lane & 7), kr = lane >> 3;
    const int sn = PERMUTE ? src_col(n0 + q4) : n0 + q4;
    f32x4 tv[8];
#pragma unroll
    for (int i = 0; i < 8; ++i) tv[i] = *(const f32x4*)(W + (size_t)(k0 + 8 * i + kr) * N + sn);
#pragma unroll
    for (int i = 0; i < 8; ++i) { LAS float* d = scr + (8 * i + kr) * 33 + q4; d[0] = tv[i][0]; d[1] = tv[i][1]; d[2] = tv[i][2]; d[3] = tv[i][3]; }
    asm volatile("s_waitcnt lgkmcnt(0)" ::: "memory");
    const int c = lane & 7;
#pragma unroll
    for (int j = 0; j < 4; ++j) { const int n = (lane >> 3) + 8 * j; const LAS float* s = scr + (8 * c) * 33 + n;
        u32x4 o; o.x = pk2(s[0 * 33], s[1 * 33]); o.y = pk2(s[2 * 33], s[3 * 33]); o.z = pk2(s[4 * 33], s[5 * 33]); o.w = pk2(s[6 * 33], s[7 * 33]);
        *(u32x4*)(WT + (size_t)(n0 + n) * K + k0 + 8 * c) = o; }
    asm volatile("s_waitcnt lgkmcnt(0)" ::: "memory");
}

__device__ __forceinline__ void conv_oct(const f32x2 (&u)[38], const f32x2 (&w)[31], const f32x2 bias, LAS f32x2* acc) {
#pragma unroll
    for (int tt = 0; tt < 8; ++tt) {
        f32x2 a = bias;
#pragma unroll
        for (int k = 0; k < 31; ++k) a += w[k] * u[tt + k];
        acc[tt * 512] = a;
    }
}
__device__ __forceinline__ void conv_load8(unsigned (&nw)[8], const unsigned* up) {
#pragma unroll
    for (int i = 0; i < 8; ++i) nw[i] = up[(long)i * 512];
}
__device__ __forceinline__ void conv_slide(f32x2 (&u)[38], const unsigned (&nw)[8]) {
#pragma unroll
    for (int i = 0; i < 30; ++i) u[i] = u[i + 8];
#pragma unroll
    for (int i = 0; i < 8; ++i) u[30 + i] = (f32x2){bflo(nw[i]), bfhi(nw[i])};
}
__device__ __forceinline__ void conv_items(const Params& p, LAS unsigned char* lds, int bid, int G, int tid) {
    const bf16_t* U = (const bf16_t*)(p.ws + WS_U); bf16_t* ZC = (bf16_t*)(p.ws + WS_ZC);
    const int c = 2 * tid;
    f32x2 w[31];
#pragma unroll
    for (int k = 0; k < 31; ++k) w[k] = *(const f32x2*)(p.conv_w + k * 1024 + c);
    const f32x2 bias = *(const f32x2*)(p.conv_b + c);
    const f32x2 g2 = *(const f32x2*)(p.ln_g + c), b2 = *(const f32x2*)(p.ln_b + c);
    LAS f32x2* red = (LAS f32x2*)lds;
    LAS f32x2* stats = (LAS f32x2*)(lds + 131072);
    for (int it = bid; it < 1024; it += G) {
        const int row0 = it * 32, s0 = row0 & (SEQ - 1);
        const unsigned* up = (const unsigned*)(U + ((long)row0 - 30) * 1024 + c);
        f32x2 u[38]; unsigned nw[8];
        {
            unsigned raw[38];
#pragma unroll
            for (int s = 0; s < 30; ++s) raw[s] = 0u;
            if (s0 > 0) {
#pragma unroll
                for (int s = 0; s < 30; ++s) raw[s] = up[(long)s * 512];
            }
#pragma unroll
            for (int s = 30; s < 38; ++s) raw[s] = up[(long)s * 512];
            conv_load8(nw, up + 38L * 512);
#pragma unroll
            for (int s = 0; s < 38; ++s) u[s] = (f32x2){bflo(raw[s]), bfhi(raw[s])};
        }
        conv_oct(u, w, bias, red + tid);
        conv_slide(u, nw); conv_load8(nw, up + 46L * 512); conv_oct(u, w, bias, red + 8 * 512 + tid);
        conv_slide(u, nw); conv_load8(nw, up + 54L * 512); conv_oct(u, w, bias, red + 16 * 512 + tid);
        conv_slide(u, nw); conv_oct(u, w, bias, red + 24 * 512 + tid);
        unsigned* zp = (unsigned*)(ZC + (size_t)row0 * 1024 + c);
        unsigned zz[32];
#pragma unroll
        for (int t = 0; t < 32; ++t) zz[t] = zp[(size_t)t * 512];
        __syncthreads();
        {
            const int t = tid >> 4, part = tid & 15; float s1 = 0.f, s2 = 0.f;
#pragma unroll 8
            for (int i = 0; i < 32; ++i) { const f32x2 v = red[t * 512 + part + 16 * i]; s1 += v.x + v.y; s2 += v.x * v.x + v.y * v.y; }
#pragma unroll
            for (int o = 1; o < 16; o <<= 1) { s1 += __shfl_xor(s1, o); s2 += __shfl_xor(s2, o); }
            if (part == 0) { const float mean = s1 * (1.f / 1024.f); const float var = fmaxf(s2 * (1.f / 1024.f) - mean * mean, 0.f); stats[t] = (f32x2){mean, 1.0f / sqrtf(var + EPS)}; }
        }
        __syncthreads();
#pragma unroll
        for (int t = 0; t < 32; ++t) {
            const f32x2 st = stats[t], av = red[t * 512 + tid];
            float y0 = (av.x - st.x) * st.y * g2.x + b2.x, y1 = (av.y - st.x) * st.y * g2.y + b2.y;
            y0 *= sigm(y0); y1 *= sigm(y1);
            zp[(size_t)t * 512] = pk2(y0 * bflo(zz[t]), y1 * bfhi(zz[t]));
        }
        __syncthreads();
    }
}

typedef short v4i16_t __attribute__((ext_vector_type(4)));
__device__ __forceinline__ float max3f(float a, float b, float c) { float r; asm("v_max3_f32 %0, %1, %2, %3" : "=v"(r) : "v"(a), "v"(b), "v"(c)); return r; }
__device__ __forceinline__ s16x4 vtr(const LAS unsigned char* p) { return __builtin_bit_cast(s16x4, __builtin_amdgcn_ds_read_tr16_b64_v4i16((LAS v4i16_t*)p)); }
constexpr int KV_ROWB = 160, LDS_VOFF = 256 * KV_ROWB;
struct AttnPre { u32x4 kv[8]; bf16x8 q0, q1; };
template <bool MERGE>
__device__ __forceinline__ void attn_decode(int idx, int& b, int& g, int& j, int& r, int& n, int& sh, size_t& sub) {
    const int q64 = idx & 63; int rest = idx >> 6; j = rest & 7; rest >>= 3;
    if (MERGE) { g = 0; b = rest; } else { g = 1 + (rest & 1); b = rest >> 1; }
    sh = 2 * g; r = q64 >> (6 - sh); n = q64 & ((64 >> sh) - 1);
    sub = ((size_t)(((b * 3 + g) * 8 + j) * SEQ) + ((size_t)r << (13 - sh))) * 64;
}
template <bool MERGE>
__device__ __forceinline__ void attn_prefetch(const Params& p, int idx, bool first, int tid, int lane, int w, AttnPre& R) {
    const bf16_t* Q = (const bf16_t*)(p.ws + WS_Q); const bf16_t* K = (const bf16_t*)(p.ws + WS_K); const bf16_t* V = (const bf16_t*)(p.ws + WS_V);
    int b, g, j, r, n, sh; size_t sub; attn_decode<MERGE>(idx, b, g, j, r, n, sh, sub);
    const size_t rc = sub + (size_t)n * 8192 + tid * 8;
    R.kv[2] = *(const u32x4*)(K + rc); R.kv[3] = *(const u32x4*)(K + rc + 4096); R.kv[6] = *(const u32x4*)(V + rc); R.kv[7] = *(const u32x4*)(V + rc + 4096);
    if (first) {
        const size_t rp = sub + (size_t)(n > 0 ? n - 1 : n) * 8192 + tid * 8;
        R.kv[0] = *(const u32x4*)(K + rp); R.kv[1] = *(const u32x4*)(K + rp + 4096); R.kv[4] = *(const u32x4*)(V + rp); R.kv[5] = *(const u32x4*)(V + rp + 4096);
    }
    const bf16_t* qptr = Q + sub + (size_t)(n * 128 + 16 * w + (lane & 15)) * 64 + 8 * (lane >> 4);
    R.q0 = *(const bf16x8*)(qptr); R.q1 = *(const bf16x8*)(qptr + 32);
}
__device__ __forceinline__ void attn_stage(LAS unsigned char* lds, int tid, const AttnPre& R, bool first, int cs) {
    LAS unsigned char* dc = lds + (cs * 128 + (tid >> 3)) * KV_ROWB + (tid & 7) * 16; LAS unsigned char* dp = lds + ((cs ^ 1) * 128 + (tid >> 3)) * KV_ROWB + (tid & 7) * 16;
    *(LAS u32x4*)(dc) = R.kv[2]; *(LAS u32x4*)(dc + 64 * KV_ROWB) = R.kv[3]; *(LAS u32x4*)(dc + LDS_VOFF) = R.kv[6]; *(LAS u32x4*)(dc + LDS_VOFF + 64 * KV_ROWB) = R.kv[7];
    if (first) { *(LAS u32x4*)(dp) = R.kv[0]; *(LAS u32x4*)(dp + 64 * KV_ROWB) = R.kv[1]; *(LAS u32x4*)(dp + LDS_VOFF) = R.kv[4]; *(LAS u32x4*)(dp + LDS_VOFF + 64 * KV_ROWB) = R.kv[5]; }
}
template <bool MERGE>
__device__ __forceinline__ void attn_compute(const Params& p, LAS unsigned char* lds, int idx, int cs, int lane, int w, const bf16x8 qf0, const bf16x8 qf1) {
    bf16_t* Q = (bf16_t*)(p.ws + WS_Q); float* LSE = (float*)(p.ws + WS_LSE);
    int b, g, j, r, n, sh; size_t sub; attn_decode<MERGE>(idx, b, g, j, r, n, sh, sub);
    const int d = 1 << sh;
    const int fr = lane & 15, fq = lane >> 4;
    const size_t qrow = (size_t)b * SEQ + (size_t)(n * 128 + 16 * w + fr) * d + r;
    bf16_t* qptr = Q + sub + (size_t)(n * 128 + 16 * w + fr) * 64;
    u32x2 o1[4], o2[4], zz[4]; float l1 = 0.f, l2 = 0.f;
    if (MERGE) {
        const int t = n * 128 + 16 * w + fr;
        const bf16_t* p1 = Q + qkv_off(b, 1, j, t) + 8 * fq; const bf16_t* p2 = Q + qkv_off(b, 2, j, t) + 8 * fq;
        const bf16_t* pz = (const bf16_t*)((const unsigned char*)p.out + DO_ZA) + qrow * 512 + j * 64 + 4 * fq;
#pragma unroll
        for (int dt = 0; dt < 4; ++dt) zz[dt] = *(const u32x2*)(pz + 16 * dt);
#pragma unroll
        for (int k = 0; k < 2; ++k) {
            const u32x4 v1 = *(const u32x4*)(p1 + 32 * k), v2 = *(const u32x4*)(p2 + 32 * k);
            o1[2 * k] = (u32x2){v1.x, v1.y}; o1[2 * k + 1] = (u32x2){v1.z, v1.w}; o2[2 * k] = (u32x2){v2.x, v2.y}; o2[2 * k + 1] = (u32x2){v2.z, v2.w};
        }
        l1 = LSE[((size_t)M + qrow) * 8 + j]; l2 = LSE[((size_t)2 * M + qrow) * 8 + j];
    }
    f32x4 s[9];
#pragma unroll
    for (int tp = 0; tp < 9; ++tp) {
        const int tau = w + tp;
        const LAS unsigned char* kb = lds + (((tau < 8 ? (cs ^ 1) : cs) * 128 + 16 * (tau & 7)) + fr) * KV_ROWB + fq * 16;
        const bf16x8 ka = *(const LAS bf16x8*)kb, kc = *(const LAS bf16x8*)(kb + 64);
        f32x4 z = (f32x4){0.f, 0.f, 0.f, 0.f};
        z = __builtin_amdgcn_mfma_f32_16x16x32_bf16(ka, qf0, z, 0, 0, 0);
        s[tp] = __builtin_amdgcn_mfma_f32_16x16x32_bf16(kc, qf1, z, 0, 0, 0);
    }
    const float NEG = -1e30f;
#pragma unroll
    for (int jj = 0; jj < 4; ++jj) { const int key = 4 * fq + jj; if (key < fr) s[0][jj] = NEG; if (key > fr) s[8][jj] = NEG; }
    if (n == 0) {
#pragma unroll
        for (int tp = 0; tp < 8; ++tp) if (w + tp < 8) s[tp] = (f32x4){NEG, NEG, NEG, NEG};
    }
    float mx = NEG;
#pragma unroll
    for (int tp = 0; tp < 9; ++tp) mx = fmaxf(fmaxf(mx, fmaxf(s[tp][0], s[tp][1])), fmaxf(s[tp][2], s[tp][3]));
    mx = fmaxf(mx, __shfl_xor(mx, 16)); mx = fmaxf(mx, __shfl_xor(mx, 32));
    float l = 0.f;
#pragma unroll
    for (int tp = 0; tp < 9; ++tp)
#pragma unroll
        for (int jj = 0; jj < 4; ++jj) { const float e = __builtin_amdgcn_exp2f(s[tp][jj] - mx); s[tp][jj] = e; l += e; }
    u32x4 pw[5];
#pragma unroll
    for (int kp = 0; kp < 4; ++kp) pw[kp] = pack8(s[2 * kp], s[2 * kp + 1]);
    pw[4] = pack8(s[8], (f32x4){0.f, 0.f, 0.f, 0.f});
    f32x4 ot[4];
#pragma unroll
    for (int dt = 0; dt < 4; ++dt) ot[dt] = (f32x4){0.f, 0.f, 0.f, 0.f};
    const LAS unsigned char* vlane = lds + LDS_VOFF + (4 * fq + (fr >> 2)) * KV_ROWB + (fr & 3) * 8;
#pragma unroll
    for (int kp = 0; kp < 5; ++kp)
#pragma unroll
        for (int dt = 0; dt < 4; ++dt) {
            const int ta = w + 2 * kp, tb = ta + 1;
            const s16x4 lo = vtr(vlane + ((ta < 8 ? (cs ^ 1) : cs) * 128 + 16 * (ta & 7)) * KV_ROWB + dt * 32);
            s16x4 hi = (s16x4){0, 0, 0, 0};
            if (kp < 4) hi = vtr(vlane + ((tb < 8 ? (cs ^ 1) : cs) * 128 + 16 * (tb & 7)) * KV_ROWB + dt * 32);
            const bf16x8 a = (bf16x8){lo[0], lo[1], lo[2], lo[3], hi[0], hi[1], hi[2], hi[3]};
            ot[dt] = __builtin_amdgcn_mfma_f32_16x16x32_bf16(a, __builtin_bit_cast(bf16x8, pw[kp]), ot[dt], 0, 0, 0);
        }
    l += __shfl_xor(l, 16); l += __shfl_xor(l, 32);
    const float inv = 1.0f / l;
    if (MERGE) {
        const float l0 = mx + __log2f(l), mxl = fmaxf(l0, fmaxf(l1, l2));
        float w0 = __builtin_amdgcn_exp2f(l0 - mxl), w1 = __builtin_amdgcn_exp2f(l1 - mxl), w2 = __builtin_amdgcn_exp2f(l2 - mxl);
        const float wi = 1.0f / (w0 + w1 + w2); w0 *= wi * inv; w1 *= wi; w2 *= wi;
        bf16_t* a2 = (bf16_t*)((unsigned char*)p.out + DO_A2) + qrow * 1024 + j * 64 + 4 * fq;
#pragma unroll
        for (int dt = 0; dt < 4; ++dt) {
            const float r0 = (w0 * ot[dt][0] + w1 * bflo(o1[dt].x) + w2 * bflo(o2[dt].x)) * bflo(zz[dt].x), r1 = (w0 * ot[dt][1] + w1 * bfhi(o1[dt].x) + w2 * bfhi(o2[dt].x)) * bfhi(zz[dt].x);
            const float r2 = (w0 * ot[dt][2] + w1 * bflo(o1[dt].y) + w2 * bflo(o2[dt].y)) * bflo(zz[dt].y), r3 = (w0 * ot[dt][3] + w1 * bfhi(o1[dt].y) + w2 * bfhi(o2[dt].y)) * bfhi(zz[dt].y);
            u32x2 o; o.x = pk2(r0, r1); o.y = pk2(r2, r3); *(u32x2*)(a2 + 16 * dt) = o;
        }
    } else {
#pragma unroll
        for (int k = 0; k < 2; ++k) {
            u32x4 o; o.x = pk2(ot[2 * k][0] * inv, ot[2 * k][1] * inv); o.y = pk2(ot[2 * k][2] * inv, ot[2 * k][3] * inv); o.z = pk2(ot[2 * k + 1][0] * inv, ot[2 * k + 1][1] * inv); o.w = pk2(ot[2 * k + 1][2] * inv, ot[2 * k + 1][3] * inv);
            *(u32x4*)(qptr + 32 * k + 8 * fq) = o;
        }
        if (fq == 0) LSE[((size_t)g * M + qrow) * 8 + j] = mx + __log2f(l);
    }
}
template <bool MERGE, int CH>
__device__ __forceinline__ void attn_phase(const Params& p, LAS unsigned char* lds, int bid, int G, int nitems, int tid, int lane, int wave) {
    const int nchains = nitems / CH;
    for (int chain = bid; chain < nchains; chain += G) {
        const int idx0 = chain * CH;
        AttnPre R; attn_prefetch<MERGE>(p, idx0, true, tid, lane, wave, R);
        __syncthreads();
        attn_stage(lds, tid, R, true, 0);
        bf16x8 qf0 = R.q0, qf1 = R.q1;
        __syncthreads();
        int cs = 0;
        for (int k = 0; k + 1 < CH; ++k) {
            attn_prefetch<MERGE>(p, idx0 + k + 1, false, tid, lane, wave, R);
            attn_compute<MERGE>(p, lds, idx0 + k, cs, lane, wave, qf0, qf1);
            cs ^= 1;
            __syncthreads();
            attn_stage(lds, tid, R, false, cs); qf0 = R.q0; qf1 = R.q1;
            __syncthreads();
        }
        attn_compute<MERGE>(p, lds, idx0 + CH - 1, cs, lane, wave, qf0, qf1);
    }
}

__global__ void __launch_bounds__(512, 2) fwd_megakernel(Params p) {
    extern __shared__ __attribute__((aligned(16))) unsigned char lds_raw[];
    LAS unsigned char* lds = (LAS unsigned char*)lds_raw;
    cg::grid_group grid = cg::this_grid();
    int tid, lane, wave, gw;
#define RELANE() do { int t_ = threadIdx.x; asm volatile("" : "+v"(t_)); tid = t_; lane = tid & 63; wave = __builtin_amdgcn_readfirstlane(tid >> 6); gw = bid * 8 + wave; } while (0)
    const int G = gridDim.x, bid = blockIdx.x, NGW = G * 8;
    RELANE();
    unsigned char* ws = p.ws; unsigned char* dout = (unsigned char*)p.out;
    float* MOD = (float*)(ws + WS_MOD); float* CS = (float*)(ws + WS_CS); float* SSQ = (float*)(ws + WS_SSQ);
    bf16_t* W1T = (bf16_t*)(ws + WS_W1T); bf16_t* WCO = (bf16_t*)(ws + WS_WCO); bf16_t* WAO = (bf16_t*)(ws + WS_WAO); bf16_t* WO = (bf16_t*)(ws + WS_WO);
    bf16_t* H = (bf16_t*)(dout + DO_H); bf16_t* ZA = (bf16_t*)(dout + DO_ZA); unsigned char* GC8 = dout + DO_GC;
    unsigned* const barw = (unsigned*)(ws + WS_BAR);
    unsigned* const pcnt = (unsigned*)(ws + WS_BAR + 65536);
    volatile LAS unsigned* const misc = (volatile LAS unsigned*)(lds + 131072 + 1024);
    if (tid == 0) { misc[0] = 0u; misc[1] = 0u; }
    __syncthreads();
    XcdBarrier xbar = xcd_barrier_post(barw, misc);
    if (G == 0x7fffffff) grid.sync();
    unsigned long long* const tsb = (unsigned long long*)(ws + 700 * 1024); int nstamp = 0;
#define STAMP() do { if (PROBE_LO >= 0) { if (bid == 0 && tid == 0) tsb[nstamp] = __builtin_amdgcn_s_memrealtime(); ++nstamp; } } while (0)
#define GSYNC() do { xcd_barrier(xbar); RELANE(); STAMP(); } while (0)
    STAMP();

    for (int it = bid; it < 96 * 8; it += G) {
        const int cgp = it % 96, kc = it / 96, n0 = cgp * 32, col = tid & 31, ks = tid >> 5;
        float a0 = 0.f, a1 = 0.f, a2 = 0.f, a3 = 0.f;
        const int kb = kc * 128 + ks * 8;
        const float* wp = p.w_ada + (size_t)kb * 3072 + n0 + col; const float* cc = p.c + kb;
#pragma unroll
        for (int k = 0; k < 8; ++k) { const float wv = wp[(size_t)k * 3072]; a0 += cc[k] * wv; a1 += cc[1024 + k] * wv; a2 += cc[2048 + k] * wv; a3 += cc[3072 + k] * wv; }
        LAS float* red = (LAS float*)lds;
        red[(ks * 4 + 0) * 32 + col] = a0; red[(ks * 4 + 1) * 32 + col] = a1; red[(ks * 4 + 2) * 32 + col] = a2; red[(ks * 4 + 3) * 32 + col] = a3;
        __syncthreads();
        if (tid < 128) { const int bb = tid >> 5; float sum = kc == 0 ? p.b_ada[n0 + col] : 0.f;
#pragma unroll
            for (int k2 = 0; k2 < 16; ++k2) sum += red[(k2 * 4 + bb) * 32 + col];
            atomicAdd(MOD + bb * 3072 + n0 + col, sum); }
        __syncthreads();
    }
    GSYNC();

    for (int rep0 = 0; rep0 < REP_P0; ++rep0) {
    {
        LAS float* scr = (LAS float*)(lds + wave * 16384);
        constexpr int I1 = 16 * 320, I2 = 16 * 32, I3 = 8 * 32, I4 = 16 * 32;
        for (int it = gw; it < I1 + I2 + I3 + I4; it += NGW) {
            int r = it;
            if (r < I1) { transpose_item<true>(p.w_in, 1024, NIN, W1T, scr, r, lane); continue; } r -= I1;
            if (r < I2) { transpose_item<false>(p.w_co, 1024, 1024, WCO, scr, r, lane); continue; } r -= I2;
            if (r < I3) { transpose_item<false>(p.w_ao, 1024  , 1024, WAO, scr, r, lane); continue; } r -= I3;
            transpose_item<false>(p.w_o, 1024, 1024, WO, scr, r, lane);
        }
    }
    for (int e = bid * 512 + tid; e < M * 8; e += G * 512) {
        const int row = e >> 3, i = e & 7;
        const float fi = i == 0 ? p.f0 : i == 1 ? p.f1 : i == 2 ? p.f2 : i == 3 ? p.f3 : i == 4 ? p.f4 : i == 5 ? p.f5 : i == 6 ? p.f6 : p.f7;
        const float ang = (float)p.pos[row] * fi;
        const double rev = (double)ang * 0.15915494309189535; const float frac = (float)(rev - __builtin_rint(rev));
        CS[row * 16 + (i >> 2) * 8 + (i & 3)] = __builtin_amdgcn_cosf(frac); CS[row * 16 + (i >> 2) * 8 + 4 + (i & 3)] = __builtin_amdgcn_sinf(frac);
    }
    for (int row = gw; row < M; row += 2 * NGW) {
        const int rowb = row + NGW;
        const bool hasb = rowb < M;
        const f32x4* xa = (const f32x4*)(p.x + (size_t)row * 1024) + lane; const f32x4* xb = (const f32x4*)(p.x + (size_t)(hasb ? rowb : row) * 1024) + lane;
        f32x4 va[4], vb[4]; float sa = 0.f, sb = 0.f;
#pragma unroll
        for (int jx = 0; jx < 4; ++jx) { va[jx] = __builtin_nontemporal_load(xa + 64 * jx); vb[jx] = __builtin_nontemporal_load(xb + 64 * jx); }
#pragma unroll
        for (int jx = 0; jx < 4; ++jx) { sa += (va[jx][0] * va[jx][0] + va[jx][1] * va[jx][1]) + (va[jx][2] * va[jx][2] + va[jx][3] * va[jx][3]); sb += (vb[jx][0] * vb[jx][0] + vb[jx][1] * vb[jx][1]) + (vb[jx][2] * vb[jx][2] + vb[jx][3] * vb[jx][3]); }
#pragma unroll
        for (int o = 1; o < 64; o <<= 1) { sa += __shfl_xor(sa, o); sb += __shfl_xor(sb, o); }
        const float ra = 1.0f / sqrtf(sa * (1.f / 1024.f) + EPS), rb = 1.0f / sqrtf(sb * (1.f / 1024.f) + EPS);
        const float* ma = MOD + (row >> 13) * 3072; const float* mb = MOD + ((hasb ? rowb : row) >> 13) * 3072;
#pragma unroll
        for (int jx = 0; jx < 4; ++jx) { const int col = 4 * lane + 256 * jx;
            const f32x4 gg = *(const f32x4*)(p.norm_g + col);
            { const f32x4 scl = *(const f32x4*)(ma + 1024 + col), sft = *(const f32x4*)(ma + col); const f32x4 y = va[jx] * ra * gg * (scl + 1.0f) + sft;
              u32x2 o; o.x = pk2(y[0], y[1]); o.y = pk2(y[2], y[3]); *(u32x2*)(H + (size_t)row * 1024 + col) = o; }
            if (hasb) { const f32x4 scl = *(const f32x4*)(mb + 1024 + col), sft = *(const f32x4*)(mb + col); const f32x4 y = vb[jx] * rb * gg * (scl + 1.0f) + sft;
              u32x2 o; o.x = pk2(y[0], y[1]); o.y = pk2(y[2], y[3]); *(u32x2*)(H + (size_t)rowb * 1024 + col) = o; }
        }
    }
    }
    GSYNC();

    for (int rep = 0; rep < REP_P1; ++rep) {
        pg8::Gemm g{H, W1T, M, NIN, 1024, H, W1T, 16, 16}; pg8::StaticOrder S; S.init(M, NIN, G, bid, WGM_P1);
        Epi1 E{ws, dout};
        pg8::gemm_phase<Epi1, pg8::StaticOrder, true, true>(lds, g, S, E);
    }
    GSYNC();

    conv_items(p, lds, bid, G, tid);
    attn_phase<false, 16>(p, lds, bid, G, 4096, tid, lane, wave);
    GSYNC();

    attn_phase<true, 8>(p, lds, bid, G, 2048, tid, lane, wave);
    GSYNC();

    for (int rep = 0; rep < REP_P4; ++rep) {
        pg8::Gemm g{(const bf16_t*)(ws + WS_ZC), WCO, M, 1024, 1024, (const bf16_t*)(dout + DO_A2), WAO, 16, 8}; pg8::PairOrder S; S.init(M, 1024, G, bid, WGM_P4);
        Epi34 E{GC8, ws + WS_GA, (bf16_t*)(ws + WS_MG)};
        pg8::gemm_phase<Epi34, pg8::PairOrder, true, true>(lds, g, S, E);
    }
    GSYNC();

    for (int rep = 0; rep < REP_P5; ++rep) {
        pg8::Gemm g{(const bf16_t*)(ws + WS_MG), WO, M, 1024, 1024, (const bf16_t*)(ws + WS_MG), WO, 16, 16}; pg8::StaticOrder S; S.init(M, 1024, G, bid, WGM_P5);
        Epi5 E{p.x, MOD, p.out, p.final_g, SSQ, pcnt + rep * 128 * 64, lds + 131072 + 2048};
        pg8::gemm_phase<Epi5, pg8::StaticOrder, true, true>(lds, g, S, E);
    }
    STAMP();
    if (PROBE_LO >= 0 && bid == 0 && threadIdx.x == 0) {
        asm volatile("s_waitcnt vmcnt(0)" ::: "memory");
        const unsigned long long dt = tsb[PROBE_HI] - tsb[PROBE_LO], t0 = __builtin_amdgcn_s_memrealtime();
        while (__builtin_amdgcn_s_memrealtime() - t0 < dt) __builtin_amdgcn_s_sleep(8);
    }
}

extern "C" void kernel_launch(void* const* d_in, const int* in_sizes, int n_in, void* d_out, int out_size, void* d_ws, size_t ws_size, hipStream_t stream) {
    static int grid = 0;
    if (grid == 0) {
        if (n_in != 15 || out_size != M * DM || ws_size < WS_END) { fprintf(stderr, "kernel_launch: unexpected sizes (n_in %d, out %d, ws %zu)\n", n_in, out_size, ws_size); grid = -1; return; }
        int dev = 0, cus = 0, per_cu = 0;
        (void)hipGetDevice(&dev); (void)hipDeviceGetAttribute(&cus, hipDeviceAttributeMultiprocessorCount, dev);
        (void)hipFuncSetAttribute((const void*)fwd_megakernel, hipFuncAttributeMaxDynamicSharedMemorySize, LDS_BYTES);
        if (hipOccupancyMaxActiveBlocksPerMultiprocessor(&per_cu, (const void*)fwd_megakernel, 512, LDS_BYTES) != hipSuccess || per_cu < 1) per_cu = 1;
        (void)hipGetLastError();
        grid = cus * per_cu;
    }
    if (grid < 0) return;
    Params p{};
    p.x = (const float*)d_in[0]; p.c = (const float*)d_in[1]; p.pos = (const int*)d_in[2]; p.norm_g = (const float*)d_in[3]; p.w_ada = (const float*)d_in[4]; p.b_ada = (const float*)d_in[5];
    p.w_in = (const float*)d_in[6]; p.conv_w = (const float*)d_in[7]; p.conv_b = (const float*)d_in[8]; p.ln_g = (const float*)d_in[9]; p.ln_b = (const float*)d_in[10];
    p.w_co = (const float*)d_in[11]; p.w_ao = (const float*)d_in[12]; p.w_o = (const float*)d_in[13]; p.final_g = (const float*)d_in[14];
    p.out = (float*)d_out; p.ws = (unsigned char*)d_ws;
    p.f0 = 1.0f; p.f1 = 1.939227432e-01f; p.f2 = 3.760603070e-02f; p.f3 = 7.292664610e-03f; p.f4 = 1.414213562e-03f; p.f5 = 2.742481884e-04f; p.f6 = 5.318295734e-05f; p.f7 = 1.031338525e-05f;
    if (hipMemsetAsync(d_ws, 0, 1 * MiB, stream) != hipSuccess) { fprintf(stderr, "kernel_launch: memset of the control words failed\n"); return; }
    void* args[] = {&p};
    const hipError_t e = hipLaunchCooperativeKernel((const void*)fwd_megakernel, dim3(grid), dim3(512), args, LDS_BYTES, stream);
    if (e != hipSuccess) fprintf(stderr, "cooperative launch failed: %s (grid %d)\n", hipGetErrorString(e), grid);
}
```
